# Optimizing an MI355X kernel written in HIP

```python
import math
import jax, jax.numpy as jnp
from jax import lax
import numpy as np

D_MODEL = 2048
BATCH = 8
SEQ = 2048
DEPTH = 1

N_DIR = 2
N_BRANCH = 2
MLSTM_HEADS = 4
MLSTM_V_DIM = 256
MLSTM_QK_DIM = 128
MLSTM_W = MLSTM_HEADS * MLSTM_V_DIM
MLSTM_QK_W = MLSTM_HEADS * MLSTM_QK_DIM
MLSTM_CHUNK = 64
DELTA_HEADS = 8
DELTA_HEAD_DIM = 128
DELTA_W = DELTA_HEADS * DELTA_HEAD_DIM
DELTA_CONV = 5
DELTA_CHUNK = 64
D_FF = 4 * D_MODEL
RMS_EPS = 1e-6
L2_EPS = 1e-6
IN_SPLITS = (MLSTM_QK_W, MLSTM_QK_W, MLSTM_W, MLSTM_W,
             N_DIR * MLSTM_HEADS, N_DIR * MLSTM_HEADS,
             3 * DELTA_W, DELTA_W, N_DIR * DELTA_HEADS, N_DIR * DELTA_HEADS,
             N_BRANCH * D_MODEL)
D_IN = sum(IN_SPLITS)

kernel_name = "bidir_mlstm_gdn_hybrid_layer"


def _rms_norm(x, g):
    xf = x.astype(jnp.float32)
    y = xf * lax.rsqrt(jnp.mean(xf * xf, axis=-1, keepdims=True) + RMS_EPS)
    return (y * g.astype(jnp.float32)).astype(x.dtype)


def _heads(t, n):
    b, s, w = t.shape
    return t.reshape(b, s, n, w // n).transpose(0, 2, 1, 3)


def _merge_heads(t):
    b, n, s, d = t.shape
    return t.transpose(0, 2, 1, 3).reshape(b, s, n * d)


def _dir_heads(t, n):
    b, s, _ = t.shape
    return t.astype(jnp.float32).reshape(b, s, N_DIR, n).transpose(2, 0, 3, 1)


def _flip(t):
    return jnp.flip(t, axis=2)


def _to_chunks(t, size):
    s = t.shape[2]
    t = t.reshape(t.shape[:2] + (s // size, size) + t.shape[3:])
    return jnp.moveaxis(t, 2, 0)


def _from_chunks(t):
    t = jnp.moveaxis(t, 0, 2)
    return t.reshape(t.shape[:2] + (t.shape[2] * t.shape[3],) + t.shape[4:])


def _l2_normalize(t):
    return t * lax.rsqrt(jnp.sum(t * t, axis=-1, keepdims=True) + L2_EPS)


def _mlstm_chunk_scan(q, k, v, i_pre, logf):
    b_, h_, s_, dk = q.shape
    dv = v.shape[-1]
    L = MLSTM_CHUNK
    qc, kc, vc, ic, fc = (_to_chunks(t, L) for t in (q, k, v, i_pre, logf))
    causal = jnp.tril(jnp.ones((L, L), dtype=bool))

    def step(carry, inp):
        c_st, n_st, m_st = carry
        qj, kj, vj, ij, fj = inp
        bcum = jnp.cumsum(fj, axis=-1)
        log_intra = jnp.where(causal, bcum[..., :, None] - bcum[..., None, :] + ij[..., None, :], -jnp.inf)
        log_inter = bcum + m_st[..., None]
        m_row = jnp.maximum(log_inter, jnp.max(log_intra, axis=-1))
        w_intra = jnp.exp(log_intra - m_row[..., None])
        w_inter = jnp.exp(log_inter - m_row)
        scores = jnp.einsum('bhld,bhsd->bhls', qj, kj) * w_intra
        num = (jnp.einsum('bhls,bhsv->bhlv', scores, vj)
               + w_inter[..., None] * jnp.einsum('bhld,bhdv->bhlv', qj, c_st))
        den = jnp.sum(scores, axis=-1) + w_inter * jnp.einsum('bhld,bhd->bhl', qj, n_st)
        h_out = num / jnp.maximum(jnp.abs(den), jnp.exp(-m_row))[..., None]
        b_last = bcum[..., -1]
        log_state = b_last[..., None] - bcum + ij
        m_new = jnp.maximum(b_last + m_st, jnp.max(log_state, axis=-1))
        w_state = jnp.exp(log_state - m_new[..., None])
        decay = jnp.exp(b_last + m_st - m_new)
        c_new = decay[..., None, None] * c_st + jnp.einsum('bhs,bhsd,bhsv->bhdv', w_state, kj, vj)
        n_new = decay[..., None] * n_st + jnp.einsum('bhs,bhsd->bhd', w_state, kj)
        return (c_new, n_new, m_new), h_out

    carry0 = (jnp.zeros((b_, h_, dk, dv), q.dtype),
              jnp.zeros((b_, h_, dk), q.dtype),
              jnp.full((b_, h_), -jnp.inf, q.dtype))
    _, h_all = lax.scan(step, carry0, (qc, kc, vc, ic, fc))
    return _from_chunks(h_all)


def _gated_delta_chunk_scan(q, k, v, g, beta):
    b_, h_, s_, dk = q.shape
    dv = v.shape[-1]
    L = DELTA_CHUNK
    qc, kc, vc, gc, bc = (_to_chunks(t, L) for t in (q, k, v, g, beta))
    gc = jnp.cumsum(gc, axis=-1)
    lower = jnp.tril(jnp.ones((L, L), dtype=bool))
    strict = jnp.tril(jnp.ones((L, L), dtype=bool), -1)
    gamma = jnp.exp(jnp.where(lower, gc[..., :, None] - gc[..., None, :], -jnp.inf))
    kb = kc * bc[..., None]
    a_mat = jnp.where(strict, jnp.einsum('nbhid,nbhjd->nbhij', kb, kc) * gamma, 0.0) + jnp.eye(L, dtype=q.dtype)
    u = lax.linalg.triangular_solve(a_mat, vc * bc[..., None], left_side=True, lower=True, unit_diagonal=True)
    w = lax.linalg.triangular_solve(a_mat, kb * jnp.exp(gc)[..., None], left_side=True, lower=True, unit_diagonal=True)
    attn = jnp.einsum('nbhid,nbhjd->nbhij', qc, kc) * gamma
    qg = qc * jnp.exp(gc)[..., None]
    g_last = gc[..., -1]
    kd = kc * jnp.exp(g_last[..., None] - gc)[..., None]

    def step(state, inp):
        qg_c, kd_c, u_c, w_c, attn_c, gl = inp
        v_new = u_c - jnp.einsum('bhld,bhdv->bhlv', w_c, state)
        o = jnp.einsum('bhld,bhdv->bhlv', qg_c, state) + jnp.einsum('bhls,bhsv->bhlv', attn_c, v_new)
        state = jnp.exp(gl)[..., None, None] * state + jnp.einsum('bhld,bhlv->bhdv', kd_c, v_new)
        return state, o

    s0 = jnp.zeros((b_, h_, dk, dv), q.dtype)
    _, o_all = lax.scan(step, s0, (qg, kd, u, w, attn, g_last))
    return _from_chunks(o_all)


def _mlstm_mixer(q, k, v, o_pre, i_pre, f_pre, i_bias, f_bias, norm_g):
    f32 = jnp.float32
    qh = _heads(q, MLSTM_HEADS).astype(f32)
    kh = _heads(k, MLSTM_HEADS).astype(f32) * (MLSTM_QK_DIM ** -0.5)
    vh = _heads(v, MLSTM_HEADS).astype(f32)
    ig = _dir_heads(i_pre, MLSTM_HEADS) + i_bias.astype(f32)[:, None, :, None]
    lf = jax.nn.log_sigmoid(_dir_heads(f_pre, MLSTM_HEADS) + f_bias.astype(f32)[:, None, :, None])
    h_fwd = _mlstm_chunk_scan(qh, kh, vh, ig[0], lf[0])
    h_bwd = _flip(_mlstm_chunk_scan(_flip(qh), _flip(kh), _flip(vh), _flip(ig[1]), _flip(lf[1])))
    h = h_fwd + h_bwd
    h = h * lax.rsqrt(jnp.mean(h * h, axis=-1, keepdims=True) + RMS_EPS)
    h = h * norm_g.astype(f32).reshape(MLSTM_HEADS, 1, MLSTM_V_DIM)
    return (jax.nn.sigmoid(o_pre.astype(f32)) * _merge_heads(h)).astype(q.dtype)


def _gated_deltanet_mixer(qkv, z, a_pre, b_pre, conv_w, a_log, dt_bias, norm_g):
    f32 = jnp.float32
    ch = qkv.shape[-1]
    pad = DELTA_CONV // 2
    qkv = lax.conv_general_dilated(qkv, conv_w[:, None, :], window_strides=(1,), padding=[(pad, pad)],
                                   dimension_numbers=('NWC', 'WIO', 'NWC'), feature_group_count=ch)
    qkv = jax.nn.silu(qkv)
    q, k, v = jnp.split(qkv, 3, axis=-1)
    qh = _l2_normalize(_heads(q, DELTA_HEADS).astype(f32)) * (DELTA_HEAD_DIM ** -0.5)
    kh = _l2_normalize(_heads(k, DELTA_HEADS).astype(f32))
    vh = _heads(v, DELTA_HEADS).astype(f32)
    a = _dir_heads(a_pre, DELTA_HEADS) + dt_bias.astype(f32)[:, None, :, None]
    g = -jnp.exp(a_log.astype(f32))[:, None, :, None] * jax.nn.softplus(a)
    beta = jax.nn.sigmoid(_dir_heads(b_pre, DELTA_HEADS))
    o_fwd = _gated_delta_chunk_scan(qh, kh, vh, g[0], beta[0])
    o_bwd = _flip(_gated_delta_chunk_scan(_flip(qh), _flip(kh), _flip(vh), _flip(g[1]), _flip(beta[1])))
    o = o_fwd + o_bwd
    o = o * lax.rsqrt(jnp.mean(o * o, axis=-1, keepdims=True) + RMS_EPS) * norm_g.astype(f32)
    return (_merge_heads(o) * jax.nn.silu(z.astype(f32))).astype(z.dtype)


def setup_inputs(seed: int = 0) -> dict:
    key = jax.random.key(seed)
    ks = jax.random.split(key, 20)
    f32 = jnp.float32

    def dense(k, fan_in, fan_out):
        return jax.random.normal(k, (DEPTH, fan_in, fan_out), f32) * (fan_in ** -0.5)

    def gain(k, n):
        return 1.0 + 0.02 * jax.random.normal(k, (DEPTH, n), f32)

    dt = jnp.exp(jax.random.uniform(ks[8], (DEPTH, N_DIR, DELTA_HEADS), f32, math.log(1e-3), math.log(1e-1)))
    return {
        "x": jax.random.normal(ks[0], (BATCH, SEQ, D_MODEL), f32),
        "norm1_g": gain(ks[1], D_MODEL),
        "w_in": dense(ks[2], D_MODEL, D_IN),
        "mlstm_i_bias": 0.1 * jax.random.normal(ks[3], (DEPTH, N_DIR, MLSTM_HEADS), f32),
        "mlstm_f_bias": jax.random.uniform(ks[4], (DEPTH, N_DIR, MLSTM_HEADS), f32, 3.0, 6.0),
        "mlstm_norm_g": gain(ks[5], MLSTM_W),
        "delta_conv_w": jax.random.normal(ks[6], (DEPTH, DELTA_CONV, 3 * DELTA_W), f32) * (DELTA_CONV ** -0.5),
        "delta_a_log": jnp.log(jax.random.uniform(ks[7], (DEPTH, N_DIR, DELTA_HEADS), f32, 1.0, 16.0)),
        "delta_dt_bias": dt + jnp.log(-jnp.expm1(-dt)),
        "delta_norm_g": gain(ks[9], DELTA_HEAD_DIM),
        "w_branch_m": dense(ks[10], MLSTM_W, D_MODEL),
        "w_branch_d": dense(ks[11], DELTA_W, D_MODEL),
        "w_out": dense(ks[12], D_MODEL, D_MODEL),
        "norm2_g": gain(ks[13], D_MODEL),
        "w_ff1": dense(ks[14], D_MODEL, D_FF),
        "w_ff2": dense(ks[15], D_FF, D_MODEL),
        "norm_f_g": 1.0 + 0.02 * jax.random.normal(ks[16], (D_MODEL,), f32),
    }


def reference(x, norm1_g, w_in, mlstm_i_bias, mlstm_f_bias, mlstm_norm_g, delta_conv_w, delta_a_log,
              delta_dt_bias, delta_norm_g, w_branch_m, w_branch_d, w_out, norm2_g, w_ff1, w_ff2, norm_f_g):
    split_points = np.cumsum(IN_SPLITS)[:-1].tolist()
    for l in range(DEPTH):
        h = _rms_norm(x, norm1_g[l])
        proj = h @ w_in[l]
        (m_q, m_k, m_v, m_o, m_i, m_f, d_qkv, d_z, d_a, d_b, gates) = jnp.split(proj, split_points, axis=-1)
        y_m = _mlstm_mixer(m_q, m_k, m_v, m_o, m_i, m_f, mlstm_i_bias[l], mlstm_f_bias[l], mlstm_norm_g[l])
        y_d = _gated_deltanet_mixer(d_qkv, d_z, d_a, d_b, delta_conv_w[l], delta_a_log[l], delta_dt_bias[l],
                                    delta_norm_g[l])
        g_m, g_d = jnp.split(gates, 2, axis=-1)
        mixed = jax.nn.sigmoid(g_m) * (y_m @ w_branch_m[l]) + jax.nn.sigmoid(g_d) * (y_d @ w_branch_d[l])
        x = x + mixed @ w_out[l]
        h = _rms_norm(x, norm2_g[l])
        x = x + jnp.square(jax.nn.relu(h @ w_ff1[l])) @ w_ff2[l]
    return _rms_norm(x, norm_f_g)
```

```cpp
#include <hip/hip_runtime.h>
#include <cstdio>
#include <cstdint>

#ifndef MK_N_LAUNCHES
#define MK_N_LAUNCHES 11
#endif
constexpr int MROWS = 16384;
namespace pg8 {
#define PG8_LAS __attribute__((address_space(3)))
typedef unsigned short bf16_t;
typedef short bf16x8 __attribute__((ext_vector_type(8)));
typedef float f32x4 __attribute__((ext_vector_type(4)));
typedef unsigned u32x4 __attribute__((ext_vector_type(4)));
constexpr int BM = 256, BK = 64, HALF = 128, HTB = HALF * BK * 2  , STAGE_BYTES = 8 * HTB, NXCD = 8, WGM = 8;

__host__ __device__ __forceinline__ int lds_byte(int r, int c) { const int st = (r >> 4) * 2 + (c >> 5), rr = r & 15, cc = c & 31, ob = rr * 64 + cc * 2; return st * 1024 + (ob ^ (((ob >> 9) & 1) << 5)); }
__host__ __device__ __forceinline__ void stage_rc(int b, int& R, int& C) { const int st = b / 1024, sb = b % 1024, swz = sb ^ (((sb >> 9) & 1) << 5); R = (st >> 1) * 16 + swz / 64; C = (st & 1) * 32 + (swz % 64) / 2; }
__host__ __device__ __forceinline__ int perm32(int rho) { const int n = rho >> 4, i = rho & 15; return 8 * (i >> 2) + 4 * n + (i & 3); }

struct Unit { int pm, pn; };
struct Gemm { const bf16_t* A; const bf16_t* Bt; int M, N, K; };

struct StaticOrder {
    int nM, nN, nwg, G, c;
    __host__ __device__ void init(int M, int N, int G_, int c_) { nM = M / BM; nN = N / BM; nwg = nM * nN; G = G_; c = c_; }
    __host__ __device__ bool next(int i, Unit& u) const {
        const long L = (long)i * G + c; if (L >= nwg) return false;
        int wgid = (int)L; { const int q = nwg / NXCD, r = nwg % NXCD, xcd = wgid % NXCD, off = wgid / NXCD; wgid = (xcd < r ? xcd * (q + 1) : r * (q + 1) + (xcd - r) * q) + off; }
        const int nig = WGM * nN, gid = wgid / nig, fm = gid * WGM, gsz = (nM - fm) < WGM ? (nM - fm) : WGM;
        u.pm = fm + ((wgid % nig) % gsz); u.pn = (wgid % nig) / gsz; return true;
    }
    __device__ __forceinline__ void a_ready(const Unit&) const {}
    __device__ __forceinline__ void done(const Unit&) const {}
};

__device__ __forceinline__ unsigned cvt_pk_bf16(float lo, float hi) { unsigned r; asm volatile("v_cvt_pk_bf16_f32 %0, %1, %2" : "=v"(r) : "v"(lo), "v"(hi)); return r; }
typedef float f32x2 __attribute__((ext_vector_type(2)));
typedef unsigned u32x2 __attribute__((ext_vector_type(2)));
__device__ __forceinline__ float bf_lo(unsigned w) { return __uint_as_float(w << 16); }
__device__ __forceinline__ float bf_hi(unsigned w) { return __uint_as_float(w & 0xffff0000u); }
__device__ __forceinline__ float fsigmoid(float x) { return __builtin_amdgcn_rcpf(1.0f + __expf(-x)); }

struct EpiProj {
    static constexpr bool PERM = true, AFTER_DRAIN = false;
    bf16_t* P; float* gates;
    __device__ __forceinline__ void operator()(const f32x4 (&acc)[2][2][4][2], const Unit& u, int wr, int wc, int fr, int fq) const {
        const int row0 = u.pm * BM + wr * 64 + fr;
        if (u.pn < 44) {
            bf16_t* base = P + (size_t)u.pn * ((size_t)MROWS * 256) + wc * 32 + 8 * fq;
#pragma unroll
            for (int ai = 0; ai < 2; ++ai)
#pragma unroll
                for (int m = 0; m < 4; ++m) { bf16_t* rowp = base + (size_t)(row0 + ai * HALF + m * 16) * 256;
#pragma unroll
                    for (int bj = 0; bj < 2; ++bj) { const f32x4 v0 = acc[ai][bj][m][0], v1 = acc[ai][bj][m][1];
                        u32x4 w; w.x = cvt_pk_bf16(v0[0], v0[1]); w.y = cvt_pk_bf16(v0[2], v0[3]); w.z = cvt_pk_bf16(v1[0], v1[1]); w.w = cvt_pk_bf16(v1[2], v1[3]);
                        *(u32x4*)(rowp + bj * HALF) = w; } }
        } else if (wc < 2) {
#pragma unroll
            for (int ai = 0; ai < 2; ++ai)
#pragma unroll
                for (int m = 0; m < 4; ++m) { float* rp = gates + (size_t)(row0 + ai * HALF + m * 16) * 64 + wc * 32 + 8 * fq;
                    *(f32x4*)rp = acc[ai][0][m][0]; *(f32x4*)(rp + 4) = acc[ai][0][m][1]; }
        }
    }
};

struct EpiBranch {
    static constexpr bool PERM = true, AFTER_DRAIN = false;
    const bf16_t* G; bf16_t* O;
    __device__ __forceinline__ void operator()(const f32x4 (&acc)[2][2][4][2], const Unit& u, int wr, int wc, int fr, int fq) const {
        const int br = u.pn >> 3, pn = u.pn & 7, pm = u.pm & 63;
        const int row0 = pm * BM + wr * 64 + fr, cl = wc * 32 + 8 * fq;
        const bf16_t* gbase = G + (size_t)(28 + 8 * br + pn) * ((size_t)MROWS * 256) + cl;
        bf16_t* obase = O + pn * 256 + cl;
#pragma unroll
        for (int ai = 0; ai < 2; ++ai)
#pragma unroll
            for (int m = 0; m < 4; ++m) { const size_t r = (size_t)(row0 + ai * HALF + m * 16);
#pragma unroll
                for (int bj = 0; bj < 2; ++bj) {
                    const u32x4 gv = *(const u32x4*)(gbase + r * 256 + bj * HALF);
                    const f32x4 a0 = acc[ai][bj][m][0], a1 = acc[ai][bj][m][1];
                    float v[8];
                    v[0] = a0[0] * fsigmoid(bf_lo(gv.x)); v[1] = a0[1] * fsigmoid(bf_hi(gv.x)); v[2] = a0[2] * fsigmoid(bf_lo(gv.y)); v[3] = a0[3] * fsigmoid(bf_hi(gv.y));
                    v[4] = a1[0] * fsigmoid(bf_lo(gv.z)); v[5] = a1[1] * fsigmoid(bf_hi(gv.z)); v[6] = a1[2] * fsigmoid(bf_lo(gv.w)); v[7] = a1[3] * fsigmoid(bf_hi(gv.w));
                    bf16_t* op = obase + r * 2048 + bj * HALF;
                    if (br) { const u32x4 pv = *(const u32x4*)op;
                        v[0] += bf_lo(pv.x); v[1] += bf_hi(pv.x); v[2] += bf_lo(pv.y); v[3] += bf_hi(pv.y); v[4] += bf_lo(pv.z); v[5] += bf_hi(pv.z); v[6] += bf_lo(pv.w); v[7] += bf_hi(pv.w); }
                    u32x4 w; w.x = cvt_pk_bf16(v[0], v[1]); w.y = cvt_pk_bf16(v[2], v[3]); w.z = cvt_pk_bf16(v[4], v[5]); w.w = cvt_pk_bf16(v[6], v[7]);
                    *(u32x4*)op = w; } }
    }
};
struct BranchOrder {
    StaticOrder so;
    __host__ __device__ void init(int G_, int c_) { so.init(MROWS, 2048, G_, c_); }
    __host__ __device__ bool next(int i, Unit& u) const { Unit t; if (!so.next(i >> 1, t)) return false; const int br = i & 1; u.pm = t.pm + 64 * br; u.pn = t.pn + 8 * br; return true; }
    __device__ __forceinline__ void a_ready(const Unit&) const {}
    __device__ __forceinline__ void done(const Unit&) const {}
};

struct EpiResid {
    static constexpr bool PERM = false, AFTER_DRAIN = false;
    const float* base; float* out; int ldc;
    __device__ __forceinline__ void operator()(const f32x4 (&acc)[2][2][4][2], const Unit& u, int wr, int wc, int fr, int fq) const {
        const int col0 = u.pn * BM + wc * 32 + 4 * fq;
#pragma unroll
        for (int ai = 0; ai < 2; ++ai)
#pragma unroll
            for (int m = 0; m < 4; ++m) { const size_t off = (size_t)(u.pm * BM + ai * HALF + wr * 64 + m * 16 + fr) * ldc + col0;
#pragma unroll
                for (int bj = 0; bj < 2; ++bj)
#pragma unroll
                    for (int n = 0; n < 2; ++n) { const f32x4 bs = *(const f32x4*)(base + off + bj * HALF + n * 16); *(f32x4*)(out + off + bj * HALF + n * 16) = bs + acc[ai][bj][m][n]; } }
    }
};

struct EpiRelu2 {
    static constexpr bool PERM = true, AFTER_DRAIN = false;
    bf16_t* O; int ldc;
    __device__ __forceinline__ void operator()(const f32x4 (&acc)[2][2][4][2], const Unit& u, int wr, int wc, int fr, int fq) const {
        const int row0 = u.pm * BM + wr * 64 + fr, col0 = u.pn * BM + wc * 32 + 8 * fq;
#pragma unroll
        for (int ai = 0; ai < 2; ++ai)
#pragma unroll
            for (int m = 0; m < 4; ++m) { bf16_t* rowp = O + (size_t)(row0 + ai * HALF + m * 16) * ldc + col0;
#pragma unroll
                for (int bj = 0; bj < 2; ++bj) { f32x4 v0 = acc[ai][bj][m][0], v1 = acc[ai][bj][m][1];
#pragma unroll
                    for (int e = 0; e < 4; ++e) { const float a = fmaxf(v0[e], 0.f), b = fmaxf(v1[e], 0.f); v0[e] = a * a; v1[e] = b * b; }
                    u32x4 w; w.x = cvt_pk_bf16(v0[0], v0[1]); w.y = cvt_pk_bf16(v0[2], v0[3]); w.z = cvt_pk_bf16(v1[0], v1[1]); w.w = cvt_pk_bf16(v1[2], v1[3]);
                    *(u32x4*)(rowp + bj * HALF) = w; } }
    }
};
template <class Epi, class Sched, bool ALIGN_EPI = false, bool SP2 = false>
__device__ __forceinline__ void gemm_phase(PG8_LAS unsigned char* lds, const Gemm g, const Sched& S, const Epi& E) {
    const int tid = threadIdx.x, wid = __builtin_amdgcn_readfirstlane(tid >> 6), lane = tid & 63, wr = wid >> 2, wc = wid & 3, fr = lane & 15, fq = lane >> 4;
    const int K = g.K, nt = K / BK;
    unsigned voffA[2], voffB[2];
#pragma unroll
    for (int i = 0; i < 2; ++i) { int R, C; stage_rc(tid * 16 + i * 8192, R, C); const int Rb = Epi::PERM ? ((R & ~31) + perm32(R & 31)) : R;
        voffA[i] = (unsigned)(R * K + C) * 2u; voffB[i] = (unsigned)(Rb * K + C) * 2u; }
    const size_t kstep = (size_t)(BK * 2);
    const size_t hstep = (size_t)HALF * K * 2;
    const size_t tstep = 2 * hstep;
    const unsigned ldsw = (unsigned)wid * 1024u;
    const int aoff = lds_byte(wr * 64 + fr, fq * 8), boff = lds_byte(wc * 32 + fr, fq * 8);
#define PG8_SA(b, h) (((b) * 2 + (h)) * HTB)
#define PG8_SB(b, h) ((4 + (b) * 2 + (h)) * HTB)
#define PG8_STAGE(bufoff, gbase, voff) do { _Pragma("unroll") for (int _i = 0; _i < 2; ++_i) \
        __builtin_amdgcn_global_load_lds((const unsigned*)((const char*)(gbase) + (voff)[_i]), (PG8_LAS unsigned*)(lds + (bufoff) + ldsw + _i * 8192), 16, 0, 0); } while (0)
#define PG8_LDA(dst, b, h) do { _Pragma("unroll") for (int m = 0; m < 4; ++m) _Pragma("unroll") for (int k = 0; k < 2; ++k) dst[m][k] = *(const PG8_LAS bf16x8*)(lds + PG8_SA(b, h) + aoff + m * 2048 + k * 1024); } while (0)
#define PG8_LDB(dst, b, h) do { _Pragma("unroll") for (int n = 0; n < 2; ++n) _Pragma("unroll") for (int k = 0; k < 2; ++k) dst[n][k] = *(const PG8_LAS bf16x8*)(lds + PG8_SB(b, h) + boff + n * 2048 + k * 1024); } while (0)
#define PG8_MMA(ai, bj, At, Bt) do { __builtin_amdgcn_s_setprio(1); _Pragma("unroll") for (int m = 0; m < 4; ++m) _Pragma("unroll") for (int n = 0; n < 2; ++n) _Pragma("unroll") for (int k = 0; k < 2; ++k) \
        acc[ai][bj][m][n] = __builtin_amdgcn_mfma_f32_16x16x32_bf16(Bt[n][k], At[m][k], acc[ai][bj][m][n], 0, 0, 0); __builtin_amdgcn_s_setprio(0); } while (0)
#define PG8_WAIT_V(n) asm volatile("s_waitcnt vmcnt(" #n ")" ::: "memory")
#define PG8_WAIT_L(n) asm volatile("s_waitcnt lgkmcnt(" #n ")" ::: "memory")
#define PG8_BAR __builtin_amdgcn_s_barrier()
#define PG8_SCHED __builtin_amdgcn_sched_barrier(0)
    Unit cur, nxt; int ui = 0;
    if (!S.next(0, cur)) return;
    f32x4 acc[2][2][4][2];
#pragma unroll
    for (int a = 0; a < 2; ++a)
#pragma unroll
        for (int b = 0; b < 2; ++b)
#pragma unroll
            for (int m = 0; m < 4; ++m)
#pragma unroll
                for (int n = 0; n < 2; ++n) acc[a][b][m][n] = (f32x4){0.f, 0.f, 0.f, 0.f};
    bf16x8 At[4][2], B0[2][2], B1[2][2];
    const char* cA = (const char*)g.A + (size_t)cur.pm * tstep; const char* cB = (const char*)g.Bt + (size_t)cur.pn * tstep;
    S.a_ready(cur);
    if constexpr (SP2) {
        PG8_STAGE(PG8_SB(0, 0), cB, voffB); PG8_STAGE(PG8_SB(0, 1), cB + hstep, voffB); PG8_STAGE(PG8_SA(0, 0), cA, voffA); PG8_STAGE(PG8_SA(0, 1), cA + hstep, voffA);
        if (wr == 1) PG8_BAR;
        PG8_WAIT_V(2); PG8_BAR;
        PG8_STAGE(PG8_SB(1, 0), cB + kstep, voffB); PG8_STAGE(PG8_SA(1, 0), cA + kstep, voffA); PG8_STAGE(PG8_SB(1, 1), cB + hstep + kstep, voffB);
        PG8_WAIT_V(6); PG8_BAR;
    } else {
        PG8_STAGE(PG8_SB(0, 0), cB, voffB); PG8_STAGE(PG8_SA(0, 0), cA, voffA); PG8_STAGE(PG8_SB(0, 1), cB + hstep, voffB); PG8_STAGE(PG8_SA(0, 1), cA + hstep, voffA);
        if (wr == 1) PG8_BAR;
        PG8_WAIT_V(4); PG8_BAR;
        PG8_STAGE(PG8_SB(1, 0), cB + kstep, voffB); PG8_STAGE(PG8_SA(1, 0), cA + kstep, voffA); PG8_STAGE(PG8_SB(1, 1), cB + hstep + kstep, voffB);
        PG8_WAIT_V(6); PG8_BAR;
    }
    for (;;) {
        const bool has_next = S.next(ui + 1, nxt);
        const char* nA = has_next ? (const char*)g.A + (size_t)nxt.pm * tstep : cA; const char* nB = has_next ? (const char*)g.Bt + (size_t)nxt.pn * tstep : cB;
        for (int t = 0; t < nt; t += 2) {
            const bool last = (t == nt - 2);
            const char* a1 = cA + (size_t)(t + 1) * kstep;
            const char* a2 = last ? nA : cA + (size_t)(t + 2) * kstep; const char* b2 = last ? nB : cB + (size_t)(t + 2) * kstep;
            const char* a3 = a2 + kstep; const char* b3 = b2 + kstep;
            if (last && has_next) S.a_ready(nxt);
            if constexpr (SP2) {
            PG8_LDB(B0, 0, 0); PG8_LDB(B1, 0, 1); PG8_SCHED; PG8_LDA(At, 0, 0); PG8_STAGE(PG8_SA(1, 1), a1 + hstep, voffA);
            PG8_WAIT_V(8); PG8_WAIT_L(0); PG8_BAR; PG8_MMA(0, 0, At, B0); PG8_MMA(0, 1, At, B1); PG8_BAR; PG8_SCHED;
            PG8_LDA(At, 0, 1); PG8_STAGE(PG8_SB(0, 0), b2, voffB); PG8_STAGE(PG8_SB(0, 1), b2 + hstep, voffB); PG8_STAGE(PG8_SA(0, 0), a2, voffA);
            PG8_WAIT_V(8); PG8_WAIT_L(0); PG8_BAR; PG8_MMA(1, 0, At, B0); PG8_MMA(1, 1, At, B1); PG8_BAR; PG8_SCHED;
            PG8_LDB(B0, 1, 0); PG8_LDB(B1, 1, 1); PG8_SCHED; PG8_LDA(At, 1, 0); PG8_STAGE(PG8_SA(0, 1), a2 + hstep, voffA);
            PG8_WAIT_V(8); PG8_WAIT_L(0); PG8_BAR; PG8_MMA(0, 0, At, B0); PG8_MMA(0, 1, At, B1); PG8_BAR; PG8_SCHED;
            PG8_LDA(At, 1, 1); PG8_STAGE(PG8_SB(1, 0), b3, voffB); PG8_STAGE(PG8_SB(1, 1), b3 + hstep, voffB); PG8_STAGE(PG8_SA(1, 0), a3, voffA);
            PG8_WAIT_V(8); PG8_WAIT_L(0); PG8_BAR; PG8_MMA(1, 0, At, B0); PG8_MMA(1, 1, At, B1); PG8_BAR; PG8_SCHED;
            } else {
            PG8_LDB(B0, 0, 0); PG8_SCHED; PG8_LDA(At, 0, 0); PG8_STAGE(PG8_SA(1, 1), a1 + hstep, voffA);
            PG8_WAIT_L(8); PG8_BAR; PG8_WAIT_L(0); PG8_MMA(0, 0, At, B0); PG8_BAR; PG8_SCHED;
            PG8_LDB(B1, 0, 1); PG8_STAGE(PG8_SB(0, 0), b2, voffB);
            PG8_BAR; PG8_WAIT_L(0); PG8_MMA(0, 1, At, B1); PG8_BAR;
            PG8_LDA(At, 0, 1); PG8_STAGE(PG8_SA(0, 0), a2, voffA);
            PG8_BAR; PG8_WAIT_L(0); PG8_MMA(1, 0, At, B0); PG8_BAR; PG8_SCHED;
            PG8_STAGE(PG8_SB(0, 1), b2 + hstep, voffB);
            PG8_WAIT_V(6); PG8_BAR; PG8_MMA(1, 1, At, B1); PG8_BAR;
            PG8_LDB(B0, 1, 0); PG8_SCHED; PG8_LDA(At, 1, 0); PG8_STAGE(PG8_SA(0, 1), a2 + hstep, voffA);
            PG8_WAIT_L(8); PG8_BAR; PG8_WAIT_L(0); PG8_MMA(0, 0, At, B0); PG8_BAR; PG8_SCHED;
            PG8_LDB(B1, 1, 1); PG8_STAGE(PG8_SB(1, 0), b3, voffB);
            PG8_BAR; PG8_WAIT_L(0); PG8_MMA(0, 1, At, B1); PG8_BAR;
            PG8_LDA(At, 1, 1); PG8_STAGE(PG8_SA(1, 0), a3, voffA);
            PG8_BAR; PG8_WAIT_L(0); PG8_MMA(1, 0, At, B0); PG8_BAR; PG8_SCHED;
            PG8_STAGE(PG8_SB(1, 1), b3 + hstep, voffB);
            PG8_WAIT_V(6); PG8_BAR; PG8_MMA(1, 1, At, B1); PG8_BAR;
            }
        }
        if constexpr (ALIGN_EPI) { if (wr == 0) PG8_BAR; }
        if constexpr (!Epi::AFTER_DRAIN) { E(acc, cur, wr, wc, fr, fq); S.done(cur); }
        if (!has_next) break;
#pragma unroll
        for (int a = 0; a < 2; ++a)
#pragma unroll
            for (int b = 0; b < 2; ++b)
#pragma unroll
                for (int m = 0; m < 4; ++m)
#pragma unroll
                    for (int n = 0; n < 2; ++n) acc[a][b][m][n] = (f32x4){0.f, 0.f, 0.f, 0.f};
        cur = nxt; cA = nA; cB = nB; ++ui;
        if constexpr (ALIGN_EPI) { if (wr == 1) PG8_BAR; }
    }
    PG8_WAIT_V(0);
    if constexpr (!ALIGN_EPI) { if (wr == 0) PG8_BAR; }
    PG8_BAR;
    if constexpr (Epi::AFTER_DRAIN) { E.fused(acc, cur, wr, wc, fr, fq, lds, wid, lane); S.done(cur); }
#undef PG8_SA
#undef PG8_SB
#undef PG8_STAGE
#undef PG8_LDA
#undef PG8_LDB
#undef PG8_MMA
#undef PG8_WAIT_V
#undef PG8_WAIT_L
#undef PG8_BAR
#undef PG8_SCHED
}
}
constexpr int NWAVES = 8;
constexpr int N_LAUNCHES = MK_N_LAUNCHES;
constexpr int PER_PHASE = 11;
constexpr int SEQ = 2048, DM = 2048, DFF = 8192, NPROJ_IN = 11312, NPROJ_PAD = 11520;
constexpr float RMS_EPS = 1e-6f;
constexpr size_t MiB = 1u << 20;
constexpr size_t BLK = (size_t)MROWS * 256;
constexpr size_t WS_CTL = 0, CTL_ZERO_BYTES = 1 * MiB;
constexpr size_t WS_GATES = 1 * MiB, WS_WBM = 5 * MiB, WS_WBD = 9 * MiB, WS_WOUT = 13 * MiB, WS_PROJ = 21 * MiB, WS_WIN = 373 * MiB, WS_XN = 418 * MiB;
constexpr size_t WS_DQ = 373 * MiB, WS_DK = 405 * MiB, WS_DV = 437 * MiB;
constexpr size_t WS_HM = 117 * MiB, WS_ODF = 181 * MiB, WS_ODB = 469 * MiB;
constexpr size_t WS_YM = 21 * MiB, WS_YD = 53 * MiB, WS_MIX = 373 * MiB;
constexpr size_t WS_XN2 = 437 * MiB, WS_W1T = 21 * MiB, WS_W2T = 53 * MiB, WS_HFF = 117 * MiB, WS_END = 501 * MiB;
constexpr int CW_BAR = 4096;
constexpr int LDS_BYTES = 163840;
constexpr int MISC_OFF = LDS_BYTES - 256;

#define GAS __attribute__((address_space(1)))
#define LAS __attribute__((address_space(3)))
typedef unsigned short bf16;
typedef unsigned v4u __attribute__((ext_vector_type(4)));
typedef unsigned v2u __attribute__((ext_vector_type(2)));
typedef float f32x4 __attribute__((ext_vector_type(4)));
typedef short bf16x8 __attribute__((ext_vector_type(8)));
typedef GAS unsigned gu32;
#define RLX_AGENT __ATOMIC_RELAXED, __HIP_MEMORY_SCOPE_AGENT
#define LDS_WAIT() asm volatile("s_waitcnt lgkmcnt(0)" ::: "memory")
#define VM_WAIT() asm volatile("s_waitcnt vmcnt(0)" ::: "memory")
__device__ __forceinline__ unsigned f2bf(float f) { unsigned u = __builtin_bit_cast(unsigned, f); return (u + 0x7fffu + ((u >> 16) & 1u)) >> 16; }
__device__ __forceinline__ unsigned pk2(float lo, float hi) { return f2bf(lo) | (f2bf(hi) << 16); }
__device__ __forceinline__ float bflo(unsigned w) { return __uint_as_float(w << 16); }
__device__ __forceinline__ float bfhi(unsigned w) { return __uint_as_float(w & 0xffff0000u); }
__device__ __forceinline__ float bfel(const v4u& v, int i) { const unsigned w = v[i >> 1]; return (i & 1) ? bfhi(w) : bflo(w); }
#define MFMA16(a, b, c) __builtin_amdgcn_mfma_f32_16x16x32_bf16((a), (b), (c), 0, 0, 0)
__device__ __forceinline__ bf16x8 ldfrag(const LAS unsigned char* p) { return *(const LAS bf16x8*)p; }
__device__ __forceinline__ void st8(LAS unsigned char* p, const f32x4& v) { v2u w; w.x = pk2(v[0], v[1]); w.y = pk2(v[2], v[3]); *(LAS v2u*)p = w; }
#define XB_TMO      128
#define XB_XCNT(j)  (256  + 64 * (j))
#define XB_XSUB(j)  (1280 + 64 * (j))
#define XB_XGEN(j)  (2304 + 64 * (j))
#define XB_TOP      3328
#define XB_TOPGEN   3392
#define XCD_BAR_WORDS 3456
#define XB_SPIN_CAP (1u << 18)

__device__ __forceinline__ unsigned xb_ld(unsigned* p)              { return __hip_atomic_load(p, __ATOMIC_RELAXED, __HIP_MEMORY_SCOPE_AGENT); }
__device__ __forceinline__ unsigned xb_add(unsigned* p, unsigned v) { return __hip_atomic_fetch_add(p, v, __ATOMIC_RELAXED, __HIP_MEMORY_SCOPE_AGENT); }
__device__ __forceinline__ unsigned xb_xcc_id() { return (unsigned)__builtin_amdgcn_s_getreg((3 << 11) | 20) & 0xFu; }
#define XB_SPIN(cond, bar) do { unsigned _sp = 0; while (cond) { __builtin_amdgcn_s_sleep(1); \
    if ((++_sp & 255u) == 0u) { if (xb_ld(&(bar)[XB_TMO])) break; if (_sp > XB_SPIN_CAP) { atomicAdd(&(bar)[XB_TMO], 1u); break; } } } } while (0)

struct XcdBarrier {
    unsigned* bar; unsigned x;
    volatile LAS unsigned* st;
};

__device__ __forceinline__ XcdBarrier xcd_barrier_post(unsigned* bar, volatile LAS unsigned* st) {
    XcdBarrier b; b.bar = bar; b.x = xb_xcc_id(); b.st = st;
    if (threadIdx.x == 0) (void)xb_add(&bar[XB_XCNT(b.x)], 1u);
    return b;
}
__device__ __forceinline__ void xcd_barrier_complete(unsigned* bar, unsigned x, unsigned& nloc, unsigned& nx) {
    const unsigned G = gridDim.x * gridDim.y * gridDim.z;
    unsigned sum, cnt, mine, sp = 0u;
    for (;;) {
        sum = 0u; cnt = 0u; mine = 0u;
#pragma unroll
        for (unsigned j = 0; j < 16; ++j) { const unsigned c = xb_ld(&bar[XB_XCNT(j)]); sum += c; cnt += (c > 0u) ? 1u : 0u; mine = (j == x) ? c : mine; }
        if (sum == G) break;
        __builtin_amdgcn_s_sleep(1);
        if ((++sp & 255u) == 0u) { if (xb_ld(&bar[XB_TMO])) break; if (sp > XB_SPIN_CAP) { atomicAdd(&bar[XB_TMO], 1u); break; } }
    }
    nloc = mine > 0u ? mine : 1u; nx = cnt > 0u ? cnt : 1u;
}

__device__ __forceinline__ void xcd_barrier(const XcdBarrier& b) {
    asm volatile("s_waitcnt vmcnt(0)" ::: "memory");
    __syncthreads();
    if (threadIdx.x == 0) {
        unsigned* bar = b.bar;
        __builtin_amdgcn_s_waitcnt(0);
        unsigned nloc = b.st[0], nx = b.st[1];
        if (nloc == 0u) { xcd_barrier_complete(bar, b.x, nloc, nx); b.st[0] = nloc; b.st[1] = nx; }
        const unsigned old = xb_add(&bar[XB_XSUB(b.x)], 1u);
        const unsigned gen = old / nloc;
        if (old + 1u == (gen + 1u) * nloc) {
            __builtin_amdgcn_fence(__ATOMIC_RELEASE, "agent");
            asm volatile("s_waitcnt vmcnt(0)" ::: "memory");
            const unsigned og = xb_add(&bar[XB_TOP], 1u);
            const unsigned tg = og / nx;
            if (og + 1u == (tg + 1u) * nx) xb_add(&bar[XB_TOPGEN], 1u);
            else XB_SPIN(xb_ld(&bar[XB_TOPGEN]) == tg, bar);
            __builtin_amdgcn_fence(__ATOMIC_ACQUIRE, "agent");
            xb_add(&bar[XB_XGEN(b.x)], 1u);
            asm volatile("s_waitcnt vmcnt(0)" ::: "memory");
        } else {
            XB_SPIN(xb_ld(&bar[XB_XGEN(b.x)]) == gen, bar);
            __builtin_amdgcn_fence(__ATOMIC_ACQUIRE, "agent");
            asm volatile("s_waitcnt vmcnt(0)" ::: "memory");
        }
    }
    __syncthreads();
}
struct Frame {
    LAS unsigned char* lds;
    volatile LAS unsigned* MISC;
    gu32* ctl;
    int tid, lane, wave;
    int vcu, G;
    float* out;
    unsigned char* ws;
};
__device__ __forceinline__ float wave_sum(float v) {
#pragma unroll
    for (int o = 1; o < 64; o <<= 1) v += __shfl_xor(v, o);
    return v;
}
__device__ __forceinline__ int win_map(int n) {
    if (n < 3072) return n;
    if (n < 3088) return 11264 + (n - 3072);
    if (n < 7184) return n - 16;
    if (n < 7216) return 11264 + 16 + (n - 7184);
    return n - 48;
}
__device__ __forceinline__ void tr_item(const float* W, int K, int N, bf16* WT, LAS float* scr, int item, int lane, bool remap) {
    const int nblk = (N + 31) / 32, kb = item / nblk, nb = item % nblk, k0 = 64 * kb, n0 = 32 * nb;
    const int nn = n0 + (lane & 31); const bool okc = nn < N;
#pragma unroll 8
    for (int i = 0; i < 32; ++i) { const int kk = 2 * i + (lane >> 5); scr[kk * 33 + (lane & 31)] = okc ? W[(size_t)(k0 + kk) * N + nn] : 0.f; }
    LDS_WAIT(); asm volatile("" ::: "memory");
    const int c = lane & 7;
#pragma unroll
    for (int j = 0; j < 4; ++j) { const int n = (lane >> 3) + 8 * j; const LAS float* s = scr + (8 * c) * 33 + n;
        v4u o; o.x = pk2(s[0 * 33], s[1 * 33]); o.y = pk2(s[2 * 33], s[3 * 33]); o.z = pk2(s[4 * 33], s[5 * 33]); o.w = pk2(s[6 * 33], s[7 * 33]);
        if (n0 + n < N) { const int row = remap ? win_map(n0 + n) : (n0 + n); *(v4u*)(WT + (size_t)row * K + k0 + 8 * c) = o; } }
    LDS_WAIT(); asm volatile("" ::: "memory");
}
__device__ __forceinline__ void rms_row_bf16(int lane, const float* xrow, const float* g, bf16* orow) {
    const f32x4* xr = (const f32x4*)xrow + lane; const f32x4* gr = (const f32x4*)g + lane;
    f32x4 v[8]; float s = 0.f;
#pragma unroll
    for (int j = 0; j < 8; ++j) { v[j] = xr[64 * j]; s += (v[j].x * v[j].x + v[j].y * v[j].y) + (v[j].z * v[j].z + v[j].w * v[j].w); }
    const float r = 1.0f / sqrtf(wave_sum(s) * (1.f / 2048.f) + RMS_EPS);
    v2u* o8 = (v2u*)orow + lane;
#pragma unroll
    for (int j = 0; j < 8; ++j) { const f32x4 gg = gr[64 * j]; v2u w; w.x = pk2(v[j].x * r * gg.x, v[j].y * r * gg.y); w.y = pk2(v[j].z * r * gg.z, v[j].w * r * gg.w); o8[64 * j] = w; }
}
__device__ __forceinline__ void rms_row_f32(int lane, const float* xrow, const float* g, float* orow) {
    const f32x4* xr = (const f32x4*)xrow + lane; const f32x4* gr = (const f32x4*)g + lane;
    f32x4 v[8]; float s = 0.f;
#pragma unroll
    for (int j = 0; j < 8; ++j) { v[j] = xr[64 * j]; s += (v[j].x * v[j].x + v[j].y * v[j].y) + (v[j].z * v[j].z + v[j].w * v[j].w); }
    const float r = 1.0f / sqrtf(wave_sum(s) * (1.f / 2048.f) + RMS_EPS);
    f32x4* o = (f32x4*)orow + lane;
#pragma unroll
    for (int j = 0; j < 8; ++j) { const f32x4 gg = gr[64 * j]; o[64 * j] = (v[j] * r) * gg; }
}

__device__ __forceinline__ void p0_prologue(Frame& F, const float* x, const float* n1g, const float* w_in, const float* w_bm, const float* w_bd, const float* w_out) {
    LAS float* scr = (LAS float*)(F.lds + F.wave * 16384);
    const int gw = F.vcu * NWAVES + F.wave, NGW = F.G * NWAVES;
    bf16* WIN = (bf16*)(F.ws + WS_WIN); bf16* WBM = (bf16*)(F.ws + WS_WBM); bf16* WBD = (bf16*)(F.ws + WS_WBD); bf16* WOUT = (bf16*)(F.ws + WS_WOUT); bf16* XN = (bf16*)(F.ws + WS_XN);
    constexpr int I_IN = (DM / 64) * ((NPROJ_IN + 31) / 32), I_B = (1024 / 64) * (DM / 32), I_O = (DM / 64) * (DM / 32);
    constexpr int NITEMS = I_IN + 2 * I_B + I_O;
    for (int it = gw; it < NITEMS; it += NGW) {
        int r = it;
        if (r < I_IN) { tr_item(w_in, DM, NPROJ_IN, WIN, scr, r, F.lane, true); continue; } r -= I_IN;
        if (r < I_B) { tr_item(w_bm, 1024, DM, WBM, scr, r, F.lane, false); continue; } r -= I_B;
        if (r < I_B) { tr_item(w_bd, 1024, DM, WBD, scr, r, F.lane, false); continue; } r -= I_B;
        tr_item(w_out, DM, DM, WOUT, scr, r, F.lane, false);
    }
    { v4u* z = (v4u*)(WIN + (size_t)(11264 + 48) * DM); const int nz = (NPROJ_PAD - 11264 - 48) * DM / 8;
      for (int i = gw * 64 + F.lane; i < nz; i += NGW * 64) z[i] = (v4u){0u, 0u, 0u, 0u}; }
    for (int m = gw; m < MROWS; m += NGW) rms_row_bf16(F.lane, x + (size_t)m * DM, n1g, XN + (size_t)m * DM);
}

__device__ __forceinline__ void p2_conv(Frame& F, const float* convw) {
    const int gw = F.vcu * NWAVES + F.wave, NGW = F.G * NWAVES, lane = F.lane;
    const bf16* PROJ = (const bf16*)(F.ws + WS_PROJ);
    bf16* DQ = (bf16*)(F.ws + WS_DQ); bf16* DK = (bf16*)(F.ws + WS_DK); bf16* DV = (bf16*)(F.ws + WS_DV);
    constexpr int NIT = 24 * (MROWS / 8);
    for (int it = gw; it < NIT; it += NGW) {
        const int gI = it % 24, tb8 = it / 24, m0 = tb8 * 8, b = m0 >> 11, t0 = m0 & 2047;
        const int c0 = gI * 128;
        const bf16* src = PROJ + (size_t)(12 + (c0 >> 8)) * BLK + (c0 & 255) + 2 * lane;
        float x0[12], x1[12];
#pragma unroll
        for (int i = 0; i < 12; ++i) { const int tp = t0 - 2 + i; unsigned wv = 0u;
            if (tp >= 0 && tp < SEQ) wv = *(const unsigned*)(src + (size_t)(b * SEQ + tp) * 256);
            x0[i] = bflo(wv); x1[i] = bfhi(wv); }
        float cw0[5], cw1[5];
#pragma unroll
        for (int i = 0; i < 5; ++i) { const float* cp = convw + (size_t)i * 3072 + c0 + 2 * lane; cw0[i] = cp[0]; cw1[i] = cp[1]; }
        bf16* dst = (gI < 8 ? DQ : (gI < 16 ? DK : DV)) + (size_t)m0 * 1024 + (c0 & 1023) + 2 * lane;
#pragma unroll
        for (int o = 0; o < 8; ++o) {
            float y0 = 0.f, y1 = 0.f;
#pragma unroll
            for (int i = 0; i < 5; ++i) { y0 += cw0[i] * x0[o + i]; y1 += cw1[i] * x1[o + i]; }
            float s0 = y0 / (1.0f + expf(-y0)), s1 = y1 / (1.0f + expf(-y1));
            if (gI < 16) { const float ss = wave_sum(s0 * s0 + s1 * s1); float r = 1.0f / sqrtf(ss + 1e-6f); if (gI < 8) r *= 0.08838834764831845f; s0 *= r; s1 *= r; }
            *(unsigned*)(dst + (size_t)o * 1024) = pk2(s0, s1);
        }
    }
}

constexpr int ML_QP = 0, ML_KS = 25600, ML_VS = 43008, ML_KWT = 60416, ML_VC = 78848, ML_VC_BYTES = 57600, ML_VEC = 136448;
constexpr float ML_SCALE = 0.08838834764831845f;
__device__ __forceinline__ void mlstm_unit(Frame& F, int unit, const float* m_ib, const float* m_fb) {
    const int tid = F.tid, lane = F.lane, w = F.wave, fr = lane & 15, fq = lane >> 4;
    const int half = unit & 1, dir = (unit >> 1) & 1, h = (unit >> 2) & 3, b = unit >> 4;
    LAS unsigned char* L = F.lds;
    LAS float* vec = (LAS float*)(L + ML_VEC);
    for (int i = tid; i < ML_VC_BYTES / 16; i += 512) ((LAS v4u*)(L + ML_VC))[i] = (v4u){0u, 0u, 0u, 0u};
    __syncthreads();
    if (tid < 32) ((LAS unsigned*)(L + ML_VC + 128 * 400))[tid] = 0x3f803f80u;
    f32x4 accS[9];
#pragma unroll
    for (int t = 0; t < 9; ++t) accS[t] = (f32x4){0.f, 0.f, 0.f, 0.f};
    float m_st = -1e30f;
    const bf16* PROJ = (const bf16*)(F.ws + WS_PROJ);
    const float* GATES = (const float*)(F.ws + WS_GATES);
    const bf16* Qg = PROJ + (size_t)(h >> 1) * BLK + (h & 1) * 128;
    const bf16* Kg = PROJ + (size_t)(2 + (h >> 1)) * BLK + (h & 1) * 128;
    const bf16* Vg = PROJ + (size_t)(4 + h) * BLK + half * 128;
    bf16* Hout = (bf16*)(F.ws + WS_HM) + (size_t)dir * MROWS * 1024 + h * 256 + half * 128;
    const float ib = m_ib[dir * 4 + h], fb = m_fb[dir * 4 + h];
    const int sr = tid >> 4, sc = tid & 15;
    for (int j = 0; j < 32; ++j) {
        v4u q[2], k[2], v[2];
#pragma unroll
        for (int p = 0; p < 2; ++p) { const int tt = j * 64 + sr + 32 * p, t = dir ? (SEQ - 1 - tt) : tt; const size_t mrow = (size_t)(b * SEQ + t);
            q[p] = *(const v4u*)(Qg + mrow * 256 + sc * 8); k[p] = *(const v4u*)(Kg + mrow * 256 + sc * 8); v[p] = *(const v4u*)(Vg + mrow * 256 + sc * 8); }
        if (w == 0) {
            const int tt = j * 64 + lane, t = dir ? (SEQ - 1 - tt) : tt; const size_t mrow = (size_t)(b * SEQ + t);
            const float ig = GATES[mrow * 64 + dir * 4 + h] + ib;
            const float fp = GATES[mrow * 64 + 8 + dir * 4 + h] + fb;
            const float lf = fp >= 0.f ? -log1pf(expf(-fp)) : fp - log1pf(expf(fp));
            float bc = lf;
#pragma unroll
            for (int o = 1; o < 64; o <<= 1) { const float t2 = __shfl_up(bc, o); if (lane >= o) bc += t2; }
            const float a = ig - bc;
            float am = a;
#pragma unroll
            for (int o = 1; o < 64; o <<= 1) { const float t2 = __shfl_up(am, o); if (lane >= o) am = fmaxf(am, t2); }
            const float Ml = fmaxf(m_st, am);
            const float M63 = __shfl(Ml, 63), bl = __shfl(bc, 63);
            vec[lane] = a; vec[64 + lane] = Ml; vec[128 + lane] = expf(-(bc + Ml)); vec[192 + lane] = expf(m_st - Ml) * ML_SCALE; vec[256 + lane] = expf(a - M63);
            if (lane == 0) vec[320] = expf(m_st - M63);
            m_st = bl + M63;
        }
#pragma unroll
        for (int p = 0; p < 2; ++p) { const int r = sr + 32 * p;
            *(LAS v4u*)(L + ML_QP + r * 400 + 128 + sc * 16) = q[p]; *(LAS v4u*)(L + ML_KS + r * 272 + sc * 16) = k[p]; *(LAS v4u*)(L + ML_VS + r * 272 + sc * 16) = v[p]; }
        __syncthreads();
        {
            const int s = tid & 63; const float ws = vec[256 + s];
#pragma unroll
            for (int p = 0; p < 2; ++p) { const int c = (tid >> 6) + 8 * p;
                const v4u kk = *(const LAS v4u*)(L + ML_KS + s * 272 + c * 16), vv = *(const LAS v4u*)(L + ML_VS + s * 272 + c * 16);
#pragma unroll
                for (int i = 0; i < 8; ++i) {
                    *(LAS unsigned short*)(L + ML_KWT + (c * 8 + i) * 144 + s * 2) = (unsigned short)f2bf(bfel(kk, i) * ws);
                    const unsigned wv = vv[i >> 1]; *(LAS unsigned short*)(L + ML_VC + (c * 8 + i) * 400 + s * 2) = (unsigned short)((i & 1) ? (wv >> 16) : (wv & 0xffffu)); } }
        }
        __syncthreads();
        {
            const int lt = w & 3, l = lt * 16 + fr; const float Ml = vec[64 + l];
#pragma unroll
            for (int s2 = 0; s2 < 2; ++s2) { const int st = (w >> 2) * 2 + s2;
                f32x4 acc = (f32x4){0.f, 0.f, 0.f, 0.f};
                if (st <= lt) {
#pragma unroll
                    for (int ks = 0; ks < 4; ++ks) acc = MFMA16(ldfrag(L + ML_KS + (st * 16 + fr) * 272 + ks * 64 + fq * 16), ldfrag(L + ML_QP + l * 400 + 128 + ks * 64 + fq * 16), acc); }
                f32x4 pv;
#pragma unroll
                for (int r = 0; r < 4; ++r) { const int s = st * 16 + 4 * fq + r; pv[r] = (s <= l) ? acc[r] * ML_SCALE * expf(fminf(vec[s] - Ml, 0.f)) : 0.f; }
                st8(L + ML_QP + l * 400 + (st * 16 + 4 * fq) * 2, pv); }
        }
        __syncthreads();
        {
            const int lt = w & 3, dq = w >> 2, l = lt * 16 + fr;
            f32x4 aPV[5], aQC[5];
#pragma unroll
            for (int t = 0; t < 5; ++t) { aPV[t] = (f32x4){0.f, 0.f, 0.f, 0.f}; aQC[t] = (f32x4){0.f, 0.f, 0.f, 0.f}; }
            bf16x8 bq[6];
#pragma unroll
            for (int ks = 0; ks < 6; ++ks) bq[ks] = ldfrag(L + ML_QP + l * 400 + ks * 64 + fq * 16);
#pragma unroll
            for (int t = 0; t < 5; ++t) { const int tile = (t < 4) ? (dq * 4 + t) : 8;
#pragma unroll
                for (int ks = 0; ks < 6; ++ks) { const bf16x8 a = ldfrag(L + ML_VC + (tile * 16 + fr) * 400 + ks * 64 + fq * 16);
                    if (ks < 2) aPV[t] = MFMA16(a, bq[ks], aPV[t]); else aQC[t] = MFMA16(a, bq[ks], aQC[t]); } }
            const float wi = vec[192 + l], eml = vec[128 + l];
            float den = aPV[4][0] + wi * aQC[4][0];
            den = __shfl(den, fr);
            const float inv = 1.0f / fmaxf(fabsf(den), eml);
            const int tt = j * 64 + l, t = dir ? (SEQ - 1 - tt) : tt; const size_t mrow = (size_t)(b * SEQ + t);
#pragma unroll
            for (int t4 = 0; t4 < 4; ++t4) { const f32x4 nv = (aPV[t4] + aQC[t4] * wi) * inv; v2u o; o.x = pk2(nv[0], nv[1]); o.y = pk2(nv[2], nv[3]);
                *(v2u*)(Hout + mrow * 1024 + (dq * 4 + t4) * 16 + 4 * fq) = o; }
        }
        {
            const float decay = vec[320];
            bf16x8 ak[2];
#pragma unroll
            for (int ks = 0; ks < 2; ++ks) ak[ks] = ldfrag(L + ML_KWT + (w * 16 + fr) * 144 + ks * 64 + fq * 16);
#pragma unroll
            for (int t = 0; t < 9; ++t) { accS[t] = accS[t] * decay;
#pragma unroll
                for (int ks = 0; ks < 2; ++ks) accS[t] = MFMA16(ak[ks], ldfrag(L + ML_VC + (t * 16 + fr) * 400 + ks * 64 + fq * 16), accS[t]); }
        }
        __syncthreads();
#pragma unroll
        for (int t = 0; t < 9; ++t) st8(L + ML_VC + (t * 16 + fr) * 400 + 128 + (w * 16 + 4 * fq) * 2, accS[t]);
    }
    __syncthreads();
}

constexpr int DN_ST = 0, DN_QS = 34816, DN_AT = 52224, DN_KDT = 61440, DN_VBT = 79872, DN_KBT = 98304, DN_KS = 116736, DN_VS = 134144, DN_VEC = 151552;
constexpr int DN_PA = DN_KS, DN_PT = DN_KS + 9216, DN_XA = DN_KS + 18432, DN_WL = DN_KBT;
__device__ __forceinline__ void delta_unit(Frame& F, int unit, const float* d_alog, const float* d_dtb) {
    const int tid = F.tid, lane = F.lane, w = F.wave, fr = lane & 15, fq = lane >> 4;
    const int dir = unit & 1, h = (unit >> 1) & 7, b = unit >> 4;
    LAS unsigned char* L = F.lds;
    LAS float* vec = (LAS float*)(L + DN_VEC);
    for (int i = tid; i < 34816 / 16; i += 512) ((LAS v4u*)(L + DN_ST))[i] = (v4u){0u, 0u, 0u, 0u};
    f32x4 accS[8];
#pragma unroll
    for (int t = 0; t < 8; ++t) accS[t] = (f32x4){0.f, 0.f, 0.f, 0.f};
    const float* GATES = (const float*)(F.ws + WS_GATES);
    const bf16* Qg = (const bf16*)(F.ws + WS_DQ) + h * 128; const bf16* Kg = (const bf16*)(F.ws + WS_DK) + h * 128; const bf16* Vg = (const bf16*)(F.ws + WS_DV) + h * 128;
    bf16* Oout = (bf16*)(F.ws + (dir ? WS_ODB : WS_ODF)) + h * 128;
    const float Aexp = expf(d_alog[dir * 8 + h]), dtb = d_dtb[dir * 8 + h];
    const int sr = tid >> 4, sc = tid & 15;
    const int tb = w & 3, ta0 = (w >> 2) * 2;
    for (int j = 0; j < 32; ++j) {
        v4u q[2], k[2], v[2];
#pragma unroll
        for (int p = 0; p < 2; ++p) { const int tt = j * 64 + sr + 32 * p, t = dir ? (SEQ - 1 - tt) : tt; const size_t mrow = (size_t)(b * SEQ + t);
            q[p] = *(const v4u*)(Qg + mrow * 1024 + sc * 8); k[p] = *(const v4u*)(Kg + mrow * 1024 + sc * 8); v[p] = *(const v4u*)(Vg + mrow * 1024 + sc * 8); }
        if (w == 0) {
            const int tt = j * 64 + lane, t = dir ? (SEQ - 1 - tt) : tt; const size_t mrow = (size_t)(b * SEQ + t);
            const float ap = GATES[mrow * 64 + 16 + dir * 8 + h] + dtb, bp = GATES[mrow * 64 + 32 + dir * 8 + h];
            const float sp = ap > 0.f ? ap + log1pf(expf(-ap)) : log1pf(expf(ap));
            const float g = -Aexp * sp, beta = 1.0f / (1.0f + expf(-bp));
            float gc = g;
#pragma unroll
            for (int o = 1; o < 64; o <<= 1) { const float t2 = __shfl_up(gc, o); if (lane >= o) gc += t2; }
            const float gl = __shfl(gc, 63);
            vec[lane] = gc; vec[64 + lane] = beta; vec[128 + lane] = expf(gc); vec[192 + lane] = expf(gl - gc);
            if (lane == 0) vec[256] = expf(gl);
        }
#pragma unroll
        for (int p = 0; p < 2; ++p) { const int r = sr + 32 * p;
            *(LAS v4u*)(L + DN_QS + r * 272 + sc * 16) = q[p]; *(LAS v4u*)(L + DN_KS + r * 272 + sc * 16) = k[p]; *(LAS v4u*)(L + DN_VS + r * 272 + sc * 16) = v[p]; }
        __syncthreads();
        {
            const int s = tid & 63; const float bs = vec[64 + s], fkd = vec[192 + s], fkb = bs * vec[128 + s];
#pragma unroll
            for (int p = 0; p < 2; ++p) { const int c = (tid >> 6) + 8 * p;
                const v4u kk = *(const LAS v4u*)(L + DN_KS + s * 272 + c * 16), vv = *(const LAS v4u*)(L + DN_VS + s * 272 + c * 16);
#pragma unroll
                for (int i = 0; i < 8; ++i) { const float kf = bfel(kk, i), vf = bfel(vv, i); const int ro = (c * 8 + i) * 144 + s * 2;
                    *(LAS unsigned short*)(L + DN_KDT + ro) = (unsigned short)f2bf(kf * fkd);
                    *(LAS unsigned short*)(L + DN_KBT + ro) = (unsigned short)f2bf(kf * fkb);
                    *(LAS unsigned short*)(L + DN_VBT + ro) = (unsigned short)f2bf(vf * bs); } }
        }
        __syncthreads();
        f32x4 accX[2];
        {
            f32x4 aKK[2], aQK[2];
#pragma unroll
            for (int x = 0; x < 2; ++x) { aKK[x] = (f32x4){0.f, 0.f, 0.f, 0.f}; aQK[x] = (f32x4){0.f, 0.f, 0.f, 0.f}; }
#pragma unroll
            for (int ks = 0; ks < 4; ++ks) {
                const bf16x8 kb = ldfrag(L + DN_KS + (tb * 16 + fr) * 272 + ks * 64 + fq * 16), qb = ldfrag(L + DN_QS + (tb * 16 + fr) * 272 + ks * 64 + fq * 16);
#pragma unroll
                for (int x = 0; x < 2; ++x) { const bf16x8 ka = ldfrag(L + DN_KS + ((ta0 + x) * 16 + fr) * 272 + ks * 64 + fq * 16);
                    aKK[x] = MFMA16(ka, kb, aKK[x]); aQK[x] = MFMA16(ka, qb, aQK[x]); } }
            __syncthreads();
            const int bI = tb * 16 + fr; const float gcb = vec[bI], betab = vec[64 + bI];
#pragma unroll
            for (int x = 0; x < 2; ++x) { const int a0 = (ta0 + x) * 16 + 4 * fq;
                f32x4 vat, vna, vnt, vxa;
#pragma unroll
                for (int r = 0; r < 4; ++r) { const int aI = a0 + r; const float gca = vec[aI], betaa = vec[64 + aI];
                    vat[r] = (aI <= bI) ? aQK[x][r] * expf(fminf(gcb - gca, 0.f)) : 0.f;
                    vna[r] = (aI < bI) ? -betab * aKK[x][r] * expf(fminf(gcb - gca, 0.f)) : 0.f;
                    vnt[r] = (bI < aI) ? -betaa * aKK[x][r] * expf(fminf(gca - gcb, 0.f)) : 0.f;
                    vxa[r] = vna[r] + ((aI == bI) ? 1.0f : 0.f); }
                accX[x] = vxa;
                st8(L + DN_AT + bI * 144 + a0 * 2, vat); st8(L + DN_PA + bI * 144 + a0 * 2, vna); st8(L + DN_PT + bI * 144 + a0 * 2, vnt); st8(L + DN_XA + bI * 144 + a0 * 2, vxa); }
        }
        __syncthreads();
        for (int kk = 1; kk <= 6; ++kk) {
            f32x4 aPA[2], aPT[2];
#pragma unroll
            for (int x = 0; x < 2; ++x) { aPA[x] = (f32x4){0.f, 0.f, 0.f, 0.f}; aPT[x] = (f32x4){0.f, 0.f, 0.f, 0.f}; }
#pragma unroll
            for (int ks = 0; ks < 2; ++ks) {
                const int ko = ks * 64 + fq * 16;
                const bf16x8 pa_b = ldfrag(L + DN_PA + (tb * 16 + fr) * 144 + ko), pt_b = ldfrag(L + DN_PT + (tb * 16 + fr) * 144 + ko), xa_b = ldfrag(L + DN_XA + (tb * 16 + fr) * 144 + ko);
#pragma unroll
                for (int x = 0; x < 2; ++x) {
                    const bf16x8 pt_a = ldfrag(L + DN_PT + ((ta0 + x) * 16 + fr) * 144 + ko), pa_a = ldfrag(L + DN_PA + ((ta0 + x) * 16 + fr) * 144 + ko);
                    if (kk >= 2) accX[x] = MFMA16(pt_a, xa_b, accX[x]);
                    if (kk <= 5) { aPA[x] = MFMA16(pt_a, pa_b, aPA[x]); aPT[x] = MFMA16(pa_a, pt_b, aPT[x]); } } }
            __syncthreads();
            const int bI = tb * 16 + fr;
#pragma unroll
            for (int x = 0; x < 2; ++x) { const int a0 = (ta0 + x) * 16 + 4 * fq;
                if (kk >= 2) st8(L + DN_XA + bI * 144 + a0 * 2, accX[x]);
                if (kk <= 5) { st8(L + DN_PA + bI * 144 + a0 * 2, aPA[x]); st8(L + DN_PT + bI * 144 + a0 * 2, aPT[x]); } }
            __syncthreads();
        }
        f32x4 accU[4];
        {
            f32x4 accW[4];
#pragma unroll
            for (int lt = 0; lt < 4; ++lt) { accU[lt] = (f32x4){0.f, 0.f, 0.f, 0.f}; accW[lt] = (f32x4){0.f, 0.f, 0.f, 0.f}; }
#pragma unroll
            for (int ks = 0; ks < 2; ++ks) { const int ko = ks * 64 + fq * 16;
                const bf16x8 vb = ldfrag(L + DN_VBT + (w * 16 + fr) * 144 + ko), kb = ldfrag(L + DN_KBT + (w * 16 + fr) * 144 + ko);
#pragma unroll
                for (int lt = 0; lt < 4; ++lt) { const bf16x8 tf = ldfrag(L + DN_XA + (lt * 16 + fr) * 144 + ko);
                    accU[lt] = MFMA16(tf, vb, accU[lt]); accW[lt] = MFMA16(kb, tf, accW[lt]); } }
            __syncthreads();
#pragma unroll
            for (int lt = 0; lt < 4; ++lt) { const f32x4 nw = -accW[lt]; st8(L + DN_WL + (lt * 16 + fr) * 272 + (w * 16 + 4 * fq) * 2, nw); }
        }
        __syncthreads();
        {
#pragma unroll
            for (int ks = 0; ks < 4; ++ks) { const int ko = ks * 64 + fq * 16;
                const bf16x8 sb = ldfrag(L + DN_ST + (w * 16 + fr) * 272 + ko);
#pragma unroll
                for (int lt = 0; lt < 4; ++lt) accU[lt] = MFMA16(ldfrag(L + DN_WL + (lt * 16 + fr) * 272 + ko), sb, accU[lt]); }
#pragma unroll
            for (int lt = 0; lt < 4; ++lt) st8(L + DN_VBT + (w * 16 + fr) * 144 + (lt * 16 + 4 * fq) * 2, accU[lt]);
        }
        __syncthreads();
        {
            const int lt = w & 3, dq = w >> 2, l = lt * 16 + fr;
            f32x4 aOA[4], aOQ[4];
#pragma unroll
            for (int t = 0; t < 4; ++t) { aOA[t] = (f32x4){0.f, 0.f, 0.f, 0.f}; aOQ[t] = (f32x4){0.f, 0.f, 0.f, 0.f}; }
#pragma unroll
            for (int ks = 0; ks < 2; ++ks) { const int ko = ks * 64 + fq * 16; const bf16x8 ab = ldfrag(L + DN_AT + l * 144 + ko);
#pragma unroll
                for (int t = 0; t < 4; ++t) aOA[t] = MFMA16(ldfrag(L + DN_VBT + ((dq * 4 + t) * 16 + fr) * 144 + ko), ab, aOA[t]); }
#pragma unroll
            for (int ks = 0; ks < 4; ++ks) { const int ko = ks * 64 + fq * 16; const bf16x8 qb = ldfrag(L + DN_QS + l * 272 + ko);
#pragma unroll
                for (int t = 0; t < 4; ++t) aOQ[t] = MFMA16(ldfrag(L + DN_ST + ((dq * 4 + t) * 16 + fr) * 272 + ko), qb, aOQ[t]); }
            const float egl_l = vec[128 + l];
            const int tt = j * 64 + l, t = dir ? (SEQ - 1 - tt) : tt; const size_t mrow = (size_t)(b * SEQ + t);
#pragma unroll
            for (int t4 = 0; t4 < 4; ++t4) { const f32x4 ov = aOA[t4] + aOQ[t4] * egl_l; v2u o; o.x = pk2(ov[0], ov[1]); o.y = pk2(ov[2], ov[3]);
                *(v2u*)(Oout + mrow * 1024 + (dq * 4 + t4) * 16 + 4 * fq) = o; }
            const float egl = vec[256];
            bf16x8 ak[2];
#pragma unroll
            for (int ks = 0; ks < 2; ++ks) ak[ks] = ldfrag(L + DN_KDT + (w * 16 + fr) * 144 + ks * 64 + fq * 16);
#pragma unroll
            for (int t8 = 0; t8 < 8; ++t8) { accS[t8] = accS[t8] * egl;
#pragma unroll
                for (int ks = 0; ks < 2; ++ks) accS[t8] = MFMA16(ak[ks], ldfrag(L + DN_VBT + (t8 * 16 + fr) * 144 + ks * 64 + fq * 16), accS[t8]); }
        }
        __syncthreads();
#pragma unroll
        for (int t8 = 0; t8 < 8; ++t8) st8(L + DN_ST + (t8 * 16 + fr) * 272 + (w * 16 + 4 * fq) * 2, accS[t8]);
    }
    __syncthreads();
}

__device__ __forceinline__ void p4_combine(Frame& F, const float* m_ng, const float* d_ng) {
    const int gw = F.vcu * NWAVES + F.wave, NGW = F.G * NWAVES, lane = F.lane;
    const bf16* PROJ = (const bf16*)(F.ws + WS_PROJ);
    const bf16* HMf = (const bf16*)(F.ws + WS_HM); const bf16* HMb = HMf + (size_t)MROWS * 1024;
    const bf16* ODf = (const bf16*)(F.ws + WS_ODF); const bf16* ODb = (const bf16*)(F.ws + WS_ODB);
    bf16* YM = (bf16*)(F.ws + WS_YM); bf16* YD = (bf16*)(F.ws + WS_YD);
    for (int m = gw; m < MROWS; m += NGW) {
        v2u hf[4], hb[4], mo[4]; unsigned of[8], ob[8], dz[8];
#pragma unroll
        for (int h = 0; h < 4; ++h) { hf[h] = *(const v2u*)(HMf + (size_t)m * 1024 + h * 256 + 4 * lane); hb[h] = *(const v2u*)(HMb + (size_t)m * 1024 + h * 256 + 4 * lane);
            mo[h] = *(const v2u*)(PROJ + (size_t)(8 + h) * BLK + (size_t)m * 256 + 4 * lane); }
#pragma unroll
        for (int h = 0; h < 8; ++h) { of[h] = *(const unsigned*)(ODf + (size_t)m * 1024 + h * 128 + 2 * lane); ob[h] = *(const unsigned*)(ODb + (size_t)m * 1024 + h * 128 + 2 * lane);
            dz[h] = *(const unsigned*)(PROJ + (size_t)(24 + (h >> 1)) * BLK + (size_t)m * 256 + (h & 1) * 128 + 2 * lane); }
#pragma unroll
        for (int h = 0; h < 4; ++h) {
            const float a0 = bflo(hf[h].x) + bflo(hb[h].x), a1 = bfhi(hf[h].x) + bfhi(hb[h].x), a2 = bflo(hf[h].y) + bflo(hb[h].y), a3 = bfhi(hf[h].y) + bfhi(hb[h].y);
            const float ss = wave_sum((a0 * a0 + a1 * a1) + (a2 * a2 + a3 * a3));
            const float r = 1.0f / sqrtf(ss * (1.f / 256.f) + RMS_EPS);
            const f32x4 g = *(const f32x4*)(m_ng + h * 256 + 4 * lane);
            const float o0 = bflo(mo[h].x), o1 = bfhi(mo[h].x), o2 = bflo(mo[h].y), o3 = bfhi(mo[h].y);
            v2u y; y.x = pk2(a0 * r * g.x / (1.f + expf(-o0)), a1 * r * g.y / (1.f + expf(-o1))); y.y = pk2(a2 * r * g.z / (1.f + expf(-o2)), a3 * r * g.w / (1.f + expf(-o3)));
            *(v2u*)(YM + (size_t)m * 1024 + h * 256 + 4 * lane) = y;
        }
        const float g0 = d_ng[2 * lane], g1 = d_ng[2 * lane + 1];
#pragma unroll
        for (int h = 0; h < 8; ++h) {
            const float a0 = bflo(of[h]) + bflo(ob[h]), a1 = bfhi(of[h]) + bfhi(ob[h]);
            const float ss = wave_sum(a0 * a0 + a1 * a1);
            const float r = 1.0f / sqrtf(ss * (1.f / 128.f) + RMS_EPS);
            const float z0 = bflo(dz[h]), z1 = bfhi(dz[h]);
            *(unsigned*)(YD + (size_t)m * 1024 + h * 128 + 2 * lane) = pk2(a0 * r * g0 * z0 / (1.f + expf(-z0)), a1 * r * g1 * z1 / (1.f + expf(-z1)));
        }
    }
}

__device__ __forceinline__ void p7_norm2(Frame& F, const float* n2g, const float* w_ff1, const float* w_ff2) {
    LAS float* scr = (LAS float*)(F.lds + F.wave * 16384);
    const int gw = F.vcu * NWAVES + F.wave, NGW = F.G * NWAVES;
    bf16* W1T = (bf16*)(F.ws + WS_W1T); bf16* W2T = (bf16*)(F.ws + WS_W2T); bf16* XN2 = (bf16*)(F.ws + WS_XN2);
    constexpr int I_1 = (DM / 64) * (DFF / 32), I_2 = (DFF / 64) * (DM / 32);
    for (int it = gw; it < I_1 + I_2; it += NGW) {
        if (it < I_1) tr_item(w_ff1, DM, DFF, W1T, scr, it, F.lane, false); else tr_item(w_ff2, DFF, DM, W2T, scr, it - I_1, F.lane, false);
    }
    for (int m = gw; m < MROWS; m += NGW) rms_row_bf16(F.lane, F.out + (size_t)m * DM, n2g, XN2 + (size_t)m * DM);
}
__device__ __forceinline__ void p10_final(Frame& F, const float* nfg) {
    const int gw = F.vcu * NWAVES + F.wave, NGW = F.G * NWAVES;
    for (int m = gw; m < MROWS; m += NGW) rms_row_f32(F.lane, F.out + (size_t)m * DM, nfg, F.out + (size_t)m * DM);
}
struct Args { const float* in[17]; float* out; unsigned char* ws; int ph_lo, ph_hi, li, pad; };
__global__ void __launch_bounds__(NWAVES * 64, 2) hybrid_fwd(Args args) {
    extern __shared__ __attribute__((aligned(16))) unsigned char lds[];
    Frame F;
    F.lds = (LAS unsigned char*)lds;
    F.MISC = (volatile LAS unsigned*)(F.lds + MISC_OFF);
    F.tid = threadIdx.x; F.lane = F.tid & 63; F.wave = __builtin_amdgcn_readfirstlane(F.tid >> 6);
    F.G = gridDim.x; { const int bx = blockIdx.x; F.vcu = (F.G % 8 == 0) ? (bx % 8) * (F.G / 8) + bx / 8 : bx; }
    F.ws = args.ws; F.ctl = (gu32*)(args.ws + WS_CTL);
    F.out = args.out;
    if (F.tid < 64) ((LAS unsigned*)(F.lds + MISC_OFF))[F.tid] = 0u;
    __syncthreads();
    XcdBarrier bar; bar.bar = (unsigned*)(F.ctl + CW_BAR); bar.x = 0; bar.st = nullptr;
    if (N_LAUNCHES != PER_PHASE) bar = xcd_barrier_post((unsigned*)(F.ctl + CW_BAR), F.MISC + 8);
#define GRID_BAR() do { if (N_LAUNCHES != PER_PHASE) xcd_barrier(bar); } while (0)
    const int lo = args.ph_lo, hi = args.ph_hi;
#ifndef PHASE_MASK
#define PHASE_MASK 0x7ff
#endif
#define IN(k) (((PHASE_MASK >> (k)) & 1) && lo <= (k) && (k) < hi)
#define BOTH(k) (IN(k) && IN((k) + 1))
    bf16* PROJ = (bf16*)(F.ws + WS_PROJ);

    if (IN(0)) { p0_prologue(F, args.in[0], args.in[1], args.in[2], args.in[10], args.in[11], args.in[12]); if (BOTH(0)) GRID_BAR(); }
    if (IN(1)) {
        pg8::Gemm g{(const bf16*)(F.ws + WS_XN), (const bf16*)(F.ws + WS_WIN), MROWS, NPROJ_PAD, DM}; pg8::StaticOrder S; S.init(MROWS, NPROJ_PAD, F.G, (int)blockIdx.x);
        pg8::EpiProj E{PROJ, (float*)(F.ws + WS_GATES)};
        pg8::gemm_phase<pg8::EpiProj, pg8::StaticOrder, true, true>(F.lds, g, S, E);
        if (BOTH(1)) GRID_BAR();
    }
    if (IN(2)) { p2_conv(F, args.in[6]); if (BOTH(2)) GRID_BAR(); }
    if (IN(3)) {
        const int u = F.vcu;
        if (u < 128) mlstm_unit(F, u, args.in[3], args.in[4]);
        else if (u < 256) delta_unit(F, u - 128, args.in[7], args.in[8]);
        if (BOTH(3)) GRID_BAR();
    }
    if (IN(4)) { p4_combine(F, args.in[5], args.in[9]); if (BOTH(4)) GRID_BAR(); }
    if (IN(5)) {
        pg8::Gemm g{(const bf16*)(F.ws + WS_YM), (const bf16*)(F.ws + WS_WBM), 2 * MROWS, 4096, 1024}; pg8::BranchOrder S; S.init(F.G, (int)blockIdx.x);
        pg8::EpiBranch E{PROJ, (bf16*)(F.ws + WS_MIX)};
        pg8::gemm_phase<pg8::EpiBranch, pg8::BranchOrder, true, true>(F.lds, g, S, E);
        if (BOTH(5)) GRID_BAR();
    }
    if (IN(6)) {
        pg8::Gemm g{(const bf16*)(F.ws + WS_MIX), (const bf16*)(F.ws + WS_WOUT), MROWS, DM, DM}; pg8::StaticOrder S; S.init(MROWS, DM, F.G, (int)blockIdx.x);
        pg8::EpiResid E{args.in[0], F.out, DM};
        pg8::gemm_phase<pg8::EpiResid, pg8::StaticOrder, true, true>(F.lds, g, S, E);
        if (BOTH(6)) GRID_BAR();
    }
    if (IN(7)) { p7_norm2(F, args.in[13], args.in[14], args.in[15]); if (BOTH(7)) GRID_BAR(); }
    if (IN(8)) {
        pg8::Gemm g{(const bf16*)(F.ws + WS_XN2), (const bf16*)(F.ws + WS_W1T), MROWS, DFF, DM}; pg8::StaticOrder S; S.init(MROWS, DFF, F.G, (int)blockIdx.x);
        pg8::EpiRelu2 E{(bf16*)(F.ws + WS_HFF), DFF};
        pg8::gemm_phase<pg8::EpiRelu2, pg8::StaticOrder, true, true>(F.lds, g, S, E);
        if (BOTH(8)) GRID_BAR();
    }
    if (IN(9)) {
        pg8::Gemm g{(const bf16*)(F.ws + WS_HFF), (const bf16*)(F.ws + WS_W2T), MROWS, DM, DFF}; pg8::StaticOrder S; S.init(MROWS, DM, F.G, (int)blockIdx.x);
        pg8::EpiResid E{F.out, F.out, DM};
        pg8::gemm_phase<pg8::EpiResid, pg8::StaticOrder, true, true>(F.lds, g, S, E);
        if (BOTH(9)) GRID_BAR();
    }
    if (IN(10)) { p10_final(F, args.in[16]); }
#undef IN
#undef BOTH
}

extern "C" void kernel_launch(void* const* d_in, const int* in_sizes, int n_in, void* d_out, int out_size, void* d_ws, size_t ws_size, hipStream_t stream) {
    static int grid = 0;
    if (grid == 0) {
        if (n_in != 17 || in_sizes[0] != MROWS * DM || out_size != MROWS * DM || ws_size < WS_END) {
            fprintf(stderr, "kernel_launch: unexpected problem: n_in %d, in0 %d, out %d, ws %zu (need %zu); nothing launched\n", n_in, n_in > 0 ? in_sizes[0] : -1, out_size, ws_size, (size_t)WS_END); grid = -1; return; }
        int dev = 0, cus = 0, per_cu = 0;
        if (hipGetDevice(&dev) != hipSuccess || hipDeviceGetAttribute(&cus, hipDeviceAttributeMultiprocessorCount, dev) != hipSuccess) { fprintf(stderr, "kernel_launch: device query failed\n"); grid = -1; return; }
        if (hipFuncSetAttribute((const void*)hybrid_fwd, hipFuncAttributeMaxDynamicSharedMemorySize, LDS_BYTES) != hipSuccess) { fprintf(stderr, "kernel_launch: hipFuncSetAttribute failed\n"); grid = -1; return; }
        if (hipOccupancyMaxActiveBlocksPerMultiprocessor(&per_cu, (const void*)hybrid_fwd, NWAVES * 64, LDS_BYTES) != hipSuccess || per_cu < 1)
            fprintf(stderr, "kernel_launch: note: occupancy query reports %d workgroups per CU\n", per_cu);
        (void)hipGetLastError();
        grid = cus;
    }
    if (grid < 0) return;
    if (hipMemsetAsync((char*)d_ws + WS_CTL, 0, CTL_ZERO_BYTES, stream) != hipSuccess) { fprintf(stderr, "kernel_launch: memset failed\n"); return; }
    Args a{};
    for (int i = 0; i < 17; ++i) a.in[i] = (const float*)d_in[i];
    a.out = (float*)d_out; a.ws = (unsigned char*)d_ws;
    for (int li = 0; li < N_LAUNCHES; ++li) {
        a.ph_lo = (N_LAUNCHES == PER_PHASE) ? li : 0; a.ph_hi = (N_LAUNCHES == PER_PHASE) ? li + 1 : PER_PHASE; a.li = li;
        hipLaunchKernelGGL(hybrid_fwd, dim3(grid), dim3(NWAVES * 64), LDS_BYTES, stream, a);
        const hipError_t le = hipPeekAtLastError();
        if (le != hipSuccess) { fprintf(stderr, "kernel_launch: launch %d failed: %s\n", li, hipGetErrorName(le)); break; }
    }
}
```

```cpp
#include <hip/hip_runtime.h>
#include <cstdio>
#include <cstdint>

#ifndef MK_N_LAUNCHES
#define MK_N_LAUNCHES 1
#endif
constexpr int MROWS = 16384;
namespace pg8 {
#define PG8_LAS __attribute__((address_space(3)))
typedef unsigned short bf16_t;
typedef short bf16x8 __attribute__((ext_vector_type(8)));
typedef float f32x4 __attribute__((ext_vector_type(4)));
typedef unsigned u32x4 __attribute__((ext_vector_type(4)));
constexpr int BM = 256, BK = 64, HALF = 128, HTB = HALF * BK * 2  , STAGE_BYTES = 8 * HTB, NXCD = 8, WGM = 8;

__host__ __device__ __forceinline__ int lds_byte(int r, int c) { const int st = (r >> 4) * 2 + (c >> 5), rr = r & 15, cc = c & 31, ob = rr * 64 + cc * 2; return st * 1024 + (ob ^ (((ob >> 9) & 1) << 5)); }
__host__ __device__ __forceinline__ void stage_rc(int b, int& R, int& C) { const int st = b / 1024, sb = b % 1024, swz = sb ^ (((sb >> 9) & 1) << 5); R = (st >> 1) * 16 + swz / 64; C = (st & 1) * 32 + (swz % 64) / 2; }
__host__ __device__ __forceinline__ int perm32(int rho) { const int n = rho >> 4, i = rho & 15; return 8 * (i >> 2) + 4 * n + (i & 3); }

struct Unit { int pm, pn; };
struct Gemm { const bf16_t* A; const bf16_t* Bt; int M, N, K; };

struct StaticOrder {
    int nM, nN, nwg, G, c;
    __host__ __device__ void init(int M, int N, int G_, int c_) { nM = M / BM; nN = N / BM; nwg = nM * nN; G = G_; c = c_; }
    __host__ __device__ bool next(int i, Unit& u) const {
        const long L = (long)i * G + c; if (L >= nwg) return false;
        int wgid = (int)L; { const int q = nwg / NXCD, r = nwg % NXCD, xcd = wgid % NXCD, off = wgid / NXCD; wgid = (xcd < r ? xcd * (q + 1) : r * (q + 1) + (xcd - r) * q) + off; }
        const int nig = WGM * nN, gid = wgid / nig, fm = gid * WGM, gsz = (nM - fm) < WGM ? (nM - fm) : WGM;
        u.pm = fm + ((wgid % nig) % gsz); u.pn = (wgid % nig) / gsz; return true;
    }
    __device__ __forceinline__ void a_ready(const Unit&) const {}
    __device__ __forceinline__ void done(const Unit&) const {}
};

__device__ __forceinline__ unsigned cvt_pk_bf16(float lo, float hi) { unsigned r; asm volatile("v_cvt_pk_bf16_f32 %0, %1, %2" : "=v"(r) : "v"(lo), "v"(hi)); return r; }
typedef float f32x2 __attribute__((ext_vector_type(2)));
typedef unsigned u32x2 __attribute__((ext_vector_type(2)));
__device__ __forceinline__ float bf_lo(unsigned w) { return __uint_as_float(w << 16); }
__device__ __forceinline__ float bf_hi(unsigned w) { return __uint_as_float(w & 0xffff0000u); }
__device__ __forceinline__ float fsigmoid(float x) { return __builtin_amdgcn_rcpf(1.0f + __expf(-x)); }

struct EpiProj {
    static constexpr bool PERM = true, AFTER_DRAIN = false;
    bf16_t* P; float* gates;
    __device__ __forceinline__ void operator()(const f32x4 (&acc)[2][2][4][2], const Unit& u, int wr, int wc, int fr, int fq) const {
        const int row0 = u.pm * BM + wr * 64 + fr;
        if (u.pn < 44) {
            bf16_t* base = P + (size_t)u.pn * ((size_t)MROWS * 256) + wc * 32 + 8 * fq;
#pragma unroll
            for (int ai = 0; ai < 2; ++ai)
#pragma unroll
                for (int m = 0; m < 4; ++m) { bf16_t* rowp = base + (size_t)(row0 + ai * HALF + m * 16) * 256;
#pragma unroll
                    for (int bj = 0; bj < 2; ++bj) { const f32x4 v0 = acc[ai][bj][m][0], v1 = acc[ai][bj][m][1];
                        u32x4 w; w.x = cvt_pk_bf16(v0[0], v0[1]); w.y = cvt_pk_bf16(v0[2], v0[3]); w.z = cvt_pk_bf16(v1[0], v1[1]); w.w = cvt_pk_bf16(v1[2], v1[3]);
                        *(u32x4*)(rowp + bj * HALF) = w; } }
        } else if (wc < 2) {
#pragma unroll
            for (int ai = 0; ai < 2; ++ai)
#pragma unroll
                for (int m = 0; m < 4; ++m) { float* rp = gates + (size_t)(row0 + ai * HALF + m * 16) * 64 + wc * 32 + 8 * fq;
                    *(f32x4*)rp = acc[ai][0][m][0]; *(f32x4*)(rp + 4) = acc[ai][0][m][1]; }
        }
    }
};

struct EpiBranch {
    static constexpr bool PERM = true, AFTER_DRAIN = false;
    const bf16_t* G; bf16_t* O;
    __device__ __forceinline__ void operator()(const f32x4 (&acc)[2][2][4][2], const Unit& u, int wr, int wc, int fr, int fq) const {
        const int br = u.pn >> 3, pn = u.pn & 7, pm = u.pm & 63;
        const int row0 = pm * BM + wr * 64 + fr, cl = wc * 32 + 8 * fq;
        const bf16_t* gbase = G + (size_t)(28 + 8 * br + pn) * ((size_t)MROWS * 256) + cl;
        bf16_t* obase = O + pn * 256 + cl;
#pragma unroll
        for (int ai = 0; ai < 2; ++ai)
#pragma unroll
            for (int m = 0; m < 4; ++m) { const size_t r = (size_t)(row0 + ai * HALF + m * 16);
#pragma unroll
                for (int bj = 0; bj < 2; ++bj) {
                    const u32x4 gv = *(const u32x4*)(gbase + r * 256 + bj * HALF);
                    const f32x4 a0 = acc[ai][bj][m][0], a1 = acc[ai][bj][m][1];
                    float v[8];
                    v[0] = a0[0] * fsigmoid(bf_lo(gv.x)); v[1] = a0[1] * fsigmoid(bf_hi(gv.x)); v[2] = a0[2] * fsigmoid(bf_lo(gv.y)); v[3] = a0[3] * fsigmoid(bf_hi(gv.y));
                    v[4] = a1[0] * fsigmoid(bf_lo(gv.z)); v[5] = a1[1] * fsigmoid(bf_hi(gv.z)); v[6] = a1[2] * fsigmoid(bf_lo(gv.w)); v[7] = a1[3] * fsigmoid(bf_hi(gv.w));
                    bf16_t* op = obase + r * 2048 + bj * HALF;
                    if (br) { const u32x4 pv = *(const u32x4*)op;
                        v[0] += bf_lo(pv.x); v[1] += bf_hi(pv.x); v[2] += bf_lo(pv.y); v[3] += bf_hi(pv.y); v[4] += bf_lo(pv.z); v[5] += bf_hi(pv.z); v[6] += bf_lo(pv.w); v[7] += bf_hi(pv.w); }
                    u32x4 w; w.x = cvt_pk_bf16(v[0], v[1]); w.y = cvt_pk_bf16(v[2], v[3]); w.z = cvt_pk_bf16(v[4], v[5]); w.w = cvt_pk_bf16(v[6], v[7]);
                    *(u32x4*)op = w; } }
    }
};
struct BranchOrder {
    StaticOrder so;
    __host__ __device__ void init(int G_, int c_) { so.init(MROWS, 2048, G_, c_); }
    __host__ __device__ bool next(int i, Unit& u) const { Unit t; if (!so.next(i >> 1, t)) return false; const int br = i & 1; u.pm = t.pm + 64 * br; u.pn = t.pn + 8 * br; return true; }
    __device__ __forceinline__ void a_ready(const Unit&) const {}
    __device__ __forceinline__ void done(const Unit&) const {}
};

struct EpiResid {
    static constexpr bool PERM = false, AFTER_DRAIN = false;
    const float* base; float* out; int ldc;
    __device__ __forceinline__ void operator()(const f32x4 (&acc)[2][2][4][2], const Unit& u, int wr, int wc, int fr, int fq) const {
        const int col0 = u.pn * BM + wc * 32 + 4 * fq;
#pragma unroll
        for (int ai = 0; ai < 2; ++ai)
#pragma unroll
            for (int m = 0; m < 4; ++m) { const size_t off = (size_t)(u.pm * BM + ai * HALF + wr * 64 + m * 16 + fr) * ldc + col0;
#pragma unroll
                for (int bj = 0; bj < 2; ++bj)
#pragma unroll
                    for (int n = 0; n < 2; ++n) { const f32x4 bs = *(const f32x4*)(base + off + bj * HALF + n * 16); *(f32x4*)(out + off + bj * HALF + n * 16) = bs + acc[ai][bj][m][n]; } }
    }
};

struct EpiRelu2 {
    static constexpr bool PERM = true, AFTER_DRAIN = false;
    bf16_t* O; int ldc;
    __device__ __forceinline__ void operator()(const f32x4 (&acc)[2][2][4][2], const Unit& u, int wr, int wc, int fr, int fq) const {
        const int row0 = u.pm * BM + wr * 64 + fr, col0 = u.pn * BM + wc * 32 + 8 * fq;
#pragma unroll
        for (int ai = 0; ai < 2; ++ai)
#pragma unroll
            for (int m = 0; m < 4; ++m) { bf16_t* rowp = O + (size_t)(row0 + ai * HALF + m * 16) * ldc + col0;
#pragma unroll
                for (int bj = 0; bj < 2; ++bj) { f32x4 v0 = acc[ai][bj][m][0], v1 = acc[ai][bj][m][1];
#pragma unroll
                    for (int e = 0; e < 4; ++e) { const float a = fmaxf(v0[e], 0.f), b = fmaxf(v1[e], 0.f); v0[e] = a * a; v1[e] = b * b; }
                    u32x4 w; w.x = cvt_pk_bf16(v0[0], v0[1]); w.y = cvt_pk_bf16(v0[2], v0[3]); w.z = cvt_pk_bf16(v1[0], v1[1]); w.w = cvt_pk_bf16(v1[2], v1[3]);
                    *(u32x4*)(rowp + bj * HALF) = w; } }
    }
};
template <class Epi, class Sched, bool ALIGN_EPI = false, bool SP2 = false>
__device__ __forceinline__ void gemm_phase(PG8_LAS unsigned char* lds, const Gemm g, const Sched& S, const Epi& E) {
    const int tid = threadIdx.x, wid = __builtin_amdgcn_readfirstlane(tid >> 6), lane = tid & 63, wr = wid >> 2, wc = wid & 3, fr = lane & 15, fq = lane >> 4;
    const int K = g.K, nt = K / BK;
    unsigned voffA[2], voffB[2];
#pragma unroll
    for (int i = 0; i < 2; ++i) { int R, C; stage_rc(tid * 16 + i * 8192, R, C); const int Rb = Epi::PERM ? ((R & ~31) + perm32(R & 31)) : R;
        voffA[i] = (unsigned)(R * K + C) * 2u; voffB[i] = (unsigned)(Rb * K + C) * 2u; }
    const size_t kstep = (size_t)(BK * 2);
    const size_t hstep = (size_t)HALF * K * 2;
    const size_t tstep = 2 * hstep;
    const unsigned ldsw = (unsigned)wid * 1024u;
    const int aoff = lds_byte(wr * 64 + fr, fq * 8), boff = lds_byte(wc * 32 + fr, fq * 8);
#define PG8_SA(b, h) (((b) * 2 + (h)) * HTB)
#define PG8_SB(b, h) ((4 + (b) * 2 + (h)) * HTB)
#define PG8_STAGE(bufoff, gbase, voff) do { _Pragma("unroll") for (int _i = 0; _i < 2; ++_i) \
        __builtin_amdgcn_global_load_lds((const unsigned*)((const char*)(gbase) + (voff)[_i]), (PG8_LAS unsigned*)(lds + (bufoff) + ldsw + _i * 8192), 16, 0, 0); } while (0)
#define PG8_LDA(dst, b, h) do { _Pragma("unroll") for (int m = 0; m < 4; ++m) _Pragma("unroll") for (int k = 0; k < 2; ++k) dst[m][k] = *(const PG8_LAS bf16x8*)(lds + PG8_SA(b, h) + aoff + m * 2048 + k * 1024); } while (0)
#define PG8_LDB(dst, b, h) do { _Pragma("unroll") for (int n = 0; n < 2; ++n) _Pragma("unroll") for (int k = 0; k < 2; ++k) dst[n][k] = *(const PG8_LAS bf16x8*)(lds + PG8_SB(b, h) + boff + n * 2048 + k * 1024); } while (0)
#define PG8_MMA(ai, bj, At, Bt) do { __builtin_amdgcn_s_setprio(1); _Pragma("unroll") for (int m = 0; m < 4; ++m) _Pragma("unroll") for (int n = 0; n < 2; ++n) _Pragma("unroll") for (int k = 0; k < 2; ++k) \
        acc[ai][bj][m][n] = __builtin_amdgcn_mfma_f32_16x16x32_bf16(Bt[n][k], At[m][k], acc[ai][bj][m][n], 0, 0, 0); __builtin_amdgcn_s_setprio(0); } while (0)
#define PG8_WAIT_V(n) asm volatile("s_waitcnt vmcnt(" #n ")" ::: "memory")
#define PG8_WAIT_L(n) asm volatile("s_waitcnt lgkmcnt(" #n ")" ::: "memory")
#define PG8_BAR __builtin_amdgcn_s_barrier()
#define PG8_SCHED __builtin_amdgcn_sched_barrier(0)
    Unit cur, nxt; int ui = 0;
    if (!S.next(0, cur)) return;
    f32x4 acc[2][2][4][2];
#pragma unroll
    for (int a = 0; a < 2; ++a)
#pragma unroll
        for (int b = 0; b < 2; ++b)
#pragma unroll
            for (int m = 0; m < 4; ++m)
#pragma unroll
                for (int n = 0; n < 2; ++n) acc[a][b][m][n] = (f32x4){0.f, 0.f, 0.f, 0.f};
    bf16x8 At[4][2], B0[2][2], B1[2][2];
    const char* cA = (const char*)g.A + (size_t)cur.pm * tstep; const char* cB = (const char*)g.Bt + (size_t)cur.pn * tstep;
    S.a_ready(cur);
    if constexpr (SP2) {
        PG8_STAGE(PG8_SB(0, 0), cB, voffB); PG8_STAGE(PG8_SB(0, 1), cB + hstep, voffB); PG8_STAGE(PG8_SA(0, 0), cA, voffA); PG8_STAGE(PG8_SA(0, 1), cA + hstep, voffA);
        if (wr == 1) PG8_BAR;
        PG8_WAIT_V(2); PG8_BAR;
        PG8_STAGE(PG8_SB(1, 0), cB + kstep, voffB); PG8_STAGE(PG8_SA(1, 0), cA + kstep, voffA); PG8_STAGE(PG8_SB(1, 1), cB + hstep + kstep, voffB);
        PG8_WAIT_V(6); PG8_BAR;
    } else {
        PG8_STAGE(PG8_SB(0, 0), cB, voffB); PG8_STAGE(PG8_SA(0, 0), cA, voffA); PG8_STAGE(PG8_SB(0, 1), cB + hstep, voffB); PG8_STAGE(PG8_SA(0, 1), cA + hstep, voffA);
        if (wr == 1) PG8_BAR;
        PG8_WAIT_V(4); PG8_BAR;
        PG8_STAGE(PG8_SB(1, 0), cB + kstep, voffB); PG8_STAGE(PG8_SA(1, 0), cA + kstep, voffA); PG8_STAGE(PG8_SB(1, 1), cB + hstep + kstep, voffB);
        PG8_WAIT_V(6); PG8_BAR;
    }
    for (;;) {
        const bool has_next = S.next(ui + 1, nxt);
        const char* nA = has_next ? (const char*)g.A + (size_t)nxt.pm * tstep : cA; const char* nB = has_next ? (const char*)g.Bt + (size_t)nxt.pn * tstep : cB;
        for (int t = 0; t < nt; t += 2) {
            const bool last = (t == nt - 2);
            const char* a1 = cA + (size_t)(t + 1) * kstep;
            const char* a2 = last ? nA : cA + (size_t)(t + 2) * kstep; const char* b2 = last ? nB : cB + (size_t)(t + 2) * kstep;
            const char* a3 = a2 + kstep; const char* b3 = b2 + kstep;
            if (last && has_next) S.a_ready(nxt);
            if constexpr (SP2) {
            PG8_LDB(B0, 0, 0); PG8_LDB(B1, 0, 1); PG8_SCHED; PG8_LDA(At, 0, 0); PG8_STAGE(PG8_SA(1, 1), a1 + hstep, voffA);
            PG8_WAIT_V(8); PG8_WAIT_L(0); PG8_BAR; PG8_MMA(0, 0, At, B0); PG8_MMA(0, 1, At, B1); PG8_BAR; PG8_SCHED;
            PG8_LDA(At, 0, 1); PG8_STAGE(PG8_SB(0, 0), b2, voffB); PG8_STAGE(PG8_SB(0, 1), b2 + hstep, voffB); PG8_STAGE(PG8_SA(0, 0), a2, voffA);
            PG8_WAIT_V(8); PG8_WAIT_L(0); PG8_BAR; PG8_MMA(1, 0, At, B0); PG8_MMA(1, 1, At, B1); PG8_BAR; PG8_SCHED;
            PG8_LDB(B0, 1, 0); PG8_LDB(B1, 1, 1); PG8_SCHED; PG8_LDA(At, 1, 0); PG8_STAGE(PG8_SA(0, 1), a2 + hstep, voffA);
            PG8_WAIT_V(8); PG8_WAIT_L(0); PG8_BAR; PG8_MMA(0, 0, At, B0); PG8_MMA(0, 1, At, B1); PG8_BAR; PG8_SCHED;
            PG8_LDA(At, 1, 1); PG8_STAGE(PG8_SB(1, 0), b3, voffB); PG8_STAGE(PG8_SB(1, 1), b3 + hstep, voffB); PG8_STAGE(PG8_SA(1, 0), a3, voffA);
            PG8_WAIT_V(8); PG8_WAIT_L(0); PG8_BAR; PG8_MMA(1, 0, At, B0); PG8_MMA(1, 1, At, B1); PG8_BAR; PG8_SCHED;
            } else {
            PG8_LDB(B0, 0, 0); PG8_SCHED; PG8_LDA(At, 0, 0); PG8_STAGE(PG8_SA(1, 1), a1 + hstep, voffA);
            PG8_WAIT_L(8); PG8_BAR; PG8_WAIT_L(0); PG8_MMA(0, 0, At, B0); PG8_BAR; PG8_SCHED;
            PG8_LDB(B1, 0, 1); PG8_STAGE(PG8_SB(0, 0), b2, voffB);
            PG8_BAR; PG8_WAIT_L(0); PG8_MMA(0, 1, At, B1); PG8_BAR;
            PG8_LDA(At, 0, 1); PG8_STAGE(PG8_SA(0, 0), a2, voffA);
            PG8_BAR; PG8_WAIT_L(0); PG8_MMA(1, 0, At, B0); PG8_BAR; PG8_SCHED;
            PG8_STAGE(PG8_SB(0, 1), b2 + hstep, voffB);
            PG8_WAIT_V(6); PG8_BAR; PG8_MMA(1, 1, At, B1); PG8_BAR;
            PG8_LDB(B0, 1, 0); PG8_SCHED; PG8_LDA(At, 1, 0); PG8_STAGE(PG8_SA(0, 1), a2 + hstep, voffA);
            PG8_WAIT_L(8); PG8_BAR; PG8_WAIT_L(0); PG8_MMA(0, 0, At, B0); PG8_BAR; PG8_SCHED;
            PG8_LDB(B1, 1, 1); PG8_STAGE(PG8_SB(1, 0), b3, voffB);
            PG8_BAR; PG8_WAIT_L(0); PG8_MMA(0, 1, At, B1); PG8_BAR;
            PG8_LDA(At, 1, 1); PG8_STAGE(PG8_SA(1, 0), a3, voffA);
            PG8_BAR; PG8_WAIT_L(0); PG8_MMA(1, 0, At, B0); PG8_BAR; PG8_SCHED;
            PG8_STAGE(PG8_SB(1, 1), b3 + hstep, voffB);
            PG8_WAIT_V(6); PG8_BAR; PG8_MMA(1, 1, At, B1); PG8_BAR;
            }
        }
        if constexpr (ALIGN_EPI) { if (wr == 0) PG8_BAR; }
        if constexpr (!Epi::AFTER_DRAIN) { E(acc, cur, wr, wc, fr, fq); S.done(cur); }
        if (!has_next) break;
#pragma unroll
        for (int a = 0; a < 2; ++a)
#pragma unroll
            for (int b = 0; b < 2; ++b)
#pragma unroll
                for (int m = 0; m < 4; ++m)
#pragma unroll
                    for (int n = 0; n < 2; ++n) acc[a][b][m][n] = (f32x4){0.f, 0.f, 0.f, 0.f};
        cur = nxt; cA = nA; cB = nB; ++ui;
        if constexpr (ALIGN_EPI) { if (wr == 1) PG8_BAR; }
    }
    PG8_WAIT_V(0);
    if constexpr (!ALIGN_EPI) { if (wr == 0) PG8_BAR; }
    PG8_BAR;
    if constexpr (Epi::AFTER_DRAIN) { E.fused(acc, cur, wr, wc, fr, fq, lds, wid, lane); S.done(cur); }
#undef PG8_SA
#undef PG8_SB
#undef PG8_STAGE
#undef PG8_LDA
#undef PG8_LDB
#undef PG8_MMA
#undef PG8_WAIT_V
#undef PG8_WAIT_L
#undef PG8_BAR
#undef PG8_SCHED
}
}
constexpr int NWAVES = 8;
constexpr int N_LAUNCHES = MK_N_LAUNCHES;
constexpr int PER_PHASE = 11;
constexpr int SEQ = 2048, DM = 2048, DFF = 8192, NPROJ_IN = 11312, NPROJ_PAD = 11520;
constexpr float RMS_EPS = 1e-6f;
constexpr size_t MiB = 1u << 20;
constexpr size_t BLK = (size_t)MROWS * 256;
constexpr size_t WS_CTL = 0, CTL_ZERO_BYTES = 1 * MiB;
constexpr size_t WS_GATES = 1 * MiB, WS_WBM = 5 * MiB, WS_WBD = 9 * MiB, WS_WOUT = 13 * MiB, WS_PROJ = 21 * MiB, WS_WIN = 373 * MiB, WS_XN = 418 * MiB;
constexpr size_t WS_DQ = 373 * MiB, WS_DK = 405 * MiB, WS_DV = 437 * MiB;
constexpr size_t WS_HM = 117 * MiB, WS_ODF = 181 * MiB, WS_ODB = 469 * MiB;
constexpr size_t WS_YM = 21 * MiB, WS_YD = 53 * MiB, WS_MIX = 373 * MiB;
constexpr size_t WS_XN2 = 437 * MiB, WS_W1T = 21 * MiB, WS_W2T = 53 * MiB, WS_HFF = 117 * MiB, WS_END = 501 * MiB;
constexpr int CW_BAR = 4096;
constexpr int LDS_BYTES = 163840;
constexpr int MISC_OFF = LDS_BYTES - 256;

#define GAS __attribute__((address_space(1)))
#define LAS __attribute__((address_space(3)))
typedef unsigned short bf16;
typedef unsigned v4u __attribute__((ext_vector_type(4)));
typedef unsigned v2u __attribute__((ext_vector_type(2)));
typedef float f32x4 __attribute__((ext_vector_type(4)));
typedef short bf16x8 __attribute__((ext_vector_type(8)));
typedef GAS unsigned gu32;
#define RLX_AGENT __ATOMIC_RELAXED, __HIP_MEMORY_SCOPE_AGENT
#define LDS_WAIT() asm volatile("s_waitcnt lgkmcnt(0)" ::: "memory")
#define VM_WAIT() asm volatile("s_waitcnt vmcnt(0)" ::: "memory")
__device__ __forceinline__ unsigned f2bf(float f) { unsigned u = __builtin_bit_cast(unsigned, f); return (u + 0x7fffu + ((u >> 16) & 1u)) >> 16; }
__device__ __forceinline__ unsigned pk2(float lo, float hi) { return f2bf(lo) | (f2bf(hi) << 16); }
__device__ __forceinline__ float bflo(unsigned w) { return __uint_as_float(w << 16); }
__device__ __forceinline__ float bfhi(unsigned w) { return __uint_as_float(w & 0xffff0000u); }
__device__ __forceinline__ float bfel(const v4u& v, int i) { const unsigned w = v[i >> 1]; return (i & 1) ? bfhi(w) : bflo(w); }
#define MFMA16(a, b, c) __builtin_amdgcn_mfma_f32_16x16x32_bf16((a), (b), (c), 0, 0, 0)
__device__ __forceinline__ bf16x8 ldfrag(const LAS unsigned char* p) { return *(const LAS bf16x8*)p; }
__device__ __forceinline__ void st8(LAS unsigned char* p, const f32x4& v) { v2u w; w.x = pk2(v[0], v[1]); w.y = pk2(v[2], v[3]); *(LAS v2u*)p = w; }
#define XB_TMO      128
#define XB_XCNT(j)  (256  + 64 * (j))
#define XB_XSUB(j)  (1280 + 64 * (j))
#define XB_XGEN(j)  (2304 + 64 * (j))
#define XB_TOP      3328
#define XB_TOPGEN   3392
#define XCD_BAR_WORDS 3456
#define XB_SPIN_CAP (1u << 18)

__device__ __forceinline__ unsigned xb_ld(unsigned* p)              { return __hip_atomic_load(p, __ATOMIC_RELAXED, __HIP_MEMORY_SCOPE_AGENT); }
__device__ __forceinline__ unsigned xb_add(unsigned* p, unsigned v) { return __hip_atomic_fetch_add(p, v, __ATOMIC_RELAXED, __HIP_MEMORY_SCOPE_AGENT); }
__device__ __forceinline__ unsigned xb_xcc_id() { return (unsigned)__builtin_amdgcn_s_getreg((3 << 11) | 20) & 0xFu; }
#define XB_SPIN(cond, bar) do { unsigned _sp = 0; while (cond) { __builtin_amdgcn_s_sleep(1); \
    if ((++_sp & 255u) == 0u) { if (xb_ld(&(bar)[XB_TMO])) break; if (_sp > XB_SPIN_CAP) { atomicAdd(&(bar)[XB_TMO], 1u); break; } } } } while (0)

struct XcdBarrier {
    unsigned* bar; unsigned x;
    volatile LAS unsigned* st;
};

__device__ __forceinline__ XcdBarrier xcd_barrier_post(unsigned* bar, volatile LAS unsigned* st) {
    XcdBarrier b; b.bar = bar; b.x = xb_xcc_id(); b.st = st;
    if (threadIdx.x == 0) (void)xb_add(&bar[XB_XCNT(b.x)], 1u);
    return b;
}
__device__ __forceinline__ void xcd_barrier_complete(unsigned* bar, unsigned x, unsigned& nloc, unsigned& nx) {
    const unsigned G = gridDim.x * gridDim.y * gridDim.z;
    unsigned sum, cnt, mine, sp = 0u;
    for (;;) {
        sum = 0u; cnt = 0u; mine = 0u;
#pragma unroll
        for (unsigned j = 0; j < 16; ++j) { const unsigned c = xb_ld(&bar[XB_XCNT(j)]); sum += c; cnt += (c > 0u) ? 1u : 0u; mine = (j == x) ? c : mine; }
        if (sum == G) break;
        __builtin_amdgcn_s_sleep(1);
        if ((++sp & 255u) == 0u) { if (xb_ld(&bar[XB_TMO])) break; if (sp > XB_SPIN_CAP) { atomicAdd(&bar[XB_TMO], 1u); break; } }
    }
    nloc = mine > 0u ? mine : 1u; nx = cnt > 0u ? cnt : 1u;
}

__device__ __forceinline__ void xcd_barrier(const XcdBarrier& b) {
    asm volatile("s_waitcnt vmcnt(0)" ::: "memory");
    __syncthreads();
    if (threadIdx.x == 0) {
        unsigned* bar = b.bar;
        __builtin_amdgcn_s_waitcnt(0);
        unsigned nloc = b.st[0], nx = b.st[1];
        if (nloc == 0u) { xcd_barrier_complete(bar, b.x, nloc, nx); b.st[0] = nloc; b.st[1] = nx; }
        const unsigned old = xb_add(&bar[XB_XSUB(b.x)], 1u);
        const unsigned gen = old / nloc;
        if (old + 1u == (gen + 1u) * nloc) {
            __builtin_amdgcn_fence(__ATOMIC_RELEASE, "agent");
            asm volatile("s_waitcnt vmcnt(0)" ::: "memory");
            const unsigned og = xb_add(&bar[XB_TOP], 1u);
            const unsigned tg = og / nx;
            if (og + 1u == (tg + 1u) * nx) xb_add(&bar[XB_TOPGEN], 1u);
            else XB_SPIN(xb_ld(&bar[XB_TOPGEN]) == tg, bar);
            __builtin_amdgcn_fence(__ATOMIC_ACQUIRE, "agent");
            xb_add(&bar[XB_XGEN(b.x)], 1u);
            asm volatile("s_waitcnt vmcnt(0)" ::: "memory");
        } else {
            XB_SPIN(xb_ld(&bar[XB_XGEN(b.x)]) == gen, bar);
            __builtin_amdgcn_fence(__ATOMIC_ACQUIRE, "agent");
            asm volatile("s_waitcnt vmcnt(0)" ::: "memory");
        }
    }
    __syncthreads();
}
struct Frame {
    LAS unsigned char* lds;
    volatile LAS unsigned* MISC;
    gu32* ctl;
    int tid, lane, wave;
    int vcu, G;
    float* out;
    unsigned char* ws;
};
__device__ __forceinline__ float wave_sum(float v) {
#pragma unroll
    for (int o = 1; o < 64; o <<= 1) v += __shfl_xor(v, o);
    return v;
}
__device__ __forceinline__ int win_map(int n) {
    if (n < 3072) return n;
    if (n < 3088) return 11264 + (n - 3072);
    if (n < 7184) return n - 16;
    if (n < 7216) return 11264 + 16 + (n - 7184);
    return n - 48;
}
__device__ __forceinline__ void tr_item(const float* W, int K, int N, bf16* WT, LAS float* scr, int item, int lane, bool remap) {
    const int nblk = (N + 31) / 32, kb = item / nblk, nb = item % nblk, k0 = 64 * kb, n0 = 32 * nb;
    const int nn = n0 + (lane & 31); const bool okc = nn < N;
#pragma unroll 8
    for (int i = 0; i < 32; ++i) { const int kk = 2 * i + (lane >> 5); scr[kk * 33 + (lane & 31)] = okc ? W[(size_t)(k0 + kk) * N + nn] : 0.f; }
    LDS_WAIT(); asm volatile("" ::: "memory");
    const int c = lane & 7;
#pragma unroll
    for (int j = 0; j < 4; ++j) { const int n = (lane >> 3) + 8 * j; const LAS float* s = scr + (8 * c) * 33 + n;
        v4u o; o.x = pk2(s[0 * 33], s[1 * 33]); o.y = pk2(s[2 * 33], s[3 * 33]); o.z = pk2(s[4 * 33], s[5 * 33]); o.w = pk2(s[6 * 33], s[7 * 33]);
        if (n0 + n < N) { const int row = remap ? win_map(n0 + n) : (n0 + n); *(v4u*)(WT + (size_t)row * K + k0 + 8 * c) = o; } }
    LDS_WAIT(); asm volatile("" ::: "memory");
}
__device__ __forceinline__ void rms_row_bf16(int lane, const float* xrow, const float* g, bf16* orow) {
    const f32x4* xr = (const f32x4*)xrow + lane; const f32x4* gr = (const f32x4*)g + lane;
    f32x4 v[8]; float s = 0.f;
#pragma unroll
    for (int j = 0; j < 8; ++j) { v[j] = xr[64 * j]; s += (v[j].x * v[j].x + v[j].y * v[j].y) + (v[j].z * v[j].z + v[j].w * v[j].w); }
    const float r = 1.0f / sqrtf(wave_sum(s) * (1.f / 2048.f) + RMS_EPS);
    v2u* o8 = (v2u*)orow + lane;
#pragma unroll
    for (int j = 0; j < 8; ++j) { const f32x4 gg = gr[64 * j]; v2u w; w.x = pk2(v[j].x * r * gg.x, v[j].y * r * gg.y); w.y = pk2(v[j].z * r * gg.z, v[j].w * r * gg.w); o8[64 * j] = w; }
}
__device__ __forceinline__ void rms_row_f32(int lane, const float* xrow, const float* g, float* orow) {
    const f32x4* xr = (const f32x4*)xrow + lane; const f32x4* gr = (const f32x4*)g + lane;
    f32x4 v[8]; float s = 0.f;
#pragma unroll
    for (int j = 0; j < 8; ++j) { v[j] = xr[64 * j]; s += (v[j].x * v[j].x + v[j].y * v[j].y) + (v[j].z * v[j].z + v[j].w * v[j].w); }
    const float r = 1.0f / sqrtf(wave_sum(s) * (1.f / 2048.f) + RMS_EPS);
    f32x4* o = (f32x4*)orow + lane;
#pragma unroll
    for (int j = 0; j < 8; ++j) { const f32x4 gg = gr[64 * j]; o[64 * j] = (v[j] * r) * gg; }
}

__device__ __forceinline__ void p0_prologue(Frame& F, const float* x, const float* n1g, const float* w_in, const float* w_bm, const float* w_bd, const float* w_out) {
    LAS float* scr = (LAS float*)(F.lds + F.wave * 16384);
    const int gw = F.vcu * NWAVES + F.wave, NGW = F.G * NWAVES;
    bf16* WIN = (bf16*)(F.ws + WS_WIN); bf16* WBM = (bf16*)(F.ws + WS_WBM); bf16* WBD = (bf16*)(F.ws + WS_WBD); bf16* WOUT = (bf16*)(F.ws + WS_WOUT); bf16* XN = (bf16*)(F.ws + WS_XN);
    constexpr int I_IN = (DM / 64) * ((NPROJ_IN + 31) / 32), I_B = (1024 / 64) * (DM / 32), I_O = (DM / 64) * (DM / 32);
    constexpr int NITEMS = I_IN + 2 * I_B + I_O;
    for (int it = gw; it < NITEMS; it += NGW) {
        int r = it;
        if (r < I_IN) { tr_item(w_in, DM, NPROJ_IN, WIN, scr, r, F.lane, true); continue; } r -= I_IN;
        if (r < I_B) { tr_item(w_bm, 1024, DM, WBM, scr, r, F.lane, false); continue; } r -= I_B;
        if (r < I_B) { tr_item(w_bd, 1024, DM, WBD, scr, r, F.lane, false); continue; } r -= I_B;
        tr_item(w_out, DM, DM, WOUT, scr, r, F.lane, false);
    }
    { v4u* z = (v4u*)(WIN + (size_t)(11264 + 48) * DM); const int nz = (NPROJ_PAD - 11264 - 48) * DM / 8;
      for (int i = gw * 64 + F.lane; i < nz; i += NGW * 64) z[i] = (v4u){0u, 0u, 0u, 0u}; }
    for (int m = gw; m < MROWS; m += NGW) rms_row_bf16(F.lane, x + (size_t)m * DM, n1g, XN + (size_t)m * DM);
}

__device__ __forceinline__ void p2_conv(Frame& F, const float* convw) {
    const int gw = F.vcu * NWAVES + F.wave, NGW = F.G * NWAVES, lane = F.lane;
    const bf16* PROJ = (const bf16*)(F.ws + WS_PROJ);
    bf16* DQ = (bf16*)(F.ws + WS_DQ); bf16* DK = (bf16*)(F.ws + WS_DK); bf16* DV = (bf16*)(F.ws + WS_DV);
    constexpr int NIT = 24 * (MROWS / 8);
    for (int it = gw; it < NIT; it += NGW) {
        const int gI = it % 24, tb8 = it / 24, m0 = tb8 * 8, b = m0 >> 11, t0 = m0 & 2047;
        const int c0 = gI * 128;
        const bf16* src = PROJ + (size_t)(12 + (c0 >> 8)) * BLK + (c0 & 255) + 2 * lane;
        float x0[12], x1[12];
#pragma unroll
        for (int i = 0; i < 12; ++i) { const int tp = t0 - 2 + i; unsigned wv = 0u;
            if (tp >= 0 && tp < SEQ) wv = *(const unsigned*)(src + (size_t)(b * SEQ + tp) * 256);
            x0[i] = bflo(wv); x1[i] = bfhi(wv); }
        float cw0[5], cw1[5];
#pragma unroll
        for (int i = 0; i < 5; ++i) { const float* cp = convw + (size_t)i * 3072 + c0 + 2 * lane; cw0[i] = cp[0]; cw1[i] = cp[1]; }
        bf16* dst = (gI < 8 ? DQ : (gI < 16 ? DK : DV)) + (size_t)m0 * 1024 + (c0 & 1023) + 2 * lane;
#pragma unroll
        for (int o = 0; o < 8; ++o) {
            float y0 = 0.f, y1 = 0.f;
#pragma unroll
            for (int i = 0; i < 5; ++i) { y0 += cw0[i] * x0[o + i]; y1 += cw1[i] * x1[o + i]; }
            float s0 = y0 / (1.0f + expf(-y0)), s1 = y1 / (1.0f + expf(-y1));
            if (gI < 16) { const float ss = wave_sum(s0 * s0 + s1 * s1); float r = 1.0f / sqrtf(ss + 1e-6f); if (gI < 8) r *= 0.08838834764831845f; s0 *= r; s1 *= r; }
            *(unsigned*)(dst + (size_t)o * 1024) = pk2(s0, s1);
        }
    }
}

constexpr int ML_QP = 0, ML_KS = 25600, ML_VS = 43008, ML_KWT = 60416, ML_VC = 78848, ML_VC_BYTES = 57600, ML_VEC = 136448;
constexpr float ML_SCALE = 0.08838834764831845f;
__device__ __forceinline__ void mlstm_unit(Frame& F, int unit, const float* m_ib, const float* m_fb) {
    const int tid = F.tid, lane = F.lane, w = F.wave, fr = lane & 15, fq = lane >> 4;
    const int half = unit & 1, dir = (unit >> 1) & 1, h = (unit >> 2) & 3, b = unit >> 4;
    LAS unsigned char* L = F.lds;
    LAS float* vec = (LAS float*)(L + ML_VEC);
    for (int i = tid; i < ML_VC_BYTES / 16; i += 512) ((LAS v4u*)(L + ML_VC))[i] = (v4u){0u, 0u, 0u, 0u};
    __syncthreads();
    if (tid < 32) ((LAS unsigned*)(L + ML_VC + 128 * 400))[tid] = 0x3f803f80u;
    f32x4 accS[9];
#pragma unroll
    for (int t = 0; t < 9; ++t) accS[t] = (f32x4){0.f, 0.f, 0.f, 0.f};
    float m_st = -1e30f;
    const bf16* PROJ = (const bf16*)(F.ws + WS_PROJ);
    const float* GATES = (const float*)(F.ws + WS_GATES);
    const bf16* Qg = PROJ + (size_t)(h >> 1) * BLK + (h & 1) * 128;
    const bf16* Kg = PROJ + (size_t)(2 + (h >> 1)) * BLK + (h & 1) * 128;
    const bf16* Vg = PROJ + (size_t)(4 + h) * BLK + half * 128;
    bf16* Hout = (bf16*)(F.ws + WS_HM) + (size_t)dir * MROWS * 1024 + h * 256 + half * 128;
    const float ib = m_ib[dir * 4 + h], fb = m_fb[dir * 4 + h];
    const int sr = tid >> 4, sc = tid & 15;
    for (int j = 0; j < 32; ++j) {
        v4u q[2], k[2], v[2];
#pragma unroll
        for (int p = 0; p < 2; ++p) { const int tt = j * 64 + sr + 32 * p, t = dir ? (SEQ - 1 - tt) : tt; const size_t mrow = (size_t)(b * SEQ + t);
            q[p] = *(const v4u*)(Qg + mrow * 256 + sc * 8); k[p] = *(const v4u*)(Kg + mrow * 256 + sc * 8); v[p] = *(const v4u*)(Vg + mrow * 256 + sc * 8); }
        if (w == 0) {
            const int tt = j * 64 + lane, t = dir ? (SEQ - 1 - tt) : tt; const size_t mrow = (size_t)(b * SEQ + t);
            const float ig = GATES[mrow * 64 + dir * 4 + h] + ib;
            const float fp = GATES[mrow * 64 + 8 + dir * 4 + h] + fb;
            const float lf = fp >= 0.f ? -log1pf(expf(-fp)) : fp - log1pf(expf(fp));
            float bc = lf;
#pragma unroll
            for (int o = 1; o < 64; o <<= 1) { const float t2 = __shfl_up(bc, o); if (lane >= o) bc += t2; }
            const float a = ig - bc;
            float am = a;
#pragma unroll
            for (int o = 1; o < 64; o <<= 1) { const float t2 = __shfl_up(am, o); if (lane >= o) am = fmaxf(am, t2); }
            const float Ml = fmaxf(m_st, am);
            const float M63 = __shfl(Ml, 63), bl = __shfl(bc, 63);
            vec[lane] = a; vec[64 + lane] = Ml; vec[128 + lane] = expf(-(bc + Ml)); vec[192 + lane] = expf(m_st - Ml) * ML_SCALE; vec[256 + lane] = expf(a - M63);
            if (lane == 0) vec[320] = expf(m_st - M63);
            m_st = bl + M63;
        }
#pragma unroll
        for (int p = 0; p < 2; ++p) { const int r = sr + 32 * p;
            *(LAS v4u*)(L + ML_QP + r * 400 + 128 + sc * 16) = q[p]; *(LAS v4u*)(L + ML_KS + r * 272 + sc * 16) = k[p]; *(LAS v4u*)(L + ML_VS + r * 272 + sc * 16) = v[p]; }
        __syncthreads();
        {
            const int s = tid & 63; const float ws = vec[256 + s];
#pragma unroll
            for (int p = 0; p < 2; ++p) { const int c = (tid >> 6) + 8 * p;
                const v4u kk = *(const LAS v4u*)(L + ML_KS + s * 272 + c * 16), vv = *(const LAS v4u*)(L + ML_VS + s * 272 + c * 16);
#pragma unroll
                for (int i = 0; i < 8; ++i) {
                    *(LAS unsigned short*)(L + ML_KWT + (c * 8 + i) * 144 + s * 2) = (unsigned short)f2bf(bfel(kk, i) * ws);
                    const unsigned wv = vv[i >> 1]; *(LAS unsigned short*)(L + ML_VC + (c * 8 + i) * 400 + s * 2) = (unsigned short)((i & 1) ? (wv >> 16) : (wv & 0xffffu)); } }
        }
        __syncthreads();
        {
            const int lt = w & 3, l = lt * 16 + fr; const float Ml = vec[64 + l];
#pragma unroll
            for (int s2 = 0; s2 < 2; ++s2) { const int st = (w >> 2) * 2 + s2;
                f32x4 acc = (f32x4){0.f, 0.f, 0.f, 0.f};
                if (st <= lt) {
#pragma unroll
                    for (int ks = 0; ks < 4; ++ks) acc = MFMA16(ldfrag(L + ML_KS + (st * 16 + fr) * 272 + ks * 64 + fq * 16), ldfrag(L + ML_QP + l * 400 + 128 + ks * 64 + fq * 16), acc); }
                f32x4 pv;
#pragma unroll
                for (int r = 0; r < 4; ++r) { const int s = st * 16 + 4 * fq + r; pv[r] = (s <= l) ? acc[r] * ML_SCALE * expf(fminf(vec[s] - Ml, 0.f)) : 0.f; }
                st8(L + ML_QP + l * 400 + (st * 16 + 4 * fq) * 2, pv); }
        }
        __syncthreads();
        {
            const int lt = w & 3, dq = w >> 2, l = lt * 16 + fr;
            f32x4 aPV[5], aQC[5];
#pragma unroll
            for (int t = 0; t < 5; ++t) { aPV[t] = (f32x4){0.f, 0.f, 0.f, 0.f}; aQC[t] = (f32x4){0.f, 0.f, 0.f, 0.f}; }
            bf16x8 bq[6];
#pragma unroll
            for (int ks = 0; ks < 6; ++ks) bq[ks] = ldfrag(L + ML_QP + l * 400 + ks * 64 + fq * 16);
#pragma unroll
            for (int t = 0; t < 5; ++t) { const int tile = (t < 4) ? (dq * 4 + t) : 8;
#pragma unroll
                for (int ks = 0; ks < 6; ++ks) { const bf16x8 a = ldfrag(L + ML_VC + (tile * 16 + fr) * 400 + ks * 64 + fq * 16);
                    if (ks < 2) aPV[t] = MFMA16(a, bq[ks], aPV[t]); else aQC[t] = MFMA16(a, bq[ks], aQC[t]); } }
            const float wi = vec[192 + l], eml = vec[128 + l];
            float den = aPV[4][0] + wi * aQC[4][0];
            den = __shfl(den, fr);
            const float inv = 1.0f / fmaxf(fabsf(den), eml);
            const int tt = j * 64 + l, t = dir ? (SEQ - 1 - tt) : tt; const size_t mrow = (size_t)(b * SEQ + t);
#pragma unroll
            for (int t4 = 0; t4 < 4; ++t4) { const f32x4 nv = (aPV[t4] + aQC[t4] * wi) * inv; v2u o; o.x = pk2(nv[0], nv[1]); o.y = pk2(nv[2], nv[3]);
                *(v2u*)(Hout + mrow * 1024 + (dq * 4 + t4) * 16 + 4 * fq) = o; }
        }
        {
            const float decay = vec[320];
            bf16x8 ak[2];
#pragma unroll
            for (int ks = 0; ks < 2; ++ks) ak[ks] = ldfrag(L + ML_KWT + (w * 16 + fr) * 144 + ks * 64 + fq * 16);
#pragma unroll
            for (int t = 0; t < 9; ++t) { accS[t] = accS[t] * decay;
#pragma unroll
                for (int ks = 0; ks < 2; ++ks) accS[t] = MFMA16(ak[ks], ldfrag(L + ML_VC + (t * 16 + fr) * 400 + ks * 64 + fq * 16), accS[t]); }
        }
        __syncthreads();
#pragma unroll
        for (int t = 0; t < 9; ++t) st8(L + ML_VC + (t * 16 + fr) * 400 + 128 + (w * 16 + 4 * fq) * 2, accS[t]);
    }
    __syncthreads();
}

constexpr int DN_ST = 0, DN_QS = 34816, DN_AT = 52224, DN_KDT = 61440, DN_VBT = 79872, DN_KBT = 98304, DN_KS = 116736, DN_VS = 134144, DN_VEC = 151552;
constexpr int DN_PA = DN_KS, DN_PT = DN_KS + 9216, DN_XA = DN_KS + 18432, DN_WL = DN_KBT;
__device__ __forceinline__ void delta_unit(Frame& F, int unit, const float* d_alog, const float* d_dtb) {
    const int tid = F.tid, lane = F.lane, w = F.wave, fr = lane & 15, fq = lane >> 4;
    const int dir = unit & 1, h = (unit >> 1) & 7, b = unit >> 4;
    LAS unsigned char* L = F.lds;
    LAS float* vec = (LAS float*)(L + DN_VEC);
    for (int i = tid; i < 34816 / 16; i += 512) ((LAS v4u*)(L + DN_ST))[i] = (v4u){0u, 0u, 0u, 0u};
    f32x4 accS[8];
#pragma unroll
    for (int t = 0; t < 8; ++t) accS[t] = (f32x4){0.f, 0.f, 0.f, 0.f};
    const float* GATES = (const float*)(F.ws + WS_GATES);
    const bf16* Qg = (const bf16*)(F.ws + WS_DQ) + h * 128; const bf16* Kg = (const bf16*)(F.ws + WS_DK) + h * 128; const bf16* Vg = (const bf16*)(F.ws + WS_DV) + h * 128;
    bf16* Oout = (bf16*)(F.ws + (dir ? WS_ODB : WS_ODF)) + h * 128;
    const float Aexp = expf(d_alog[dir * 8 + h]), dtb = d_dtb[dir * 8 + h];
    const int sr = tid >> 4, sc = tid & 15;
    const int tb = w & 3, ta0 = (w >> 2) * 2;
    for (int j = 0; j < 32; ++j) {
        v4u q[2], k[2], v[2];
#pragma unroll
        for (int p = 0; p < 2; ++p) { const int tt = j * 64 + sr + 32 * p, t = dir ? (SEQ - 1 - tt) : tt; const size_t mrow = (size_t)(b * SEQ + t);
            q[p] = *(const v4u*)(Qg + mrow * 1024 + sc * 8); k[p] = *(const v4u*)(Kg + mrow * 1024 + sc * 8); v[p] = *(const v4u*)(Vg + mrow * 1024 + sc * 8); }
        if (w == 0) {
            const int tt = j * 64 + lane, t = dir ? (SEQ - 1 - tt) : tt; const size_t mrow = (size_t)(b * SEQ + t);
            const float ap = GATES[mrow * 64 + 16 + dir * 8 + h] + dtb, bp = GATES[mrow * 64 + 32 + dir * 8 + h];
            const float sp = ap > 0.f ? ap + log1pf(expf(-ap)) : log1pf(expf(ap));
            const float g = -Aexp * sp, beta = 1.0f / (1.0f + expf(-bp));
            float gc = g;
#pragma unroll
            for (int o = 1; o < 64; o <<= 1) { const float t2 = __shfl_up(gc, o); if (lane >= o) gc += t2; }
            const float gl = __shfl(gc, 63);
            vec[lane] = gc; vec[64 + lane] = beta; vec[128 + lane] = expf(gc); vec[192 + lane] = expf(gl - gc);
            if (lane == 0) vec[256] = expf(gl);
        }
#pragma unroll
        for (int p = 0; p < 2; ++p) { const int r = sr + 32 * p;
            *(LAS v4u*)(L + DN_QS + r * 272 + sc * 16) = q[p]; *(LAS v4u*)(L + DN_KS + r * 272 + sc * 16) = k[p]; *(LAS v4u*)(L + DN_VS + r * 272 + sc * 16) = v[p]; }
        __syncthreads();
        {
            const int s = tid & 63; const float bs = vec[64 + s], fkd = vec[192 + s], fkb = bs * vec[128 + s];
#pragma unroll
            for (int p = 0; p < 2; ++p) { const int c = (tid >> 6) + 8 * p;
                const v4u kk = *(const LAS v4u*)(L + DN_KS + s * 272 + c * 16), vv = *(const LAS v4u*)(L + DN_VS + s * 272 + c * 16);
#pragma unroll
                for (int i = 0; i < 8; ++i) { const float kf = bfel(kk, i), vf = bfel(vv, i); const int ro = (c * 8 + i) * 144 + s * 2;
                    *(LAS unsigned short*)(L + DN_KDT + ro) = (unsigned short)f2bf(kf * fkd);
                    *(LAS unsigned short*)(L + DN_KBT + ro) = (unsigned short)f2bf(kf * fkb);
                    *(LAS unsigned short*)(L + DN_VBT + ro) = (unsigned short)f2bf(vf * bs); } }
        }
        __syncthreads();
        f32x4 accX[2];
        {
            f32x4 aKK[2], aQK[2];
#pragma unroll
            for (int x = 0; x < 2; ++x) { aKK[x] = (f32x4){0.f, 0.f, 0.f, 0.f}; aQK[x] = (f32x4){0.f, 0.f, 0.f, 0.f}; }
#pragma unroll
            for (int ks = 0; ks < 4; ++ks) {
                const bf16x8 kb = ldfrag(L + DN_KS + (tb * 16 + fr) * 272 + ks * 64 + fq * 16), qb = ldfrag(L + DN_QS + (tb * 16 + fr) * 272 + ks * 64 + fq * 16);
#pragma unroll
                for (int x = 0; x < 2; ++x) { const bf16x8 ka = ldfrag(L + DN_KS + ((ta0 + x) * 16 + fr) * 272 + ks * 64 + fq * 16);
                    aKK[x] = MFMA16(ka, kb, aKK[x]); aQK[x] = MFMA16(ka, qb, aQK[x]); } }
            __syncthreads();
            const int bI = tb * 16 + fr; const float gcb = vec[bI], betab = vec[64 + bI];
#pragma unroll
            for (int x = 0; x < 2; ++x) { const int a0 = (ta0 + x) * 16 + 4 * fq;
                f32x4 vat, vna, vnt, vxa;
#pragma unroll
                for (int r = 0; r < 4; ++r) { const int aI = a0 + r; const float gca = vec[aI], betaa = vec[64 + aI];
                    vat[r] = (aI <= bI) ? aQK[x][r] * expf(fminf(gcb - gca, 0.f)) : 0.f;
                    vna[r] = (aI < bI) ? -betab * aKK[x][r] * expf(fminf(gcb - gca, 0.f)) : 0.f;
                    vnt[r] = (bI < aI) ? -betaa * aKK[x][r] * expf(fminf(gca - gcb, 0.f)) : 0.f;
                    vxa[r] = vna[r] + ((aI == bI) ? 1.0f : 0.f); }
                accX[x] = vxa;
                st8(L + DN_AT + bI * 144 + a0 * 2, vat); st8(L + DN_PA + bI * 144 + a0 * 2, vna); st8(L + DN_PT + bI * 144 + a0 * 2, vnt); st8(L + DN_XA + bI * 144 + a0 * 2, vxa); }
        }
        __syncthreads();
        for (int kk = 1; kk <= 6; ++kk) {
            f32x4 aPA[2], aPT[2];
#pragma unroll
            for (int x = 0; x < 2; ++x) { aPA[x] = (f32x4){0.f, 0.f, 0.f, 0.f}; aPT[x] = (f32x4){0.f, 0.f, 0.f, 0.f}; }
#pragma unroll
            for (int ks = 0; ks < 2; ++ks) {
                const int ko = ks * 64 + fq * 16;
                const bf16x8 pa_b = ldfrag(L + DN_PA + (tb * 16 + fr) * 144 + ko), pt_b = ldfrag(L + DN_PT + (tb * 16 + fr) * 144 + ko), xa_b = ldfrag(L + DN_XA + (tb * 16 + fr) * 144 + ko);
#pragma unroll
                for (int x = 0; x < 2; ++x) {
                    const bf16x8 pt_a = ldfrag(L + DN_PT + ((ta0 + x) * 16 + fr) * 144 + ko), pa_a = ldfrag(L + DN_PA + ((ta0 + x) * 16 + fr) * 144 + ko);
                    if (kk >= 2) accX[x] = MFMA16(pt_a, xa_b, accX[x]);
                    if (kk <= 5) { aPA[x] = MFMA16(pt_a, pa_b, aPA[x]); aPT[x] = MFMA16(pa_a, pt_b, aPT[x]); } } }
            __syncthreads();
            const int bI = tb * 16 + fr;
#pragma unroll
            for (int x = 0; x < 2; ++x) { const int a0 = (ta0 + x) * 16 + 4 * fq;
                if (kk >= 2) st8(L + DN_XA + bI * 144 + a0 * 2, accX[x]);
                if (kk <= 5) { st8(L + DN_PA + bI * 144 + a0 * 2, aPA[x]); st8(L + DN_PT + bI * 144 + a0 * 2, aPT[x]); } }
            __syncthreads();
        }
        f32x4 accU[4];
        {
            f32x4 accW[4];
#pragma unroll
            for (int lt = 0; lt < 4; ++lt) { accU[lt] = (f32x4){0.f, 0.f, 0.f, 0.f}; accW[lt] = (f32x4){0.f, 0.f, 0.f, 0.f}; }
#pragma unroll
            for (int ks = 0; ks < 2; ++ks) { const int ko = ks * 64 + fq * 16;
                const bf16x8 vb = ldfrag(L + DN_VBT + (w * 16 + fr) * 144 + ko), kb = ldfrag(L + DN_KBT + (w * 16 + fr) * 144 + ko);
#pragma unroll
                for (int lt = 0; lt < 4; ++lt) { const bf16x8 tf = ldfrag(L + DN_XA + (lt * 16 + fr) * 144 + ko);
                    accU[lt] = MFMA16(tf, vb, accU[lt]); accW[lt] = MFMA16(kb, tf, accW[lt]); } }
            __syncthreads();
#pragma unroll
            for (int lt = 0; lt < 4; ++lt) { const f32x4 nw = -accW[lt]; st8(L + DN_WL + (lt * 16 + fr) * 272 + (w * 16 + 4 * fq) * 2, nw); }
        }
        __syncthreads();
        {
#pragma unroll
            for (int ks = 0; ks < 4; ++ks) { const int ko = ks * 64 + fq * 16;
                const bf16x8 sb = ldfrag(L + DN_ST + (w * 16 + fr) * 272 + ko);
#pragma unroll
                for (int lt = 0; lt < 4; ++lt) accU[lt] = MFMA16(ldfrag(L + DN_WL + (lt * 16 + fr) * 272 + ko), sb, accU[lt]); }
#pragma unroll
            for (int lt = 0; lt < 4; ++lt) st8(L + DN_VBT + (w * 16 + fr) * 144 + (lt * 16 + 4 * fq) * 2, accU[lt]);
        }
        __syncthreads();
        {
            const int lt = w & 3, dq = w >> 2, l = lt * 16 + fr;
            f32x4 aOA[4], aOQ[4];
#pragma unroll
            for (int t = 0; t < 4; ++t) { aOA[t] = (f32x4){0.f, 0.f, 0.f, 0.f}; aOQ[t] = (f32x4){0.f, 0.f, 0.f, 0.f}; }
#pragma unroll
            for (int ks = 0; ks < 2; ++ks) { const int ko = ks * 64 + fq * 16; const bf16x8 ab = ldfrag(L + DN_AT + l * 144 + ko);
#pragma unroll
                for (int t = 0; t < 4; ++t) aOA[t] = MFMA16(ldfrag(L + DN_VBT + ((dq * 4 + t) * 16 + fr) * 144 + ko), ab, aOA[t]); }
#pragma unroll
            for (int ks = 0; ks < 4; ++ks) { const int ko = ks * 64 + fq * 16; const bf16x8 qb = ldfrag(L + DN_QS + l * 272 + ko);
#pragma unroll
                for (int t = 0; t < 4; ++t) aOQ[t] = MFMA16(ldfrag(L + DN_ST + ((dq * 4 + t) * 16 + fr) * 272 + ko), qb, aOQ[t]); }
            const float egl_l = vec[128 + l];
            const int tt = j * 64 + l, t = dir ? (SEQ - 1 - tt) : tt; const size_t mrow = (size_t)(b * SEQ + t);
#pragma unroll
            for (int t4 = 0; t4 < 4; ++t4) { const f32x4 ov = aOA[t4] + aOQ[t4] * egl_l; v2u o; o.x = pk2(ov[0], ov[1]); o.y = pk2(ov[2], ov[3]);
                *(v2u*)(Oout + mrow * 1024 + (dq * 4 + t4) * 16 + 4 * fq) = o; }
            const float egl = vec[256];
            bf16x8 ak[2];
#pragma unroll
            for (int ks = 0; ks < 2; ++ks) ak[ks] = ldfrag(L + DN_KDT + (w * 16 + fr) * 144 + ks * 64 + fq * 16);
#pragma unroll
            for (int t8 = 0; t8 < 8; ++t8) { accS[t8] = accS[t8] * egl;
#pragma unroll
                for (int ks = 0; ks < 2; ++ks) accS[t8] = MFMA16(ak[ks], ldfrag(L + DN_VBT + (t8 * 16 + fr) * 144 + ks * 64 + fq * 16), accS[t8]); }
        }
        __syncthreads();
#pragma unroll
        for (int t8 = 0; t8 < 8; ++t8) st8(L + DN_ST + (t8 * 16 + fr) * 272 + (w * 16 + 4 * fq) * 2, accS[t8]);
    }
    __syncthreads();
}

__device__ __forceinline__ void p4_combine(Frame& F, const float* m_ng, const float* d_ng) {
    const int gw = F.vcu * NWAVES + F.wave, NGW = F.G * NWAVES, lane = F.lane;
    const bf16* PROJ = (const bf16*)(F.ws + WS_PROJ);
    const bf16* HMf = (const bf16*)(F.ws + WS_HM); const bf16* HMb = HMf + (size_t)MROWS * 1024;
    const bf16* ODf = (const bf16*)(F.ws + WS_ODF); const bf16* ODb = (const bf16*)(F.ws + WS_ODB);
    bf16* YM = (bf16*)(F.ws + WS_YM); bf16* YD = (bf16*)(F.ws + WS_YD);
    for (int m = gw; m < MROWS; m += NGW) {
        v2u hf[4], hb[4], mo[4]; unsigned of[8], ob[8], dz[8];
#pragma unroll
        for (int h = 0; h < 4; ++h) { hf[h] = *(const v2u*)(HMf + (size_t)m * 1024 + h * 256 + 4 * lane); hb[h] = *(const v2u*)(HMb + (size_t)m * 1024 + h * 256 + 4 * lane);
            mo[h] = *(const v2u*)(PROJ + (size_t)(8 + h) * BLK + (size_t)m * 256 + 4 * lane); }
#pragma unroll
        for (int h = 0; h < 8; ++h) { of[h] = *(const unsigned*)(ODf + (size_t)m * 1024 + h * 128 + 2 * lane); ob[h] = *(const unsigned*)(ODb + (size_t)m * 1024 + h * 128 + 2 * lane);
            dz[h] = *(const unsigned*)(PROJ + (size_t)(24 + (h >> 1)) * BLK + (size_t)m * 256 + (h & 1) * 128 + 2 * lane); }
#pragma unroll
        for (int h = 0; h < 4; ++h) {
            const float a0 = bflo(hf[h].x) + bflo(hb[h].x), a1 = bfhi(hf[h].x) + bfhi(hb[h].x), a2 = bflo(hf[h].y) + bflo(hb[h].y), a3 = bfhi(hf[h].y) + bfhi(hb[h].y);
            const float ss = wave_sum((a0 * a0 + a1 * a1) + (a2 * a2 + a3 * a3));
            const float r = 1.0f / sqrtf(ss * (1.f / 256.f) + RMS_EPS);
            const f32x4 g = *(const f32x4*)(m_ng + h * 256 + 4 * lane);
            const float o0 = bflo(mo[h].x), o1 = bfhi(mo[h].x), o2 = bflo(mo[h].y), o3 = bfhi(mo[h].y);
            v2u y; y.x = pk2(a0 * r * g.x / (1.f + expf(-o0)), a1 * r * g.y / (1.f + expf(-o1))); y.y = pk2(a2 * r * g.z / (1.f + expf(-o2)), a3 * r * g.w / (1.f + expf(-o3)));
            *(v2u*)(YM + (size_t)m * 1024 + h * 256 + 4 * lane) = y;
        }
        const float g0 = d_ng[2 * lane], g1 = d_ng[2 * lane + 1];
#pragma unroll
        for (int h = 0; h < 8; ++h) {
            const float a0 = bflo(of[h]) + bflo(ob[h]), a1 = bfhi(of[h]) + bfhi(ob[h]);
            const float ss = wave_sum(a0 * a0 + a1 * a1);
            const float r = 1.0f / sqrtf(ss * (1.f / 128.f) + RMS_EPS);
            const float z0 = bflo(dz[h]), z1 = bfhi(dz[h]);
            *(unsigned*)(YD + (size_t)m * 1024 + h * 128 + 2 * lane) = pk2(a0 * r * g0 * z0 / (1.f + expf(-z0)), a1 * r * g1 * z1 / (1.f + expf(-z1)));
        }
    }
}

__device__ __forceinline__ void p7_norm2(Frame& F, const float* n2g, const float* w_ff1, const float* w_ff2) {
    LAS float* scr = (LAS float*)(F.lds + F.wave * 16384);
    const int gw = F.vcu * NWAVES + F.wave, NGW = F.G * NWAVES;
    bf16* W1T = (bf16*)(F.ws + WS_W1T); bf16* W2T = (bf16*)(F.ws + WS_W2T); bf16* XN2 = (bf16*)(F.ws + WS_XN2);
    constexpr int I_1 = (DM / 64) * (DFF / 32), I_2 = (DFF / 64) * (DM / 32);
    for (int it = gw; it < I_1 + I_2; it += NGW) {
        if (it < I_1) tr_item(w_ff1, DM, DFF, W1T, scr, it, F.lane, false); else tr_item(w_ff2, DFF, DM, W2T, scr, it - I_1, F.lane, false);
    }
    for (int m = gw; m < MROWS; m += NGW) rms_row_bf16(F.lane, F.out + (size_t)m * DM, n2g, XN2 + (size_t)m * DM);
}
__device__ __forceinline__ void p10_final(Frame& F, const float* nfg) {
    const int gw = F.vcu * NWAVES + F.wave, NGW = F.G * NWAVES;
    for (int m = gw; m < MROWS; m += NGW) rms_row_f32(F.lane, F.out + (size_t)m * DM, nfg, F.out + (size_t)m * DM);
}
struct Args { const float* in[17]; float* out; unsigned char* ws; int ph_lo, ph_hi, li, pad; };
__global__ void __launch_bounds__(NWAVES * 64, 2) hybrid_fwd(Args args) {
    extern __shared__ __attribute__((aligned(16))) unsigned char lds[];
    Frame F;
    F.lds = (LAS unsigned char*)lds;
    F.MISC = (volatile LAS unsigned*)(F.lds + MISC_OFF);
    F.tid = threadIdx.x; F.lane = F.tid & 63; F.wave = __builtin_amdgcn_readfirstlane(F.tid >> 6);
    F.G = gridDim.x; { const int bx = blockIdx.x; F.vcu = (F.G % 8 == 0) ? (bx % 8) * (F.G / 8) + bx / 8 : bx; }
    F.ws = args.ws; F.ctl = (gu32*)(args.ws + WS_CTL);
    F.out = args.out;
    if (F.tid < 64) ((LAS unsigned*)(F.lds + MISC_OFF))[F.tid] = 0u;
    __syncthreads();
    XcdBarrier bar; bar.bar = (unsigned*)(F.ctl + CW_BAR); bar.x = 0; bar.st = nullptr;
    if (N_LAUNCHES != PER_PHASE) bar = xcd_barrier_post((unsigned*)(F.ctl + CW_BAR), F.MISC + 8);
#define GRID_BAR() do { if (N_LAUNCHES != PER_PHASE) xcd_barrier(bar); } while (0)
    const int lo = args.ph_lo, hi = args.ph_hi;
#ifndef PHASE_MASK
#define PHASE_MASK 0x7ff
#endif
#define IN(k) (((PHASE_MASK >> (k)) & 1) && lo <= (k) && (k) < hi)
#define BOTH(k) (IN(k) && IN((k) + 1))
    bf16* PROJ = (bf16*)(F.ws + WS_PROJ);

    if (IN(0)) { p0_prologue(F, args.in[0], args.in[1], args.in[2], args.in[10], args.in[11], args.in[12]); if (BOTH(0)) GRID_BAR(); }
    if (IN(1)) {
        pg8::Gemm g{(const bf16*)(F.ws + WS_XN), (const bf16*)(F.ws + WS_WIN), MROWS, NPROJ_PAD, DM}; pg8::StaticOrder S; S.init(MROWS, NPROJ_PAD, F.G, (int)blockIdx.x);
        pg8::EpiProj E{PROJ, (float*)(F.ws + WS_GATES)};
        pg8::gemm_phase<pg8::EpiProj, pg8::StaticOrder, true, true>(F.lds, g, S, E);
        if (BOTH(1)) GRID_BAR();
    }
    if (IN(2)) { p2_conv(F, args.in[6]); if (BOTH(2)) GRID_BAR(); }
    if (IN(3)) {
        const int u = F.vcu;
        if (u < 128) mlstm_unit(F, u, args.in[3], args.in[4]);
        else if (u < 256) delta_unit(F, u - 128, args.in[7], args.in[8]);
        if (BOTH(3)) GRID_BAR();
    }
    if (IN(4)) { p4_combine(F, args.in[5], args.in[9]); if (BOTH(4)) GRID_BAR(); }
    if (IN(5)) {
        pg8::Gemm g{(const bf16*)(F.ws + WS_YM), (const bf16*)(F.ws + WS_WBM), 2 * MROWS, 4096, 1024}; pg8::BranchOrder S; S.init(F.G, (int)blockIdx.x);
        pg8::EpiBranch E{PROJ, (bf16*)(F.ws + WS_MIX)};
        pg8::gemm_phase<pg8::EpiBranch, pg8::BranchOrder, true, true>(F.lds, g, S, E);
        if (BOTH(5)) GRID_BAR();
    }
    if (IN(6)) {
        pg8::Gemm g{(const bf16*)(F.ws + WS_MIX), (const bf16*)(F.ws + WS_WOUT), MROWS, DM, DM}; pg8::StaticOrder S; S.init(MROWS, DM, F.G, (int)blockIdx.x);
        pg8::EpiResid E{args.in[0], F.out, DM};
        pg8::gemm_phase<pg8::EpiResid, pg8::StaticOrder, true, true>(F.lds, g, S, E);
        if (BOTH(6)) GRID_BAR();
    }
    if (IN(7)) { p7_norm2(F, args.in[13], args.in[14], args.in[15]); if (BOTH(7)) GRID_BAR(); }
    if (IN(8)) {
        pg8::Gemm g{(const bf16*)(F.ws + WS_XN2), (const bf16*)(F.ws + WS_W1T), MROWS, DFF, DM}; pg8::StaticOrder S; S.init(MROWS, DFF, F.G, (int)blockIdx.x);
        pg8::EpiRelu2 E{(bf16*)(F.ws + WS_HFF), DFF};
        pg8::gemm_phase<pg8::EpiRelu2, pg8::StaticOrder, true, true>(F.lds, g, S, E);
        if (BOTH(8)) GRID_BAR();
    }
    if (IN(9)) {
        pg8::Gemm g{(const bf16*)(F.ws + WS_HFF), (const bf16*)(F.ws + WS_W2T), MROWS, DM, DFF}; pg8::StaticOrder S; S.init(MROWS, DM, F.G, (int)blockIdx.x);
        pg8::EpiResid E{F.out, F.out, DM};
        pg8::gemm_phase<pg8::EpiResid, pg8::StaticOrder, true, true>(F.lds, g, S, E);
        if (BOTH(9)) GRID_BAR();
    }
    if (IN(10)) { p10_final(F, args.in[16]); }
#undef IN
#undef BOTH
}

extern "C" void kernel_launch(void* const* d_in, const int* in_sizes, int n_in, void* d_out, int out_size, void* d_ws, size_t ws_size, hipStream_t stream) {
    static int grid = 0;
    if (grid == 0) {
        if (n_in != 17 || in_sizes[0] != MROWS * DM || out_size != MROWS * DM || ws_size < WS_END) {
            fprintf(stderr, "kernel_launch: unexpected problem: n_in %d, in0 %d, out %d, ws %zu (need %zu); nothing launched\n", n_in, n_in > 0 ? in_sizes[0] : -1, out_size, ws_size, (size_t)WS_END); grid = -1; return; }
        int dev = 0, cus = 0, per_cu = 0;
        if (hipGetDevice(&dev) != hipSuccess || hipDeviceGetAttribute(&cus, hipDeviceAttributeMultiprocessorCount, dev) != hipSuccess) { fprintf(stderr, "kernel_launch: device query failed\n"); grid = -1; return; }
        if (hipFuncSetAttribute((const void*)hybrid_fwd, hipFuncAttributeMaxDynamicSharedMemorySize, LDS_BYTES) != hipSuccess) { fprintf(stderr, "kernel_launch: hipFuncSetAttribute failed\n"); grid = -1; return; }
        if (hipOccupancyMaxActiveBlocksPerMultiprocessor(&per_cu, (const void*)hybrid_fwd, NWAVES * 64, LDS_BYTES) != hipSuccess || per_cu < 1)
            fprintf(stderr, "kernel_launch: note: occupancy query reports %d workgroups per CU\n", per_cu);
        (void)hipGetLastError();
        grid = cus;
    }
    if (grid < 0) return;
    if (hipMemsetAsync((char*)d_ws + WS_CTL, 0, CTL_ZERO_BYTES, stream) != hipSuccess) { fprintf(stderr, "kernel_launch: memset failed\n"); return; }
    Args a{};
    for (int i = 0; i < 17; ++i) a.in[i] = (const float*)d_in[i];
    a.out = (float*)d_out; a.ws = (unsigned char*)d_ws;
    for (int li = 0; li < N_LAUNCHES; ++li) {
        a.ph_lo = (N_LAUNCHES == PER_PHASE) ? li : 0; a.ph_hi = (N_LAUNCHES == PER_PHASE) ? li + 1 : PER_PHASE; a.li = li;
        hipLaunchKernelGGL(hybrid_fwd, dim3(grid), dim3(NWAVES * 64), LDS_BYTES, stream, a);
        const hipError_t le = hipPeekAtLastError();
        if (le != hipSuccess) { fprintf(stderr, "kernel_launch: launch %d failed: %s\n", li, hipGetErrorName(le)); break; }
    }
}
```

```cpp
#include <hip/hip_runtime.h>
#include <cstdio>
#include <cstdint>

#ifndef MK_N_LAUNCHES
#define MK_N_LAUNCHES 1
#endif
constexpr int MROWS = 16384;
namespace pg8 {
#define PG8_LAS __attribute__((address_space(3)))
typedef unsigned short bf16_t;
typedef short bf16x8 __attribute__((ext_vector_type(8)));
typedef float f32x4 __attribute__((ext_vector_type(4)));
typedef unsigned u32x4 __attribute__((ext_vector_type(4)));
constexpr int BM = 256, BK = 64, HALF = 128, HTB = HALF * BK * 2  , STAGE_BYTES = 8 * HTB, NXCD = 8, WGM = 8;

__host__ __device__ __forceinline__ int lds_byte(int r, int c) { const int st = (r >> 4) * 2 + (c >> 5), rr = r & 15, cc = c & 31, ob = rr * 64 + cc * 2; return st * 1024 + (ob ^ (((ob >> 9) & 1) << 5)); }
__host__ __device__ __forceinline__ void stage_rc(int b, int& R, int& C) { const int st = b / 1024, sb = b % 1024, swz = sb ^ (((sb >> 9) & 1) << 5); R = (st >> 1) * 16 + swz / 64; C = (st & 1) * 32 + (swz % 64) / 2; }
__host__ __device__ __forceinline__ int perm32(int rho) { const int n = rho >> 4, i = rho & 15; return 8 * (i >> 2) + 4 * n + (i & 3); }

struct Unit { int pm, pn; };
struct Gemm { const bf16_t* A; const bf16_t* Bt; int M, N, K; };

struct StaticOrder {
    int nM, nN, nwg, G, c;
    __host__ __device__ void init(int M, int N, int G_, int c_) { nM = M / BM; nN = N / BM; nwg = nM * nN; G = G_; c = c_; }
    __host__ __device__ bool next(int i, Unit& u) const {
        const long L = (long)i * G + c; if (L >= nwg) return false;
        int wgid = (int)L; { const int q = nwg / NXCD, r = nwg % NXCD, xcd = wgid % NXCD, off = wgid / NXCD; wgid = (xcd < r ? xcd * (q + 1) : r * (q + 1) + (xcd - r) * q) + off; }
        const int nig = WGM * nN, gid = wgid / nig, fm = gid * WGM, gsz = (nM - fm) < WGM ? (nM - fm) : WGM;
        u.pm = fm + ((wgid % nig) % gsz); u.pn = (wgid % nig) / gsz; return true;
    }
    __device__ __forceinline__ void a_ready(const Unit&) const {}
    __device__ __forceinline__ void done(const Unit&) const {}
};

__device__ __forceinline__ unsigned cvt_pk_bf16(float lo, float hi) { unsigned r; asm volatile("v_cvt_pk_bf16_f32 %0, %1, %2" : "=v"(r) : "v"(lo), "v"(hi)); return r; }
typedef float f32x2 __attribute__((ext_vector_type(2)));
typedef unsigned u32x2 __attribute__((ext_vector_type(2)));
__device__ __forceinline__ float bf_lo(unsigned w) { return __uint_as_float(w << 16); }
__device__ __forceinline__ float bf_hi(unsigned w) { return __uint_as_float(w & 0xffff0000u); }
__device__ __forceinline__ float fsigmoid(float x) { return __builtin_amdgcn_rcpf(1.0f + __expf(-x)); }

struct EpiProj {
    static constexpr bool PERM = true, AFTER_DRAIN = false;
    bf16_t* P; float* gates;
    __device__ __forceinline__ void operator()(const f32x4 (&acc)[2][2][4][2], const Unit& u, int wr, int wc, int fr, int fq) const {
        const int row0 = u.pm * BM + wr * 64 + fr;
        if (u.pn < 44) {
            bf16_t* base = P + (size_t)u.pn * ((size_t)MROWS * 256) + wc * 32 + 8 * fq;
#pragma unroll
            for (int ai = 0; ai < 2; ++ai)
#pragma unroll
                for (int m = 0; m < 4; ++m) { bf16_t* rowp = base + (size_t)(row0 + ai * HALF + m * 16) * 256;
#pragma unroll
                    for (int bj = 0; bj < 2; ++bj) { const f32x4 v0 = acc[ai][bj][m][0], v1 = acc[ai][bj][m][1];
                        u32x4 w; w.x = cvt_pk_bf16(v0[0], v0[1]); w.y = cvt_pk_bf16(v0[2], v0[3]); w.z = cvt_pk_bf16(v1[0], v1[1]); w.w = cvt_pk_bf16(v1[2], v1[3]);
                        *(u32x4*)(rowp + bj * HALF) = w; } }
        } else if (wc < 2) {
#pragma unroll
            for (int ai = 0; ai < 2; ++ai)
#pragma unroll
                for (int m = 0; m < 4; ++m) { float* rp = gates + (size_t)(row0 + ai * HALF + m * 16) * 64 + wc * 32 + 8 * fq;
                    *(f32x4*)rp = acc[ai][0][m][0]; *(f32x4*)(rp + 4) = acc[ai][0][m][1]; }
        }
    }
};

struct EpiBranch {
    static constexpr bool PERM = true, AFTER_DRAIN = false;
    const bf16_t* G; bf16_t* O;
    __device__ __forceinline__ void operator()(const f32x4 (&acc)[2][2][4][2], const Unit& u, int wr, int wc, int fr, int fq) const {
        const int br = u.pn >> 3, pn = u.pn & 7, pm = u.pm & 63;
        const int row0 = pm * BM + wr * 64 + fr, cl = wc * 32 + 8 * fq;
        const bf16_t* gbase = G + (size_t)(28 + 8 * br + pn) * ((size_t)MROWS * 256) + cl;
        bf16_t* obase = O + pn * 256 + cl;
#pragma unroll
        for (int ai = 0; ai < 2; ++ai)
#pragma unroll
            for (int m = 0; m < 4; ++m) { const size_t r = (size_t)(row0 + ai * HALF + m * 16);
#pragma unroll
                for (int bj = 0; bj < 2; ++bj) {
                    const u32x4 gv = *(const u32x4*)(gbase + r * 256 + bj * HALF);
                    const f32x4 a0 = acc[ai][bj][m][0], a1 = acc[ai][bj][m][1];
                    float v[8];
                    v[0] = a0[0] * fsigmoid(bf_lo(gv.x)); v[1] = a0[1] * fsigmoid(bf_hi(gv.x)); v[2] = a0[2] * fsigmoid(bf_lo(gv.y)); v[3] = a0[3] * fsigmoid(bf_hi(gv.y));
                    v[4] = a1[0] * fsigmoid(bf_lo(gv.z)); v[5] = a1[1] * fsigmoid(bf_hi(gv.z)); v[6] = a1[2] * fsigmoid(bf_lo(gv.w)); v[7] = a1[3] * fsigmoid(bf_hi(gv.w));
                    bf16_t* op = obase + r * 2048 + bj * HALF;
                    if (br) { const u32x4 pv = *(const u32x4*)op;
                        v[0] += bf_lo(pv.x); v[1] += bf_hi(pv.x); v[2] += bf_lo(pv.y); v[3] += bf_hi(pv.y); v[4] += bf_lo(pv.z); v[5] += bf_hi(pv.z); v[6] += bf_lo(pv.w); v[7] += bf_hi(pv.w); }
                    u32x4 w; w.x = cvt_pk_bf16(v[0], v[1]); w.y = cvt_pk_bf16(v[2], v[3]); w.z = cvt_pk_bf16(v[4], v[5]); w.w = cvt_pk_bf16(v[6], v[7]);
                    *(u32x4*)op = w; } }
    }
};
struct BranchOrder {
    StaticOrder so;
    __host__ __device__ void init(int G_, int c_) { so.init(MROWS, 2048, G_, c_); }
    __host__ __device__ bool next(int i, Unit& u) const { Unit t; if (!so.next(i >> 1, t)) return false; const int br = i & 1; u.pm = t.pm + 64 * br; u.pn = t.pn + 8 * br; return true; }
    __device__ __forceinline__ void a_ready(const Unit&) const {}
    __device__ __forceinline__ void done(const Unit&) const {}
};

struct EpiResid {
    static constexpr bool PERM = false, AFTER_DRAIN = false;
    const float* base; float* out; int ldc;
    __device__ __forceinline__ void operator()(const f32x4 (&acc)[2][2][4][2], const Unit& u, int wr, int wc, int fr, int fq) const {
        const int col0 = u.pn * BM + wc * 32 + 4 * fq;
#pragma unroll
        for (int ai = 0; ai < 2; ++ai)
#pragma unroll
            for (int m = 0; m < 4; ++m) { const size_t off = (size_t)(u.pm * BM + ai * HALF + wr * 64 + m * 16 + fr) * ldc + col0;
#pragma unroll
                for (int bj = 0; bj < 2; ++bj)
#pragma unroll
                    for (int n = 0; n < 2; ++n) { const f32x4 bs = *(const f32x4*)(base + off + bj * HALF + n * 16); *(f32x4*)(out + off + bj * HALF + n * 16) = bs + acc[ai][bj][m][n]; } }
    }
};

struct EpiRelu2 {
    static constexpr bool PERM = true, AFTER_DRAIN = false;
    bf16_t* O; int ldc;
    __device__ __forceinline__ void operator()(const f32x4 (&acc)[2][2][4][2], const Unit& u, int wr, int wc, int fr, int fq) const {
        const int row0 = u.pm * BM + wr * 64 + fr, col0 = u.pn * BM + wc * 32 + 8 * fq;
#pragma unroll
        for (int ai = 0; ai < 2; ++ai)
#pragma unroll
            for (int m = 0; m < 4; ++m) { bf16_t* rowp = O + (size_t)(row0 + ai * HALF + m * 16) * ldc + col0;
#pragma unroll
                for (int bj = 0; bj < 2; ++bj) { f32x4 v0 = acc[ai][bj][m][0], v1 = acc[ai][bj][m][1];
#pragma unroll
                    for (int e = 0; e < 4; ++e) { const float a = fmaxf(v0[e], 0.f), b = fmaxf(v1[e], 0.f); v0[e] = a * a; v1[e] = b * b; }
                    u32x4 w; w.x = cvt_pk_bf16(v0[0], v0[1]); w.y = cvt_pk_bf16(v0[2], v0[3]); w.z = cvt_pk_bf16(v1[0], v1[1]); w.w = cvt_pk_bf16(v1[2], v1[3]);
                    *(u32x4*)(rowp + bj * HALF) = w; } }
    }
};
template <class Epi, class Sched, bool ALIGN_EPI = false, bool SP2 = false>
__device__ __forceinline__ void gemm_phase(PG8_LAS unsigned char* lds, const Gemm g, const Sched& S, const Epi& E) {
    const int tid = threadIdx.x, wid = __builtin_amdgcn_readfirstlane(tid >> 6), lane = tid & 63, wr = wid >> 2, wc = wid & 3, fr = lane & 15, fq = lane >> 4;
    const int K = g.K, nt = K / BK;
    unsigned voffA[2], voffB[2];
#pragma unroll
    for (int i = 0; i < 2; ++i) { int R, C; stage_rc(tid * 16 + i * 8192, R, C); const int Rb = Epi::PERM ? ((R & ~31) + perm32(R & 31)) : R;
        voffA[i] = (unsigned)(R * K + C) * 2u; voffB[i] = (unsigned)(Rb * K + C) * 2u; }
    const size_t kstep = (size_t)(BK * 2);
    const size_t hstep = (size_t)HALF * K * 2;
    const size_t tstep = 2 * hstep;
    const unsigned ldsw = (unsigned)wid * 1024u;
    const int aoff = lds_byte(wr * 64 + fr, fq * 8), boff = lds_byte(wc * 32 + fr, fq * 8);
#define PG8_SA(b, h) (((b) * 2 + (h)) * HTB)
#define PG8_SB(b, h) ((4 + (b) * 2 + (h)) * HTB)
#define PG8_STAGE(bufoff, gbase, voff) do { _Pragma("unroll") for (int _i = 0; _i < 2; ++_i) \
        __builtin_amdgcn_global_load_lds((const unsigned*)((const char*)(gbase) + (voff)[_i]), (PG8_LAS unsigned*)(lds + (bufoff) + ldsw + _i * 8192), 16, 0, 0); } while (0)
#define PG8_LDA(dst, b, h) do { _Pragma("unroll") for (int m = 0; m < 4; ++m) _Pragma("unroll") for (int k = 0; k < 2; ++k) dst[m][k] = *(const PG8_LAS bf16x8*)(lds + PG8_SA(b, h) + aoff + m * 2048 + k * 1024); } while (0)
#define PG8_LDB(dst, b, h) do { _Pragma("unroll") for (int n = 0; n < 2; ++n) _Pragma("unroll") for (int k = 0; k < 2; ++k) dst[n][k] = *(const PG8_LAS bf16x8*)(lds + PG8_SB(b, h) + boff + n * 2048 + k * 1024); } while (0)
#define PG8_MMA(ai, bj, At, Bt) do { __builtin_amdgcn_s_setprio(1); _Pragma("unroll") for (int m = 0; m < 4; ++m) _Pragma("unroll") for (int n = 0; n < 2; ++n) _Pragma("unroll") for (int k = 0; k < 2; ++k) \
        acc[ai][bj][m][n] = __builtin_amdgcn_mfma_f32_16x16x32_bf16(Bt[n][k], At[m][k], acc[ai][bj][m][n], 0, 0, 0); __builtin_amdgcn_s_setprio(0); } while (0)
#define PG8_WAIT_V(n) asm volatile("s_waitcnt vmcnt(" #n ")" ::: "memory")
#define PG8_WAIT_L(n) asm volatile("s_waitcnt lgkmcnt(" #n ")" ::: "memory")
#define PG8_BAR __builtin_amdgcn_s_barrier()
#define PG8_SCHED __builtin_amdgcn_sched_barrier(0)
    Unit cur, nxt; int ui = 0;
    if (!S.next(0, cur)) return;
    f32x4 acc[2][2][4][2];
#pragma unroll
    for (int a = 0; a < 2; ++a)
#pragma unroll
        for (int b = 0; b < 2; ++b)
#pragma unroll
            for (int m = 0; m < 4; ++m)
#pragma unroll
                for (int n = 0; n < 2; ++n) acc[a][b][m][n] = (f32x4){0.f, 0.f, 0.f, 0.f};
    bf16x8 At[4][2], B0[2][2], B1[2][2];
    const char* cA = (const char*)g.A + (size_t)cur.pm * tstep; const char* cB = (const char*)g.Bt + (size_t)cur.pn * tstep;
    S.a_ready(cur);
    if constexpr (SP2) {
        PG8_STAGE(PG8_SB(0, 0), cB, voffB); PG8_STAGE(PG8_SB(0, 1), cB + hstep, voffB); PG8_STAGE(PG8_SA(0, 0), cA, voffA); PG8_STAGE(PG8_SA(0, 1), cA + hstep, voffA);
        if (wr == 1) PG8_BAR;
        PG8_WAIT_V(2); PG8_BAR;
        PG8_STAGE(PG8_SB(1, 0), cB + kstep, voffB); PG8_STAGE(PG8_SA(1, 0), cA + kstep, voffA); PG8_STAGE(PG8_SB(1, 1), cB + hstep + kstep, voffB);
        PG8_WAIT_V(6); PG8_BAR;
    } else {
        PG8_STAGE(PG8_SB(0, 0), cB, voffB); PG8_STAGE(PG8_SA(0, 0), cA, voffA); PG8_STAGE(PG8_SB(0, 1), cB + hstep, voffB); PG8_STAGE(PG8_SA(0, 1), cA + hstep, voffA);
        if (wr == 1) PG8_BAR;
        PG8_WAIT_V(4); PG8_BAR;
        PG8_STAGE(PG8_SB(1, 0), cB + kstep, voffB); PG8_STAGE(PG8_SA(1, 0), cA + kstep, voffA); PG8_STAGE(PG8_SB(1, 1), cB + hstep + kstep, voffB);
        PG8_WAIT_V(6); PG8_BAR;
    }
    for (;;) {
        const bool has_next = S.next(ui + 1, nxt);
        const char* nA = has_next ? (const char*)g.A + (size_t)nxt.pm * tstep : cA; const char* nB = has_next ? (const char*)g.Bt + (size_t)nxt.pn * tstep : cB;
        for (int t = 0; t < nt; t += 2) {
            const bool last = (t == nt - 2);
            const char* a1 = cA + (size_t)(t + 1) * kstep;
            const char* a2 = last ? nA : cA + (size_t)(t + 2) * kstep; const char* b2 = last ? nB : cB + (size_t)(t + 2) * kstep;
            const char* a3 = a2 + kstep; const char* b3 = b2 + kstep;
            if (last && has_next) S.a_ready(nxt);
            if constexpr (SP2) {
            PG8_LDB(B0, 0, 0); PG8_LDB(B1, 0, 1); PG8_SCHED; PG8_LDA(At, 0, 0); PG8_STAGE(PG8_SA(1, 1), a1 + hstep, voffA);
            PG8_WAIT_V(8); PG8_WAIT_L(0); PG8_BAR; PG8_MMA(0, 0, At, B0); PG8_MMA(0, 1, At, B1); PG8_BAR; PG8_SCHED;
            PG8_LDA(At, 0, 1); PG8_STAGE(PG8_SB(0, 0), b2, voffB); PG8_STAGE(PG8_SB(0, 1), b2 + hstep, voffB); PG8_STAGE(PG8_SA(0, 0), a2, voffA);
            PG8_WAIT_V(8); PG8_WAIT_L(0); PG8_BAR; PG8_MMA(1, 0, At, B0); PG8_MMA(1, 1, At, B1); PG8_BAR; PG8_SCHED;
            PG8_LDB(B0, 1, 0); PG8_LDB(B1, 1, 1); PG8_SCHED; PG8_LDA(At, 1, 0); PG8_STAGE(PG8_SA(0, 1), a2 + hstep, voffA);
            PG8_WAIT_V(8); PG8_WAIT_L(0); PG8_BAR; PG8_MMA(0, 0, At, B0); PG8_MMA(0, 1, At, B1); PG8_BAR; PG8_SCHED;
            PG8_LDA(At, 1, 1); PG8_STAGE(PG8_SB(1, 0), b3, voffB); PG8_STAGE(PG8_SB(1, 1), b3 + hstep, voffB); PG8_STAGE(PG8_SA(1, 0), a3, voffA);
            PG8_WAIT_V(8); PG8_WAIT_L(0); PG8_BAR; PG8_MMA(1, 0, At, B0); PG8_MMA(1, 1, At, B1); PG8_BAR; PG8_SCHED;
            } else {
            PG8_LDB(B0, 0, 0); PG8_SCHED; PG8_LDA(At, 0, 0); PG8_STAGE(PG8_SA(1, 1), a1 + hstep, voffA);
            PG8_WAIT_L(8); PG8_BAR; PG8_WAIT_L(0); PG8_MMA(0, 0, At, B0); PG8_BAR; PG8_SCHED;
            PG8_LDB(B1, 0, 1); PG8_STAGE(PG8_SB(0, 0), b2, voffB);
            PG8_BAR; PG8_WAIT_L(0); PG8_MMA(0, 1, At, B1); PG8_BAR;
            PG8_LDA(At, 0, 1); PG8_STAGE(PG8_SA(0, 0), a2, voffA);
            PG8_BAR; PG8_WAIT_L(0); PG8_MMA(1, 0, At, B0); PG8_BAR; PG8_SCHED;
            PG8_STAGE(PG8_SB(0, 1), b2 + hstep, voffB);
            PG8_WAIT_V(6); PG8_BAR; PG8_MMA(1, 1, At, B1); PG8_BAR;
            PG8_LDB(B0, 1, 0); PG8_SCHED; PG8_LDA(At, 1, 0); PG8_STAGE(PG8_SA(0, 1), a2 + hstep, voffA);
            PG8_WAIT_L(8); PG8_BAR; PG8_WAIT_L(0); PG8_MMA(0, 0, At, B0); PG8_BAR; PG8_SCHED;
            PG8_LDB(B1, 1, 1); PG8_STAGE(PG8_SB(1, 0), b3, voffB);
            PG8_BAR; PG8_WAIT_L(0); PG8_MMA(0, 1, At, B1); PG8_BAR;
            PG8_LDA(At, 1, 1); PG8_STAGE(PG8_SA(1, 0), a3, voffA);
            PG8_BAR; PG8_WAIT_L(0); PG8_MMA(1, 0, At, B0); PG8_BAR; PG8_SCHED;
            PG8_STAGE(PG8_SB(1, 1), b3 + hstep, voffB);
            PG8_WAIT_V(6); PG8_BAR; PG8_MMA(1, 1, At, B1); PG8_BAR;
            }
        }
        if constexpr (ALIGN_EPI) { if (wr == 0) PG8_BAR; }
        if constexpr (!Epi::AFTER_DRAIN) { E(acc, cur, wr, wc, fr, fq); S.done(cur); }
        if (!has_next) break;
#pragma unroll
        for (int a = 0; a < 2; ++a)
#pragma unroll
            for (int b = 0; b < 2; ++b)
#pragma unroll
                for (int m = 0; m < 4; ++m)
#pragma unroll
                    for (int n = 0; n < 2; ++n) acc[a][b][m][n] = (f32x4){0.f, 0.f, 0.f, 0.f};
        cur = nxt; cA = nA; cB = nB; ++ui;
        if constexpr (ALIGN_EPI) { if (wr == 1) PG8_BAR; }
    }
    PG8_WAIT_V(0);
    if constexpr (!ALIGN_EPI) { if (wr == 0) PG8_BAR; }
    PG8_BAR;
    if constexpr (Epi::AFTER_DRAIN) { E.fused(acc, cur, wr, wc, fr, fq, lds, wid, lane); S.done(cur); }
#undef PG8_SA
#undef PG8_SB
#undef PG8_STAGE
#undef PG8_LDA
#undef PG8_LDB
#undef PG8_MMA
#undef PG8_WAIT_V
#undef PG8_WAIT_L
#undef PG8_BAR
#undef PG8_SCHED
}
}
constexpr int NWAVES = 8;
constexpr int N_LAUNCHES = MK_N_LAUNCHES;
constexpr int PER_PHASE = 11;
constexpr int SEQ = 2048, DM = 2048, DFF = 8192, NPROJ_IN = 11312, NPROJ_PAD = 11520;
constexpr float RMS_EPS = 1e-6f;
constexpr size_t MiB = 1u << 20;
constexpr size_t BLK = (size_t)MROWS * 256;
constexpr size_t WS_CTL = 0, CTL_ZERO_BYTES = 1 * MiB;
constexpr size_t WS_GATES = 1 * MiB, WS_WBM = 5 * MiB, WS_WBD = 9 * MiB, WS_WOUT = 13 * MiB, WS_PROJ = 21 * MiB, WS_WIN = 373 * MiB, WS_XN = 418 * MiB;
constexpr size_t WS_DQ = 373 * MiB, WS_DK = 405 * MiB, WS_DV = 437 * MiB;
constexpr size_t WS_HM = 117 * MiB, WS_ODF = 181 * MiB, WS_ODB = 469 * MiB;
constexpr size_t WS_YM = 21 * MiB, WS_YD = 53 * MiB, WS_MIX = 373 * MiB;
constexpr size_t WS_XN2 = 437 * MiB, WS_W1T = 21 * MiB, WS_W2T = 53 * MiB, WS_HFF = 117 * MiB, WS_END = 509 * MiB;
constexpr int CW_BAR = 4096;
constexpr int LDS_BYTES = 163840;
constexpr int MISC_OFF = LDS_BYTES - 256;

#define GAS __attribute__((address_space(1)))
#define LAS __attribute__((address_space(3)))
typedef unsigned short bf16;
typedef unsigned v4u __attribute__((ext_vector_type(4)));
typedef unsigned v2u __attribute__((ext_vector_type(2)));
typedef float f32x4 __attribute__((ext_vector_type(4)));
typedef short bf16x8 __attribute__((ext_vector_type(8)));
typedef GAS unsigned gu32;
#define RLX_AGENT __ATOMIC_RELAXED, __HIP_MEMORY_SCOPE_AGENT
#define LDS_WAIT() asm volatile("s_waitcnt lgkmcnt(0)" ::: "memory")
#define VM_WAIT() asm volatile("s_waitcnt vmcnt(0)" ::: "memory")
__device__ __forceinline__ unsigned f2bf(float f) { unsigned u = __builtin_bit_cast(unsigned, f); return (u + 0x7fffu + ((u >> 16) & 1u)) >> 16; }
__device__ __forceinline__ unsigned pk2(float lo, float hi) { return f2bf(lo) | (f2bf(hi) << 16); }
__device__ __forceinline__ float bflo(unsigned w) { return __uint_as_float(w << 16); }
__device__ __forceinline__ float bfhi(unsigned w) { return __uint_as_float(w & 0xffff0000u); }
__device__ __forceinline__ float bfel(const v4u& v, int i) { const unsigned w = v[i >> 1]; return (i & 1) ? bfhi(w) : bflo(w); }
#define MFMA16(a, b, c) __builtin_amdgcn_mfma_f32_16x16x32_bf16((a), (b), (c), 0, 0, 0)
__device__ __forceinline__ bf16x8 ldfrag(const LAS unsigned char* p) { return *(const LAS bf16x8*)p; }
__device__ __forceinline__ void st8(LAS unsigned char* p, const f32x4& v) { v2u w; w.x = pk2(v[0], v[1]); w.y = pk2(v[2], v[3]); *(LAS v2u*)p = w; }
#define XB_TMO      128
#define XB_XCNT(j)  (256  + 64 * (j))
#define XB_XSUB(j)  (1280 + 64 * (j))
#define XB_XGEN(j)  (2304 + 64 * (j))
#define XB_TOP      3328
#define XB_TOPGEN   3392
#define XCD_BAR_WORDS 3456
#define XB_SPIN_CAP (1u << 18)

__device__ __forceinline__ unsigned xb_ld(unsigned* p)              { return __hip_atomic_load(p, __ATOMIC_RELAXED, __HIP_MEMORY_SCOPE_AGENT); }
__device__ __forceinline__ unsigned xb_add(unsigned* p, unsigned v) { return __hip_atomic_fetch_add(p, v, __ATOMIC_RELAXED, __HIP_MEMORY_SCOPE_AGENT); }
__device__ __forceinline__ unsigned xb_xcc_id() { return (unsigned)__builtin_amdgcn_s_getreg((3 << 11) | 20) & 0xFu; }
#define XB_SPIN(cond, bar) do { unsigned _sp = 0; while (cond) { __builtin_amdgcn_s_sleep(1); \
    if ((++_sp & 255u) == 0u) { if (xb_ld(&(bar)[XB_TMO])) break; if (_sp > XB_SPIN_CAP) { atomicAdd(&(bar)[XB_TMO], 1u); break; } } } } while (0)

struct XcdBarrier {
    unsigned* bar; unsigned x;
    volatile LAS unsigned* st;
};

__device__ __forceinline__ XcdBarrier xcd_barrier_post(unsigned* bar, volatile LAS unsigned* st) {
    XcdBarrier b; b.bar = bar; b.x = xb_xcc_id(); b.st = st;
    if (threadIdx.x == 0) (void)xb_add(&bar[XB_XCNT(b.x)], 1u);
    return b;
}
__device__ __forceinline__ void xcd_barrier_complete(unsigned* bar, unsigned x, unsigned& nloc, unsigned& nx) {
    const unsigned G = gridDim.x * gridDim.y * gridDim.z;
    unsigned sum, cnt, mine, sp = 0u;
    for (;;) {
        sum = 0u; cnt = 0u; mine = 0u;
#pragma unroll
        for (unsigned j = 0; j < 16; ++j) { const unsigned c = xb_ld(&bar[XB_XCNT(j)]); sum += c; cnt += (c > 0u) ? 1u : 0u; mine = (j == x) ? c : mine; }
        if (sum == G) break;
        __builtin_amdgcn_s_sleep(1);
        if ((++sp & 255u) == 0u) { if (xb_ld(&bar[XB_TMO])) break; if (sp > XB_SPIN_CAP) { atomicAdd(&bar[XB_TMO], 1u); break; } }
    }
    nloc = mine > 0u ? mine : 1u; nx = cnt > 0u ? cnt : 1u;
}

__device__ __forceinline__ void xcd_barrier(const XcdBarrier& b) {
    asm volatile("s_waitcnt vmcnt(0)" ::: "memory");
    __syncthreads();
    if (threadIdx.x == 0) {
        unsigned* bar = b.bar;
        __builtin_amdgcn_s_waitcnt(0);
        unsigned nloc = b.st[0], nx = b.st[1];
        if (nloc == 0u) { xcd_barrier_complete(bar, b.x, nloc, nx); b.st[0] = nloc; b.st[1] = nx; }
        const unsigned old = xb_add(&bar[XB_XSUB(b.x)], 1u);
        const unsigned gen = old / nloc;
        if (old + 1u == (gen + 1u) * nloc) {
            __builtin_amdgcn_fence(__ATOMIC_RELEASE, "agent");
            asm volatile("s_waitcnt vmcnt(0)" ::: "memory");
            const unsigned og = xb_add(&bar[XB_TOP], 1u);
            const unsigned tg = og / nx;
            if (og + 1u == (tg + 1u) * nx) xb_add(&bar[XB_TOPGEN], 1u);
            else XB_SPIN(xb_ld(&bar[XB_TOPGEN]) == tg, bar);
            __builtin_amdgcn_fence(__ATOMIC_ACQUIRE, "agent");
            xb_add(&bar[XB_XGEN(b.x)], 1u);
            asm volatile("s_waitcnt vmcnt(0)" ::: "memory");
        } else {
            XB_SPIN(xb_ld(&bar[XB_XGEN(b.x)]) == gen, bar);
            __builtin_amdgcn_fence(__ATOMIC_ACQUIRE, "agent");
            asm volatile("s_waitcnt vmcnt(0)" ::: "memory");
        }
    }
    __syncthreads();
}
struct Frame {
    LAS unsigned char* lds;
    volatile LAS unsigned* MISC;
    gu32* ctl;
    int tid, lane, wave;
    int vcu, G;
    float* out;
    unsigned char* ws;
};
__device__ __forceinline__ float wave_sum(float v) {
#pragma unroll
    for (int o = 1; o < 64; o <<= 1) v += __shfl_xor(v, o);
    return v;
}
__device__ __forceinline__ int win_map(int n) {
    if (n < 3072) return n;
    if (n < 3088) return 11264 + (n - 3072);
    if (n < 7184) return n - 16;
    if (n < 7216) return 11264 + 16 + (n - 7184);
    return n - 48;
}
__device__ __forceinline__ void tr_item(const float* W, int K, int N, bf16* WT, LAS float* scr, int item, int lane, bool remap) {
    const int nblk = (N + 31) / 32, kb = item / nblk, nb = item % nblk, k0 = 64 * kb, n0 = 32 * nb;
    const int nn = n0 + (lane & 31); const bool okc = nn < N;
#pragma unroll 8
    for (int i = 0; i < 32; ++i) { const int kk = 2 * i + (lane >> 5); scr[kk * 33 + (lane & 31)] = okc ? W[(size_t)(k0 + kk) * N + nn] : 0.f; }
    LDS_WAIT(); asm volatile("" ::: "memory");
    const int c = lane & 7;
#pragma unroll
    for (int j = 0; j < 4; ++j) { const int n = (lane >> 3) + 8 * j; const LAS float* s = scr + (8 * c) * 33 + n;
        v4u o; o.x = pk2(s[0 * 33], s[1 * 33]); o.y = pk2(s[2 * 33], s[3 * 33]); o.z = pk2(s[4 * 33], s[5 * 33]); o.w = pk2(s[6 * 33], s[7 * 33]);
        if (n0 + n < N) { const int row = remap ? win_map(n0 + n) : (n0 + n); *(v4u*)(WT + (size_t)row * K + k0 + 8 * c) = o; } }
    LDS_WAIT(); asm volatile("" ::: "memory");
}
__device__ __forceinline__ void rms_row_bf16(int lane, const float* xrow, const float* g, bf16* orow) {
    const f32x4* xr = (const f32x4*)xrow + lane; const f32x4* gr = (const f32x4*)g + lane;
    f32x4 v[8]; float s = 0.f;
#pragma unroll
    for (int j = 0; j < 8; ++j) { v[j] = xr[64 * j]; s += (v[j].x * v[j].x + v[j].y * v[j].y) + (v[j].z * v[j].z + v[j].w * v[j].w); }
    const float r = 1.0f / sqrtf(wave_sum(s) * (1.f / 2048.f) + RMS_EPS);
    v2u* o8 = (v2u*)orow + lane;
#pragma unroll
    for (int j = 0; j < 8; ++j) { const f32x4 gg = gr[64 * j]; v2u w; w.x = pk2(v[j].x * r * gg.x, v[j].y * r * gg.y); w.y = pk2(v[j].z * r * gg.z, v[j].w * r * gg.w); o8[64 * j] = w; }
}
__device__ __forceinline__ void rms_row_f32(int lane, const float* xrow, const float* g, float* orow) {
    const f32x4* xr = (const f32x4*)xrow + lane; const f32x4* gr = (const f32x4*)g + lane;
    f32x4 v[8]; float s = 0.f;
#pragma unroll
    for (int j = 0; j < 8; ++j) { v[j] = xr[64 * j]; s += (v[j].x * v[j].x + v[j].y * v[j].y) + (v[j].z * v[j].z + v[j].w * v[j].w); }
    const float r = 1.0f / sqrtf(wave_sum(s) * (1.f / 2048.f) + RMS_EPS);
    f32x4* o = (f32x4*)orow + lane;
#pragma unroll
    for (int j = 0; j < 8; ++j) { const f32x4 gg = gr[64 * j]; o[64 * j] = (v[j] * r) * gg; }
}

__device__ __forceinline__ void p0_prologue(Frame& F, const float* x, const float* n1g, const float* w_in, const float* w_bm, const float* w_bd, const float* w_out) {
    LAS float* scr = (LAS float*)(F.lds + F.wave * 16384);
    const int gw = F.vcu * NWAVES + F.wave, NGW = F.G * NWAVES;
    bf16* WIN = (bf16*)(F.ws + WS_WIN); bf16* WBM = (bf16*)(F.ws + WS_WBM); bf16* WBD = (bf16*)(F.ws + WS_WBD); bf16* WOUT = (bf16*)(F.ws + WS_WOUT); bf16* XN = (bf16*)(F.ws + WS_XN);
    constexpr int I_IN = (DM / 64) * ((NPROJ_IN + 31) / 32), I_B = (1024 / 64) * (DM / 32), I_O = (DM / 64) * (DM / 32);
    constexpr int NITEMS = I_IN + 2 * I_B + I_O;
    for (int it = gw; it < NITEMS; it += NGW) {
        int r = it;
        if (r < I_IN) { tr_item(w_in, DM, NPROJ_IN, WIN, scr, r, F.lane, true); continue; } r -= I_IN;
        if (r < I_B) { tr_item(w_bm, 1024, DM, WBM, scr, r, F.lane, false); continue; } r -= I_B;
        if (r < I_B) { tr_item(w_bd, 1024, DM, WBD, scr, r, F.lane, false); continue; } r -= I_B;
        tr_item(w_out, DM, DM, WOUT, scr, r, F.lane, false);
    }
    { v4u* z = (v4u*)(WIN + (size_t)(11264 + 48) * DM); const int nz = (NPROJ_PAD - 11264 - 48) * DM / 8;
      for (int i = gw * 64 + F.lane; i < nz; i += NGW * 64) z[i] = (v4u){0u, 0u, 0u, 0u}; }
    for (int m = gw; m < MROWS; m += NGW) rms_row_bf16(F.lane, x + (size_t)m * DM, n1g, XN + (size_t)m * DM);
}

__device__ __forceinline__ void p2_conv(Frame& F, const float* convw) {
    const int gw = F.vcu * NWAVES + F.wave, NGW = F.G * NWAVES, lane = F.lane;
    const bf16* PROJ = (const bf16*)(F.ws + WS_PROJ);
    bf16* DQ = (bf16*)(F.ws + WS_DQ); bf16* DK = (bf16*)(F.ws + WS_DK); bf16* DV = (bf16*)(F.ws + WS_DV);
    constexpr int NIT = 24 * (MROWS / 8);
    for (int it = gw; it < NIT; it += NGW) {
        const int gI = it % 24, tb8 = it / 24, m0 = tb8 * 8, b = m0 >> 11, t0 = m0 & 2047;
        const int c0 = gI * 128;
        const bf16* src = PROJ + (size_t)(12 + (c0 >> 8)) * BLK + (c0 & 255) + 2 * lane;
        float x0[12], x1[12];
#pragma unroll
        for (int i = 0; i < 12; ++i) { const int tp = t0 - 2 + i; unsigned wv = 0u;
            if (tp >= 0 && tp < SEQ) wv = *(const unsigned*)(src + (size_t)(b * SEQ + tp) * 256);
            x0[i] = bflo(wv); x1[i] = bfhi(wv); }
        float cw0[5], cw1[5];
#pragma unroll
        for (int i = 0; i < 5; ++i) { const float* cp = convw + (size_t)i * 3072 + c0 + 2 * lane; cw0[i] = cp[0]; cw1[i] = cp[1]; }
        bf16* dst = (gI < 8 ? DQ : (gI < 16 ? DK : DV)) + (size_t)m0 * 1024 + (c0 & 1023) + 2 * lane;
#pragma unroll
        for (int o = 0; o < 8; ++o) {
            float y0 = 0.f, y1 = 0.f;
#pragma unroll
            for (int i = 0; i < 5; ++i) { y0 += cw0[i] * x0[o + i]; y1 += cw1[i] * x1[o + i]; }
            float s0 = y0 / (1.0f + expf(-y0)), s1 = y1 / (1.0f + expf(-y1));
            if (gI < 16) { const float ss = wave_sum(s0 * s0 + s1 * s1); float r = 1.0f / sqrtf(ss + 1e-6f); if (gI < 8) r *= 0.08838834764831845f; s0 *= r; s1 *= r; }
            *(unsigned*)(dst + (size_t)o * 1024) = pk2(s0, s1);
        }
    }
}

typedef short s16x4 __attribute__((ext_vector_type(4)));
__device__ __forceinline__ bf16x8 ldfrag_tr(const LAS unsigned char* p, int RS) {
    const s16x4 lo = __builtin_amdgcn_ds_read_tr16_b64_v4i16((LAS s16x4*)p);
    const s16x4 hi = __builtin_amdgcn_ds_read_tr16_b64_v4i16((LAS s16x4*)(p + 4 * RS));
    return __builtin_shufflevector(lo, hi, 0, 1, 2, 3, 4, 5, 6, 7);
}
__device__ __forceinline__ int trofs(int lane, int RS) { const int i = lane & 15, g = lane >> 4; return (8 * g + (i >> 2)) * RS + 8 * (i & 3); }
template <int CTRL, int ROWMASK> __device__ __forceinline__ float dppf(float old, float src) {
    return __builtin_bit_cast(float, __builtin_amdgcn_update_dpp(__builtin_bit_cast(int, old), __builtin_bit_cast(int, src), CTRL, ROWMASK, 0xf, false)); }
__device__ __forceinline__ float wave_incl_sum(float v) {
    v += dppf<0x111, 0xf>(0.f, v); v += dppf<0x112, 0xf>(0.f, v); v += dppf<0x114, 0xf>(0.f, v); v += dppf<0x118, 0xf>(0.f, v);
    v += dppf<0x142, 0xa>(0.f, v); v += dppf<0x143, 0xc>(0.f, v); return v; }
__device__ __forceinline__ float wave_incl_max(float v) {
    const float NI = -3.0e38f;
    v = fmaxf(v, dppf<0x111, 0xf>(NI, v)); v = fmaxf(v, dppf<0x112, 0xf>(NI, v)); v = fmaxf(v, dppf<0x114, 0xf>(NI, v)); v = fmaxf(v, dppf<0x118, 0xf>(NI, v));
    v = fmaxf(v, dppf<0x142, 0xa>(NI, v)); v = fmaxf(v, dppf<0x143, 0xc>(NI, v)); return v; }
__device__ __forceinline__ float lane63(float v) { return __builtin_bit_cast(float, __builtin_amdgcn_readlane(__builtin_bit_cast(int, v), 63)); }
__device__ __forceinline__ v4u scale8(const v4u& v, float s) { v4u o; o.x = pk2(bflo(v.x) * s, bfhi(v.x) * s); o.y = pk2(bflo(v.y) * s, bfhi(v.y) * s); o.z = pk2(bflo(v.z) * s, bfhi(v.z) * s); o.w = pk2(bflo(v.w) * s, bfhi(v.w) * s); return o; }

constexpr int ML_QP = 0, ML_KS = 25600, ML_KW = 43008, ML_VX = 60416, ML_CT = 79872, ML_CT_BYTES = 39168, ML_VEC = 119040, ML_VECN = 336;
constexpr float ML_SCALE = 0.08838834764831845f;
__device__ __forceinline__ void mlstm_unit(Frame& F, int unit, const float* m_ib, const float* m_fb) {
    const int tid = F.tid, lane = F.lane, w = F.wave, fr = lane & 15, fq = lane >> 4;
    const int half = unit & 1, dir = (unit >> 1) & 1, h = (unit >> 2) & 3, b = unit >> 4;
    LAS unsigned char* L = F.lds;
    LAS float* vec = (LAS float*)(L + ML_VEC);
    const int tro272 = trofs(lane, 272), tro304 = trofs(lane, 304);
    for (int i = tid; i < ML_CT_BYTES / 16; i += 512) ((LAS v4u*)(L + ML_CT))[i] = (v4u){0u, 0u, 0u, 0u};
    if (tid < 64) { *(LAS v4u*)(L + ML_VX + tid * 304 + 256) = (v4u){0x00003f80u, 0u, 0u, 0u}; *(LAS v4u*)(L + ML_VX + tid * 304 + 272) = (v4u){0u, 0u, 0u, 0u}; }
    f32x4 accS[9];
#pragma unroll
    for (int t = 0; t < 9; ++t) accS[t] = (f32x4){0.f, 0.f, 0.f, 0.f};
    float m_st = -1e30f;
    const bf16* PROJ = (const bf16*)(F.ws + WS_PROJ);
    const float* GATES = (const float*)(F.ws + WS_GATES);
    const bf16* Qg = PROJ + (size_t)(h >> 1) * BLK + (h & 1) * 128;
    const bf16* Kg = PROJ + (size_t)(2 + (h >> 1)) * BLK + (h & 1) * 128;
    const bf16* Vg = PROJ + (size_t)(4 + h) * BLK + half * 128;
    bf16* Hout = (bf16*)(F.ws + WS_HM) + (size_t)dir * MROWS * 1024 + h * 256 + half * 128;
    const float ib = m_ib[dir * 4 + h], fb = m_fb[dir * 4 + h];
    const int sr = tid >> 4, sc = tid & 15;
    v4u q[2], k[2], v[2];
    float g_i = 0.f, g_f = 0.f;
#define ML_GATES(vb_, ig_raw, f_raw) do { \
        const float ig_ = (ig_raw) + ib, fp_ = (f_raw) + fb; \
        const float lf_ = fp_ >= 0.f ? -__logf(1.0f + __expf(-fp_)) : fp_ - __logf(1.0f + __expf(fp_)); \
        const float bc_ = wave_incl_sum(lf_), a_ = ig_ - bc_, am_ = wave_incl_max(a_); \
        const float Ml_ = fmaxf(m_st, am_), M63_ = lane63(Ml_), bl_ = lane63(bc_); \
        (vb_)[lane] = a_; (vb_)[64 + lane] = Ml_; (vb_)[128 + lane] = __expf(-(bc_ + Ml_)); (vb_)[192 + lane] = __expf(m_st - Ml_) * ML_SCALE; (vb_)[256 + lane] = __expf(a_ - M63_); \
        if (lane == 0) (vb_)[320] = __expf(m_st - M63_); \
        m_st = bl_ + M63_; } while (0)
#define ML_LOADQKV(jj) do { _Pragma("unroll") for (int p = 0; p < 2; ++p) { const int tt_ = (jj) * 64 + sr + 32 * p, t_ = dir ? (SEQ - 1 - tt_) : tt_; const size_t mr_ = (size_t)(b * SEQ + t_); \
        q[p] = *(const v4u*)(Qg + mr_ * 256 + sc * 8); k[p] = *(const v4u*)(Kg + mr_ * 256 + sc * 8); v[p] = *(const v4u*)(Vg + mr_ * 256 + sc * 8); } } while (0)
#define ML_LOADG(jj) do { const int tt_ = (jj) * 64 + lane, t_ = dir ? (SEQ - 1 - tt_) : tt_; const size_t mr_ = (size_t)(b * SEQ + t_); g_i = GATES[mr_ * 64 + dir * 4 + h]; g_f = GATES[mr_ * 64 + 8 + dir * 4 + h]; } while (0)
    ML_LOADQKV(0);
    if (w == 0) { ML_LOADG(0); ML_GATES(vec, g_i, g_f); ML_LOADG(1); }
    __syncthreads();
    for (int j = 0; j < 32; ++j) {
        LAS float* vb = vec + (j & 1) * ML_VECN;
#pragma unroll
        for (int p = 0; p < 2; ++p) { const int r = sr + 32 * p; const float wsr = vb[256 + r];
            *(LAS v4u*)(L + ML_QP + r * 400 + 128 + sc * 16) = q[p]; *(LAS v4u*)(L + ML_KS + r * 272 + sc * 16) = k[p];
            *(LAS v4u*)(L + ML_KW + r * 272 + sc * 16) = scale8(k[p], wsr); *(LAS v4u*)(L + ML_VX + r * 304 + sc * 16) = v[p]; }
        if (j + 1 < 32) ML_LOADQKV(j + 1);
        if (w == 0 && j + 1 < 32) { LAS float* vn = vec + ((j + 1) & 1) * ML_VECN; ML_GATES(vn, g_i, g_f); if (j + 2 < 32) ML_LOADG(j + 2); }
        __syncthreads();
        {
            const int lt = w & 3, l = lt * 16 + fr; const float Ml = vb[64 + l];
#pragma unroll
            for (int s2 = 0; s2 < 2; ++s2) { const int st = (w >> 2) * 2 + s2;
                f32x4 acc = (f32x4){0.f, 0.f, 0.f, 0.f};
                if (st <= lt) {
#pragma unroll
                    for (int ks = 0; ks < 4; ++ks) acc = MFMA16(ldfrag(L + ML_KS + (st * 16 + fr) * 272 + ks * 64 + fq * 16), ldfrag(L + ML_QP + l * 400 + 128 + ks * 64 + fq * 16), acc); }
                f32x4 pv;
#pragma unroll
                for (int r = 0; r < 4; ++r) { const int s = st * 16 + 4 * fq + r; pv[r] = (s <= l) ? acc[r] * ML_SCALE * __expf(fminf(vb[s] - Ml, 0.f)) : 0.f; }
                st8(L + ML_QP + l * 400 + (st * 16 + 4 * fq) * 2, pv); }
        }
        __syncthreads();
        {
            const int lt = w & 3, dq = w >> 2, l = lt * 16 + fr;
            f32x4 aPV[5], aQC[5];
#pragma unroll
            for (int t = 0; t < 5; ++t) { aPV[t] = (f32x4){0.f, 0.f, 0.f, 0.f}; aQC[t] = (f32x4){0.f, 0.f, 0.f, 0.f}; }
            bf16x8 bq[6];
#pragma unroll
            for (int ks = 0; ks < 6; ++ks) bq[ks] = ldfrag(L + ML_QP + l * 400 + ks * 64 + fq * 16);
#pragma unroll
            for (int t = 0; t < 5; ++t) { const int tile = (t < 4) ? (dq * 4 + t) : 8;
#pragma unroll
                for (int ks = 0; ks < 2; ++ks) aPV[t] = MFMA16(ldfrag_tr(L + ML_VX + (ks * 32) * 304 + tile * 32 + tro304, 304), bq[ks], aPV[t]);
#pragma unroll
                for (int ks = 0; ks < 4; ++ks) aQC[t] = MFMA16(ldfrag(L + ML_CT + (tile * 16 + fr) * 272 + ks * 64 + fq * 16), bq[2 + ks], aQC[t]); }
            const float wi = vb[192 + l], eml = vb[128 + l];
            float den = aPV[4][0] + wi * aQC[4][0];
            den = __shfl(den, fr);
            const float inv = 1.0f / fmaxf(fabsf(den), eml);
            const int tt = j * 64 + l, t = dir ? (SEQ - 1 - tt) : tt; const size_t mrow = (size_t)(b * SEQ + t);
#pragma unroll
            for (int t4 = 0; t4 < 4; ++t4) { const f32x4 nv = (aPV[t4] + aQC[t4] * wi) * inv; v2u o; o.x = pk2(nv[0], nv[1]); o.y = pk2(nv[2], nv[3]);
                *(v2u*)(Hout + mrow * 1024 + (dq * 4 + t4) * 16 + 4 * fq) = o; }
        }
        {
            const float decay = vb[320];
            bf16x8 ak[2];
#pragma unroll
            for (int ks = 0; ks < 2; ++ks) ak[ks] = ldfrag_tr(L + ML_KW + (ks * 32) * 272 + w * 32 + tro272, 272);
#pragma unroll
            for (int t = 0; t < 9; ++t) { accS[t] = accS[t] * decay;
#pragma unroll
                for (int ks = 0; ks < 2; ++ks) accS[t] = MFMA16(ak[ks], ldfrag_tr(L + ML_VX + (ks * 32) * 304 + t * 32 + tro304, 304), accS[t]); }
        }
        __syncthreads();
#pragma unroll
        for (int t = 0; t < 9; ++t) st8(L + ML_CT + (t * 16 + fr) * 272 + (w * 16 + 4 * fq) * 2, accS[t]);
    }
    __syncthreads();
#undef ML_GATES
#undef ML_LOADQKV
#undef ML_LOADG
}

constexpr int DN_ST = 0, DN_QS = 34816, DN_KS = 52224, DN_KD = 69632, DN_VS = 87040, DN_T1 = 104448, DN_T2 = 113664, DN_AT = 122880, DN_WL = 132096;
constexpr int DN_VN = DN_VS;
constexpr int DN_WREG = 19456;
constexpr int DN_VEC = 8 * DN_WREG, DN_VECN = 264;
constexpr size_t WS_TSCR = 501 * MiB;
__device__ __forceinline__ void delta_unit(Frame& F, int unit, const float* d_alog, const float* d_dtb) {
    const int tid = F.tid, lane = F.lane, w = F.wave, fr0 = lane & 15, fq0 = lane >> 4;
    const int dir = unit & 1, h = (unit >> 1) & 7, b = unit >> 4;
    LAS unsigned char* L = F.lds;
    LAS float* vec = (LAS float*)(L + DN_VEC);
    f32x4 accS[8];
#pragma unroll
    for (int t = 0; t < 8; ++t) accS[t] = (f32x4){0.f, 0.f, 0.f, 0.f};
    const float* Ga = (const float*)(F.ws + WS_GATES) + 16 + dir * 8 + h; const float* Gb = Ga + 16;
    const bf16* Qg = (const bf16*)(F.ws + WS_DQ) + h * 128; const bf16* Kg = (const bf16*)(F.ws + WS_DK) + h * 128; const bf16* Vg = (const bf16*)(F.ws + WS_DV) + h * 128;
    bf16* Oout = (bf16*)(F.ws + (dir ? WS_ODB : WS_ODF)) + h * 128;
    bf16* Tg = (bf16*)(F.ws + WS_TSCR) + (size_t)unit * (8 * 4096);
    const float Aexp = __expf(d_alog[dir * 8 + h]), dtb = d_dtb[dir * 8 + h];
    const int sr = tid >> 4, sc = tid & 15;
    v4u q[2], k[2], v[2], tT;
    float g_a = 0.f, g_b = 0.f;
#define DN_GB(a_raw, b_raw, gq_, beta_) const float ap_ = (a_raw) + dtb; const float sp_ = ap_ > 0.f ? ap_ + __logf(1.0f + __expf(-ap_)) : __logf(1.0f + __expf(ap_)); \
        const float gq_ = -Aexp * sp_, beta_ = 1.0f / (1.0f + __expf(-(b_raw)));
#define DN_GATES(vb_, a_raw, b_raw) do { DN_GB(a_raw, b_raw, gq__, beta__) const float gc_ = wave_incl_sum(gq__), gl_ = lane63(gc_); \
        (vb_)[lane] = gc_; (vb_)[64 + lane] = beta__; (vb_)[128 + lane] = __expf(gc_); (vb_)[192 + lane] = __expf(gl_ - gc_); if (lane == 0) (vb_)[256] = __expf(gl_); } while (0)
#define DN_LOADG(jj) do { const int tt_ = (jj) * 64 + lane, t_ = dir ? (SEQ - 1 - tt_) : tt_; const unsigned go_ = (unsigned)(b * SEQ + t_) * 256u; g_a = *(const float*)((const char*)Ga + go_); g_b = *(const float*)((const char*)Gb + go_); } while (0)
#define DN_LOADQKV(jj) do { _Pragma("unroll") for (int p = 0; p < 2; ++p) { const int tt_ = (jj) * 64 + sr + 32 * p, t_ = dir ? (SEQ - 1 - tt_) : tt_; const unsigned ro_ = (unsigned)(b * SEQ + t_) * 2048u + (unsigned)sc * 16u; \
        q[p] = *(const v4u*)((const char*)Qg + ro_); k[p] = *(const v4u*)((const char*)Kg + ro_); v[p] = *(const v4u*)((const char*)Vg + ro_); } \
        tT = __builtin_nontemporal_load((const v4u*)((const char*)Tg + (unsigned)(((jj) & 7) * 8192 + tid * 16))); } while (0)
    if (w == 0) { DN_LOADG(0); DN_GATES(vec, g_a, g_b); DN_LOADG(1); }
    for (int grp = 0; grp < 4; ++grp) {
        int fr = fr0, fq = fq0; asm volatile("" : "+v"(fr), "+v"(fq));
        __syncthreads();
        {
            const int c = grp * 8 + w; const int tro144 = trofs(fq * 16 + fr, 144);
            LAS unsigned char* PA = L + w * DN_WREG; LAS unsigned char* XA = PA + 9216; LAS float* gv = (LAS float*)(PA + 18432);
            { const int tt = c * 64 + lane, t = dir ? (SEQ - 1 - tt) : tt; const unsigned go = (unsigned)(b * SEQ + t) * 256u;
              const float ar = *(const float*)((const char*)Ga + go), brw = *(const float*)((const char*)Gb + go);
              DN_GB(ar, brw, gq, beta) gv[lane] = wave_incl_sum(gq); gv[64 + lane] = beta; }
            f32x4 accX[4][4];
#pragma unroll
            for (int tb = 0; tb < 4; ++tb)
#pragma unroll
                for (int ta = 0; ta < 4; ++ta) accX[ta][tb] = (f32x4){0.f, 0.f, 0.f, 0.f};
#pragma unroll
            for (int kh = 0; kh < 2; ++kh) {
                bf16x8 kf[4][2];
#pragma unroll
                for (int t4 = 0; t4 < 4; ++t4) { const int tt = c * 64 + t4 * 16 + fr, t = dir ? (SEQ - 1 - tt) : tt; const unsigned ro = (unsigned)(b * SEQ + t) * 2048u + (unsigned)fq * 16u;
#pragma unroll
                    for (int ks = 0; ks < 2; ++ks) kf[t4][ks] = *(const bf16x8*)((const char*)Kg + ro + (kh * 2 + ks) * 64); }
#pragma unroll
                for (int tb = 0; tb < 4; ++tb)
#pragma unroll
                    for (int ta = 0; ta < 4; ++ta) if (ta <= tb) {
#pragma unroll
                        for (int ks = 0; ks < 2; ++ks) accX[ta][tb] = MFMA16(kf[ta][ks], kf[tb][ks], accX[ta][tb]); }
            }
#pragma unroll
            for (int tb = 0; tb < 4; ++tb)
#pragma unroll
                for (int ta = 0; ta < 4; ++ta) {
                    const int bI = tb * 16 + fr, a0 = ta * 16 + 4 * fq;
                    if (ta <= tb) {
                        const f32x4 acc = accX[ta][tb];
                        const float gcb = gv[bI], betab = gv[64 + bI];
                        f32x4 vna, vxa;
#pragma unroll
                        for (int r = 0; r < 4; ++r) { const int aI = a0 + r; const float e = -betab * acc[r] * __expf(fminf(gcb - gv[aI], 0.f));
                            if (ta == tb) { const int dd = (4 * fq + r) - fr; vna[r] = dd < 0 ? e : 0.f; vxa[r] = dd < 0 ? e : (dd == 0 ? 1.0f : 0.f); }
                            else { vna[r] = e; vxa[r] = e; } }
                        accX[ta][tb] = vxa;
                        st8(PA + bI * 144 + a0 * 2, vna); st8(XA + bI * 144 + a0 * 2, vxa);
                    } else { const f32x4 z = (f32x4){0.f, 0.f, 0.f, 0.f}; st8(PA + bI * 144 + a0 * 2, z); st8(XA + bI * 144 + a0 * 2, z); }
                }
#pragma unroll 1
            for (int kk = 1; kk <= 6; ++kk) {
                f32x4 accP[4][4];
                bf16x8 fA[4][2];
#pragma unroll
                for (int ta = 0; ta < 4; ++ta)
#pragma unroll
                    for (int ks = 0; ks < 2; ++ks) if (ks >= (ta >> 1)) fA[ta][ks] = ldfrag_tr(PA + (ks * 32) * 144 + ta * 32 + tro144, 144);
#pragma unroll
                for (int tb = 0; tb < 4; ++tb) {
                    bf16x8 pb[2], xb[2];
#pragma unroll
                    for (int ks = 0; ks < 2; ++ks) if (ks <= (tb >> 1)) { pb[ks] = ldfrag(PA + (tb * 16 + fr) * 144 + ks * 64 + fq * 16); xb[ks] = ldfrag(XA + (tb * 16 + fr) * 144 + ks * 64 + fq * 16); }
#pragma unroll
                    for (int ta = 0; ta < 4; ++ta) if (ta <= tb) {
                        accP[ta][tb] = (f32x4){0.f, 0.f, 0.f, 0.f};
#pragma unroll
                        for (int ks = 0; ks < 2; ++ks) if (ks >= (ta >> 1) && ks <= (tb >> 1)) {
                            if (kk <= 5) accP[ta][tb] = MFMA16(fA[ta][ks], pb[ks], accP[ta][tb]);
                            if (kk >= 2) accX[ta][tb] = MFMA16(fA[ta][ks], xb[ks], accX[ta][tb]); } }
                }
#pragma unroll
                for (int tb = 0; tb < 4; ++tb)
#pragma unroll
                    for (int ta = 0; ta < 4; ++ta) if (ta <= tb) { const int off = (tb * 16 + fr) * 144 + (ta * 16 + 4 * fq) * 2;
                        if (kk <= 5) st8(PA + off, accP[ta][tb]);
                        if (kk >= 2) st8(XA + off, accX[ta][tb]); }
            }
            bf16* Tc = Tg + (size_t)w * 4096;
#pragma unroll
            for (int tb = 0; tb < 4; ++tb)
#pragma unroll
                for (int ta = 0; ta < 4; ++ta) { v2u o; if (ta <= tb) { o.x = pk2(accX[ta][tb][0], accX[ta][tb][1]); o.y = pk2(accX[ta][tb][2], accX[ta][tb][3]); } else { o.x = 0u; o.y = 0u; }
                    *(v2u*)((char*)Tc + (unsigned)(((tb * 16 + fr) * 64 + ta * 16 + 4 * fq) * 2)) = o; }
        }
        __syncthreads();
#pragma unroll
        for (int t8 = 0; t8 < 8; ++t8) st8(L + DN_ST + (t8 * 16 + fr) * 272 + (w * 16 + 4 * fq) * 2, accS[t8]);
        DN_LOADQKV(grp * 8);
        for (int jc = 0; jc < 8; ++jc) {
            const int j = grp * 8 + jc; asm volatile("" : "+v"(fr), "+v"(fq)); const int tro272 = trofs(fq * 16 + fr, 272);
            LAS float* vb = vec + (j & 1) * DN_VECN;
#pragma unroll
            for (int p = 0; p < 2; ++p) { const int r = sr + 32 * p; const float kds = vb[192 + r];
                *(LAS v4u*)(L + DN_QS + r * 272 + sc * 16) = q[p]; *(LAS v4u*)(L + DN_KS + r * 272 + sc * 16) = k[p];
                *(LAS v4u*)(L + DN_KD + r * 272 + sc * 16) = scale8(k[p], kds); *(LAS v4u*)(L + DN_VS + r * 272 + sc * 16) = v[p]; }
            {
                const int tr = tid >> 3, c0 = (tid & 7) * 8; v4u t1, t2;
#pragma unroll
                for (int i = 0; i < 4; ++i) { const float b0 = vb[64 + c0 + 2 * i], b1 = vb[64 + c0 + 2 * i + 1], e0 = vb[128 + c0 + 2 * i], e1 = vb[128 + c0 + 2 * i + 1];
                    const float x0 = bflo(tT[i]) * b0, x1 = bfhi(tT[i]) * b1; t1[i] = pk2(x0, x1); t2[i] = pk2(x0 * e0, x1 * e1); }
                *(LAS v4u*)(L + DN_T1 + tr * 144 + c0 * 2) = t1; *(LAS v4u*)(L + DN_T2 + tr * 144 + c0 * 2) = t2; }
            if (jc + 1 < 8) DN_LOADQKV(j + 1);
            if (w == 0 && j + 1 < 32) { LAS float* vn = vec + ((j + 1) & 1) * DN_VECN; DN_GATES(vn, g_a, g_b); if (j + 2 < 32) DN_LOADG(j + 2); }
            __syncthreads();
            f32x4 accU[4];
            {
                const int tb = w & 3, bI = tb * 16 + fr; const float gcb = vb[bI];
#pragma unroll
                for (int x = 0; x < 2; ++x) { const int ta = (w >> 2) * 2 + x, a0 = ta * 16 + 4 * fq;
                    f32x4 acc = (f32x4){0.f, 0.f, 0.f, 0.f};
                    if (ta <= tb) {
#pragma unroll
                        for (int ks = 0; ks < 4; ++ks) acc = MFMA16(ldfrag(L + DN_KS + (ta * 16 + fr) * 272 + ks * 64 + fq * 16), ldfrag(L + DN_QS + bI * 272 + ks * 64 + fq * 16), acc); }
                    f32x4 vat;
#pragma unroll
                    for (int r = 0; r < 4; ++r) { const int aI = a0 + r; const float e = acc[r] * __expf(fminf(gcb - vb[aI], 0.f)); vat[r] = (ta < tb || (ta == tb && 4 * fq + r <= fr)) ? e : 0.f; }
                    st8(L + DN_AT + bI * 144 + a0 * 2, vat); }
                f32x4 accW[4];
#pragma unroll
                for (int lt = 0; lt < 4; ++lt) { accU[lt] = (f32x4){0.f, 0.f, 0.f, 0.f}; accW[lt] = (f32x4){0.f, 0.f, 0.f, 0.f}; }
#pragma unroll
                for (int ks = 0; ks < 2; ++ks) {
                    const bf16x8 vtr = ldfrag_tr(L + DN_VS + (ks * 32) * 272 + w * 32 + tro272, 272), ktr = ldfrag_tr(L + DN_KS + (ks * 32) * 272 + w * 32 + tro272, 272);
#pragma unroll
                    for (int lt = 0; lt < 4; ++lt) if (ks <= (lt >> 1)) {
                        accU[lt] = MFMA16(ldfrag(L + DN_T1 + (lt * 16 + fr) * 144 + ks * 64 + fq * 16), vtr, accU[lt]);
                        accW[lt] = MFMA16(ktr, ldfrag(L + DN_T2 + (lt * 16 + fr) * 144 + ks * 64 + fq * 16), accW[lt]); } }
#pragma unroll
                for (int lt = 0; lt < 4; ++lt) { const f32x4 nw = -accW[lt]; st8(L + DN_WL + (lt * 16 + fr) * 272 + (w * 16 + 4 * fq) * 2, nw); }
            }
            __syncthreads();
            {
#pragma unroll
                for (int ks = 0; ks < 4; ++ks) { const int ko = ks * 64 + fq * 16;
                    const bf16x8 sb = ldfrag(L + DN_ST + (w * 16 + fr) * 272 + ko);
#pragma unroll
                    for (int lt = 0; lt < 4; ++lt) accU[lt] = MFMA16(ldfrag(L + DN_WL + (lt * 16 + fr) * 272 + ko), sb, accU[lt]); }
#pragma unroll
                for (int lt = 0; lt < 4; ++lt) st8(L + DN_VN + (w * 16 + fr) * 144 + (lt * 16 + 4 * fq) * 2, accU[lt]);
            }
            __syncthreads();
            {
                const int lt = w & 3, dq = w >> 2, l = lt * 16 + fr;
                f32x4 aOA[4], aOQ[4];
#pragma unroll
                for (int t = 0; t < 4; ++t) { aOA[t] = (f32x4){0.f, 0.f, 0.f, 0.f}; aOQ[t] = (f32x4){0.f, 0.f, 0.f, 0.f}; }
#pragma unroll
                for (int ks = 0; ks < 2; ++ks) { const int ko = ks * 64 + fq * 16; const bf16x8 ab = ldfrag(L + DN_AT + l * 144 + ko);
#pragma unroll
                    for (int t = 0; t < 4; ++t) aOA[t] = MFMA16(ldfrag(L + DN_VN + ((dq * 4 + t) * 16 + fr) * 144 + ko), ab, aOA[t]); }
#pragma unroll
                for (int ks = 0; ks < 4; ++ks) { const int ko = ks * 64 + fq * 16; const bf16x8 qb = ldfrag(L + DN_QS + l * 272 + ko);
#pragma unroll
                    for (int t = 0; t < 4; ++t) aOQ[t] = MFMA16(ldfrag(L + DN_ST + ((dq * 4 + t) * 16 + fr) * 272 + ko), qb, aOQ[t]); }
                const float egl_l = vb[128 + l];
                const int tt = j * 64 + l, t = dir ? (SEQ - 1 - tt) : tt; const unsigned oo = (unsigned)(b * SEQ + t) * 2048u + (unsigned)(dq * 64 + 4 * fq) * 2u;
#pragma unroll
                for (int t4 = 0; t4 < 4; ++t4) { const f32x4 ov = aOA[t4] + aOQ[t4] * egl_l; v2u o; o.x = pk2(ov[0], ov[1]); o.y = pk2(ov[2], ov[3]);
                    *(v2u*)((char*)Oout + oo + t4 * 32) = o; }
                const float egl = vb[256];
                bf16x8 ak[2];
#pragma unroll
                for (int ks = 0; ks < 2; ++ks) ak[ks] = ldfrag_tr(L + DN_KD + (ks * 32) * 272 + w * 32 + tro272, 272);
#pragma unroll
                for (int t8 = 0; t8 < 8; ++t8) { accS[t8] = accS[t8] * egl;
#pragma unroll
                    for (int ks = 0; ks < 2; ++ks) accS[t8] = MFMA16(ak[ks], ldfrag(L + DN_VN + (t8 * 16 + fr) * 144 + ks * 64 + fq * 16), accS[t8]); }
            }
            __syncthreads();
#pragma unroll
            for (int t8 = 0; t8 < 8; ++t8) st8(L + DN_ST + (t8 * 16 + fr) * 272 + (w * 16 + 4 * fq) * 2, accS[t8]);
        }
    }
    __syncthreads();
#undef DN_GB
#undef DN_GATES
#undef DN_LOADG
#undef DN_LOADQKV
}

__device__ __forceinline__ void p4_combine(Frame& F, const float* m_ng, const float* d_ng) {
    const int gw = F.vcu * NWAVES + F.wave, NGW = F.G * NWAVES, lane = F.lane;
    const bf16* PROJ = (const bf16*)(F.ws + WS_PROJ);
    const bf16* HMf = (const bf16*)(F.ws + WS_HM); const bf16* HMb = HMf + (size_t)MROWS * 1024;
    const bf16* ODf = (const bf16*)(F.ws + WS_ODF); const bf16* ODb = (const bf16*)(F.ws + WS_ODB);
    bf16* YM = (bf16*)(F.ws + WS_YM); bf16* YD = (bf16*)(F.ws + WS_YD);
    for (int m = gw; m < MROWS; m += NGW) {
        v2u hf[4], hb[4], mo[4]; unsigned of[8], ob[8], dz[8];
#pragma unroll
        for (int h = 0; h < 4; ++h) { hf[h] = *(const v2u*)(HMf + (size_t)m * 1024 + h * 256 + 4 * lane); hb[h] = *(const v2u*)(HMb + (size_t)m * 1024 + h * 256 + 4 * lane);
            mo[h] = *(const v2u*)(PROJ + (size_t)(8 + h) * BLK + (size_t)m * 256 + 4 * lane); }
#pragma unroll
        for (int h = 0; h < 8; ++h) { of[h] = *(const unsigned*)(ODf + (size_t)m * 1024 + h * 128 + 2 * lane); ob[h] = *(const unsigned*)(ODb + (size_t)m * 1024 + h * 128 + 2 * lane);
            dz[h] = *(const unsigned*)(PROJ + (size_t)(24 + (h >> 1)) * BLK + (size_t)m * 256 + (h & 1) * 128 + 2 * lane); }
#pragma unroll
        for (int h = 0; h < 4; ++h) {
            const float a0 = bflo(hf[h].x) + bflo(hb[h].x), a1 = bfhi(hf[h].x) + bfhi(hb[h].x), a2 = bflo(hf[h].y) + bflo(hb[h].y), a3 = bfhi(hf[h].y) + bfhi(hb[h].y);
            const float ss = wave_sum((a0 * a0 + a1 * a1) + (a2 * a2 + a3 * a3));
            const float r = 1.0f / sqrtf(ss * (1.f / 256.f) + RMS_EPS);
            const f32x4 g = *(const f32x4*)(m_ng + h * 256 + 4 * lane);
            const float o0 = bflo(mo[h].x), o1 = bfhi(mo[h].x), o2 = bflo(mo[h].y), o3 = bfhi(mo[h].y);
            v2u y; y.x = pk2(a0 * r * g.x / (1.f + expf(-o0)), a1 * r * g.y / (1.f + expf(-o1))); y.y = pk2(a2 * r * g.z / (1.f + expf(-o2)), a3 * r * g.w / (1.f + expf(-o3)));
            *(v2u*)(YM + (size_t)m * 1024 + h * 256 + 4 * lane) = y;
        }
        const float g0 = d_ng[2 * lane], g1 = d_ng[2 * lane + 1];
#pragma unroll
        for (int h = 0; h < 8; ++h) {
            const float a0 = bflo(of[h]) + bflo(ob[h]), a1 = bfhi(of[h]) + bfhi(ob[h]);
            const float ss = wave_sum(a0 * a0 + a1 * a1);
            const float r = 1.0f / sqrtf(ss * (1.f / 128.f) + RMS_EPS);
            const float z0 = bflo(dz[h]), z1 = bfhi(dz[h]);
            *(unsigned*)(YD + (size_t)m * 1024 + h * 128 + 2 * lane) = pk2(a0 * r * g0 * z0 / (1.f + expf(-z0)), a1 * r * g1 * z1 / (1.f + expf(-z1)));
        }
    }
}

__device__ __forceinline__ void p7_norm2(Frame& F, const float* n2g, const float* w_ff1, const float* w_ff2) {
    LAS float* scr = (LAS float*)(F.lds + F.wave * 16384);
    const int gw = F.vcu * NWAVES + F.wave, NGW = F.G * NWAVES;
    bf16* W1T = (bf16*)(F.ws + WS_W1T); bf16* W2T = (bf16*)(F.ws + WS_W2T); bf16* XN2 = (bf16*)(F.ws + WS_XN2);
    constexpr int I_1 = (DM / 64) * (DFF / 32), I_2 = (DFF / 64) * (DM / 32);
    for (int it = gw; it < I_1 + I_2; it += NGW) {
        if (it < I_1) tr_item(w_ff1, DM, DFF, W1T, scr, it, F.lane, false); else tr_item(w_ff2, DFF, DM, W2T, scr, it - I_1, F.lane, false);
    }
    for (int m = gw; m < MROWS; m += NGW) rms_row_bf16(F.lane, F.out + (size_t)m * DM, n2g, XN2 + (size_t)m * DM);
}
__device__ __forceinline__ void p10_final(Frame& F, const float* nfg) {
    const int gw = F.vcu * NWAVES + F.wave, NGW = F.G * NWAVES;
    for (int m = gw; m < MROWS; m += NGW) rms_row_f32(F.lane, F.out + (size_t)m * DM, nfg, F.out + (size_t)m * DM);
}
struct Args { const float* in[17]; float* out; unsigned char* ws; int ph_lo, ph_hi, li, pad; };
__global__ void __launch_bounds__(NWAVES * 64, 2) hybrid_fwd(Args args) {
    extern __shared__ __attribute__((aligned(16))) unsigned char lds[];
    Frame F;
    F.lds = (LAS unsigned char*)lds;
    F.MISC = (volatile LAS unsigned*)(F.lds + MISC_OFF);
    F.tid = threadIdx.x; F.lane = F.tid & 63; F.wave = __builtin_amdgcn_readfirstlane(F.tid >> 6);
    F.G = gridDim.x; { const int bx = blockIdx.x; F.vcu = (F.G % 8 == 0) ? (bx % 8) * (F.G / 8) + bx / 8 : bx; }
    F.ws = args.ws; F.ctl = (gu32*)(args.ws + WS_CTL);
    F.out = args.out;
    if (F.tid < 64) ((LAS unsigned*)(F.lds + MISC_OFF))[F.tid] = 0u;
    __syncthreads();
    XcdBarrier bar; bar.bar = (unsigned*)(F.ctl + CW_BAR); bar.x = 0; bar.st = nullptr;
    if (N_LAUNCHES != PER_PHASE) bar = xcd_barrier_post((unsigned*)(F.ctl + CW_BAR), F.MISC + 8);
#define GRID_BAR() do { if (N_LAUNCHES != PER_PHASE) xcd_barrier(bar); } while (0)
    const int lo = args.ph_lo, hi = args.ph_hi;
#ifndef PHASE_MASK
#define PHASE_MASK 0x7ff
#endif
#define IN(k) (((PHASE_MASK >> (k)) & 1) && lo <= (k) && (k) < hi)
#define BOTH(k) (IN(k) && IN((k) + 1))
    bf16* PROJ = (bf16*)(F.ws + WS_PROJ);

    if (IN(0)) { p0_prologue(F, args.in[0], args.in[1], args.in[2], args.in[10], args.in[11], args.in[12]); if (BOTH(0)) GRID_BAR(); }
    if (IN(1)) {
        pg8::Gemm g{(const bf16*)(F.ws + WS_XN), (const bf16*)(F.ws + WS_WIN), MROWS, NPROJ_PAD, DM}; pg8::StaticOrder S; S.init(MROWS, NPROJ_PAD, F.G, (int)blockIdx.x);
        pg8::EpiProj E{PROJ, (float*)(F.ws + WS_GATES)};
        pg8::gemm_phase<pg8::EpiProj, pg8::StaticOrder, true, true>(F.lds, g, S, E);
        if (BOTH(1)) GRID_BAR();
    }
    if (IN(2)) { p2_conv(F, args.in[6]); if (BOTH(2)) GRID_BAR(); }
    if (IN(3)) {
        const int u = F.vcu;
        if (u < 128) { if (args.pad != 2) mlstm_unit(F, u, args.in[3], args.in[4]); }
        else if (u < 256) { if (args.pad != 1) delta_unit(F, u - 128, args.in[7], args.in[8]); }
        if (BOTH(3)) GRID_BAR();
    }
    if (IN(4)) { p4_combine(F, args.in[5], args.in[9]); if (BOTH(4)) GRID_BAR(); }
    if (IN(5)) {
        pg8::Gemm g{(const bf16*)(F.ws + WS_YM), (const bf16*)(F.ws + WS_WBM), 2 * MROWS, 4096, 1024}; pg8::BranchOrder S; S.init(F.G, (int)blockIdx.x);
        pg8::EpiBranch E{PROJ, (bf16*)(F.ws + WS_MIX)};
        pg8::gemm_phase<pg8::EpiBranch, pg8::BranchOrder, true, true>(F.lds, g, S, E);
        if (BOTH(5)) GRID_BAR();
    }
    if (IN(6)) {
        pg8::Gemm g{(const bf16*)(F.ws + WS_MIX), (const bf16*)(F.ws + WS_WOUT), MROWS, DM, DM}; pg8::StaticOrder S; S.init(MROWS, DM, F.G, (int)blockIdx.x);
        pg8::EpiResid E{args.in[0], F.out, DM};
        pg8::gemm_phase<pg8::EpiResid, pg8::StaticOrder, true, true>(F.lds, g, S, E);
        if (BOTH(6)) GRID_BAR();
    }
    if (IN(7)) { p7_norm2(F, args.in[13], args.in[14], args.in[15]); if (BOTH(7)) GRID_BAR(); }
    if (IN(8)) {
        pg8::Gemm g{(const bf16*)(F.ws + WS_XN2), (const bf16*)(F.ws + WS_W1T), MROWS, DFF, DM}; pg8::StaticOrder S; S.init(MROWS, DFF, F.G, (int)blockIdx.x);
        pg8::EpiRelu2 E{(bf16*)(F.ws + WS_HFF), DFF};
        pg8::gemm_phase<pg8::EpiRelu2, pg8::StaticOrder, true, true>(F.lds, g, S, E);
        if (BOTH(8)) GRID_BAR();
    }
    if (IN(9)) {
        pg8::Gemm g{(const bf16*)(F.ws + WS_HFF), (const bf16*)(F.ws + WS_W2T), MROWS, DM, DFF}; pg8::StaticOrder S; S.init(MROWS, DM, F.G, (int)blockIdx.x);
        pg8::EpiResid E{F.out, F.out, DM};
        pg8::gemm_phase<pg8::EpiResid, pg8::StaticOrder, true, true>(F.lds, g, S, E);
        if (BOTH(9)) GRID_BAR();
    }
    if (IN(10)) { p10_final(F, args.in[16]); }
#undef IN
#undef BOTH
}

extern "C" void kernel_launch(void* const* d_in, const int* in_sizes, int n_in, void* d_out, int out_size, void* d_ws, size_t ws_size, hipStream_t stream) {
    static int grid = 0;
    if (grid == 0) {
        if (n_in != 17 || in_sizes[0] != MROWS * DM || out_size != MROWS * DM || ws_size < WS_END) {
            fprintf(stderr, "kernel_launch: unexpected problem: n_in %d, in0 %d, out %d, ws %zu (need %zu); nothing launched\n", n_in, n_in > 0 ? in_sizes[0] : -1, out_size, ws_size, (size_t)WS_END); grid = -1; return; }
        int dev = 0, cus = 0, per_cu = 0;
        if (hipGetDevice(&dev) != hipSuccess || hipDeviceGetAttribute(&cus, hipDeviceAttributeMultiprocessorCount, dev) != hipSuccess) { fprintf(stderr, "kernel_launch: device query failed\n"); grid = -1; return; }
        if (hipFuncSetAttribute((const void*)hybrid_fwd, hipFuncAttributeMaxDynamicSharedMemorySize, LDS_BYTES) != hipSuccess) { fprintf(stderr, "kernel_launch: hipFuncSetAttribute failed\n"); grid = -1; return; }
        if (hipOccupancyMaxActiveBlocksPerMultiprocessor(&per_cu, (const void*)hybrid_fwd, NWAVES * 64, LDS_BYTES) != hipSuccess || per_cu < 1)
            fprintf(stderr, "kernel_launch: note: occupancy query reports %d workgroups per CU\n", per_cu);
        (void)hipGetLastError();
        grid = cus;
    }
    if (grid < 0) return;
    if (hipMemsetAsync((char*)d_ws + WS_CTL, 0, CTL_ZERO_BYTES, stream) != hipSuccess) { fprintf(stderr, "kernel_launch: memset failed\n"); return; }
    Args a{};
    for (int i = 0; i < 17; ++i) a.in[i] = (const float*)d_in[i];
    a.out = (float*)d_out; a.ws = (unsigned char*)d_ws;
#ifdef PROBE_PH
    const int nl = 2; const int plo[2] = {0, PROBE_PH}, phi[2] = {PROBE_PH + 1, PER_PHASE};
#else
    const int nl = N_LAUNCHES; const int plo[2] = {0, 0}, phi[2] = {PER_PHASE, PER_PHASE};
#endif
    for (int li = 0; li < nl; ++li) {
        if (li > 0 && N_LAUNCHES != PER_PHASE) (void)hipMemsetAsync((char*)d_ws + WS_CTL, 0, CTL_ZERO_BYTES, stream);
#ifdef PROBE_SKIP
        a.pad = (li == 1) ? PROBE_SKIP : 0;
#endif
        a.ph_lo = (N_LAUNCHES == PER_PHASE) ? li : plo[li & 1]; a.ph_hi = (N_LAUNCHES == PER_PHASE) ? li + 1 : phi[li & 1]; a.li = li;
        hipLaunchKernelGGL(hybrid_fwd, dim3(grid), dim3(NWAVES * 64), LDS_BYTES, stream, a);
        const hipError_t le = hipPeekAtLastError();
        if (le != hipSuccess) { fprintf(stderr, "kernel_launch: launch %d failed: %s\n", li, hipGetErrorName(le)); break; }
    }
}
```

```cpp
#include <hip/hip_runtime.h>
#include <cstdio>
#include <cstdint>

#ifndef MK_N_LAUNCHES
#define MK_N_LAUNCHES 1
#endif
constexpr int MROWS = 16384;
namespace pg8 {
#define PG8_LAS __attribute__((address_space(3)))
typedef unsigned short bf16_t;
typedef short bf16x8 __attribute__((ext_vector_type(8)));
typedef float f32x4 __attribute__((ext_vector_type(4)));
typedef unsigned u32x4 __attribute__((ext_vector_type(4)));
constexpr int BM = 256, BK = 64, HALF = 128, HTB = HALF * BK * 2  , STAGE_BYTES = 8 * HTB, NXCD = 8, WGM = 8;

__host__ __device__ __forceinline__ int lds_byte(int r, int c) { const int st = (r >> 4) * 2 + (c >> 5), rr = r & 15, cc = c & 31, ob = rr * 64 + cc * 2; return st * 1024 + (ob ^ (((ob >> 9) & 1) << 5)); }
__host__ __device__ __forceinline__ void stage_rc(int b, int& R, int& C) { const int st = b / 1024, sb = b % 1024, swz = sb ^ (((sb >> 9) & 1) << 5); R = (st >> 1) * 16 + swz / 64; C = (st & 1) * 32 + (swz % 64) / 2; }
__host__ __device__ __forceinline__ int perm32(int rho) { const int n = rho >> 4, i = rho & 15; return 8 * (i >> 2) + 4 * n + (i & 3); }

struct Unit { int pm, pn; };
struct Gemm { const bf16_t* A; const bf16_t* Bt; int M, N, K; };

struct StaticOrder {
    int nM, nN, nwg, G, c;
    __host__ __device__ void init(int M, int N, int G_, int c_) { nM = M / BM; nN = N / BM; nwg = nM * nN; G = G_; c = c_; }
    __host__ __device__ bool next(int i, Unit& u) const {
        const long L = (long)i * G + c; if (L >= nwg) return false;
        int wgid = (int)L; { const int q = nwg / NXCD, r = nwg % NXCD, xcd = wgid % NXCD, off = wgid / NXCD; wgid = (xcd < r ? xcd * (q + 1) : r * (q + 1) + (xcd - r) * q) + off; }
        const int nig = WGM * nN, gid = wgid / nig, fm = gid * WGM, gsz = (nM - fm) < WGM ? (nM - fm) : WGM;
        u.pm = fm + ((wgid % nig) % gsz); u.pn = (wgid % nig) / gsz; return true;
    }
    __device__ __forceinline__ void a_ready(const Unit&) const {}
    __device__ __forceinline__ void done(const Unit&) const {}
};

__device__ __forceinline__ unsigned cvt_pk_bf16(float lo, float hi) { unsigned r; asm volatile("v_cvt_pk_bf16_f32 %0, %1, %2" : "=v"(r) : "v"(lo), "v"(hi)); return r; }
typedef float f32x2 __attribute__((ext_vector_type(2)));
typedef unsigned u32x2 __attribute__((ext_vector_type(2)));
__device__ __forceinline__ float bf_lo(unsigned w) { return __uint_as_float(w << 16); }
__device__ __forceinline__ float bf_hi(unsigned w) { return __uint_as_float(w & 0xffff0000u); }
__device__ __forceinline__ float fsigmoid(float x) { return __builtin_amdgcn_rcpf(1.0f + __expf(-x)); }

struct EpiProj {
    static constexpr bool PERM = true, AFTER_DRAIN = false;
    bf16_t* P; float* gates;
    __device__ __forceinline__ void operator()(const f32x4 (&acc)[2][2][4][2], const Unit& u, int wr, int wc, int fr, int fq) const {
        const int row0 = u.pm * BM + wr * 64 + fr;
        if (u.pn < 44) {
            bf16_t* base = P + (size_t)u.pn * ((size_t)MROWS * 256) + wc * 32 + 8 * fq;
#pragma unroll
            for (int ai = 0; ai < 2; ++ai)
#pragma unroll
                for (int m = 0; m < 4; ++m) { bf16_t* rowp = base + (size_t)(row0 + ai * HALF + m * 16) * 256;
#pragma unroll
                    for (int bj = 0; bj < 2; ++bj) { const f32x4 v0 = acc[ai][bj][m][0], v1 = acc[ai][bj][m][1];
                        u32x4 w; w.x = cvt_pk_bf16(v0[0], v0[1]); w.y = cvt_pk_bf16(v0[2], v0[3]); w.z = cvt_pk_bf16(v1[0], v1[1]); w.w = cvt_pk_bf16(v1[2], v1[3]);
                        *(u32x4*)(rowp + bj * HALF) = w; } }
        } else if (wc < 2) {
#pragma unroll
            for (int ai = 0; ai < 2; ++ai)
#pragma unroll
                for (int m = 0; m < 4; ++m) { float* rp = gates + (size_t)(row0 + ai * HALF + m * 16) * 64 + wc * 32 + 8 * fq;
                    *(f32x4*)rp = acc[ai][0][m][0]; *(f32x4*)(rp + 4) = acc[ai][0][m][1]; }
        }
    }
};

struct EpiBranch {
    static constexpr bool PERM = true, AFTER_DRAIN = false;
    const bf16_t* G; bf16_t* O;
    __device__ __forceinline__ void operator()(const f32x4 (&acc)[2][2][4][2], const Unit& u, int wr, int wc, int fr, int fq) const {
        const int br = u.pn >> 3, pn = u.pn & 7, pm = u.pm & 63;
        const int row0 = pm * BM + wr * 64 + fr, cl = wc * 32 + 8 * fq;
        const bf16_t* gbase = G + (size_t)(28 + 8 * br + pn) * ((size_t)MROWS * 256) + cl;
        bf16_t* obase = O + pn * 256 + cl;
#pragma unroll
        for (int ai = 0; ai < 2; ++ai)
#pragma unroll
            for (int m = 0; m < 4; ++m) { const size_t r = (size_t)(row0 + ai * HALF + m * 16);
#pragma unroll
                for (int bj = 0; bj < 2; ++bj) {
                    const u32x4 gv = *(const u32x4*)(gbase + r * 256 + bj * HALF);
                    const f32x4 a0 = acc[ai][bj][m][0], a1 = acc[ai][bj][m][1];
                    float v[8];
                    v[0] = a0[0] * fsigmoid(bf_lo(gv.x)); v[1] = a0[1] * fsigmoid(bf_hi(gv.x)); v[2] = a0[2] * fsigmoid(bf_lo(gv.y)); v[3] = a0[3] * fsigmoid(bf_hi(gv.y));
                    v[4] = a1[0] * fsigmoid(bf_lo(gv.z)); v[5] = a1[1] * fsigmoid(bf_hi(gv.z)); v[6] = a1[2] * fsigmoid(bf_lo(gv.w)); v[7] = a1[3] * fsigmoid(bf_hi(gv.w));
                    bf16_t* op = obase + r * 2048 + bj * HALF;
                    if (br) { const u32x4 pv = *(const u32x4*)op;
                        v[0] += bf_lo(pv.x); v[1] += bf_hi(pv.x); v[2] += bf_lo(pv.y); v[3] += bf_hi(pv.y); v[4] += bf_lo(pv.z); v[5] += bf_hi(pv.z); v[6] += bf_lo(pv.w); v[7] += bf_hi(pv.w); }
                    u32x4 w; w.x = cvt_pk_bf16(v[0], v[1]); w.y = cvt_pk_bf16(v[2], v[3]); w.z = cvt_pk_bf16(v[4], v[5]); w.w = cvt_pk_bf16(v[6], v[7]);
                    *(u32x4*)op = w; } }
    }
};
struct BranchOrder {
    StaticOrder so;
    __host__ __device__ void init(int G_, int c_) { so.init(MROWS, 2048, G_, c_); }
    __host__ __device__ bool next(int i, Unit& u) const { Unit t; if (!so.next(i >> 1, t)) return false; const int br = i & 1; u.pm = t.pm + 64 * br; u.pn = t.pn + 8 * br; return true; }
    __device__ __forceinline__ void a_ready(const Unit&) const {}
    __device__ __forceinline__ void done(const Unit&) const {}
};

struct EpiResid {
    static constexpr bool PERM = false, AFTER_DRAIN = false;
    const float* base; float* out; int ldc;
    __device__ __forceinline__ void operator()(const f32x4 (&acc)[2][2][4][2], const Unit& u, int wr, int wc, int fr, int fq) const {
        const int col0 = u.pn * BM + wc * 32 + 4 * fq;
#pragma unroll
        for (int ai = 0; ai < 2; ++ai)
#pragma unroll
            for (int m = 0; m < 4; ++m) { const size_t off = (size_t)(u.pm * BM + ai * HALF + wr * 64 + m * 16 + fr) * ldc + col0;
#pragma unroll
                for (int bj = 0; bj < 2; ++bj)
#pragma unroll
                    for (int n = 0; n < 2; ++n) { const f32x4 bs = *(const f32x4*)(base + off + bj * HALF + n * 16); *(f32x4*)(out + off + bj * HALF + n * 16) = bs + acc[ai][bj][m][n]; } }
    }
};

struct EpiRelu2 {
    static constexpr bool PERM = true, AFTER_DRAIN = false;
    bf16_t* O; int ldc;
    __device__ __forceinline__ void operator()(const f32x4 (&acc)[2][2][4][2], const Unit& u, int wr, int wc, int fr, int fq) const {
        const int row0 = u.pm * BM + wr * 64 + fr, col0 = u.pn * BM + wc * 32 + 8 * fq;
#pragma unroll
        for (int ai = 0; ai < 2; ++ai)
#pragma unroll
            for (int m = 0; m < 4; ++m) { bf16_t* rowp = O + (size_t)(row0 + ai * HALF + m * 16) * ldc + col0;
#pragma unroll
                for (int bj = 0; bj < 2; ++bj) { f32x4 v0 = acc[ai][bj][m][0], v1 = acc[ai][bj][m][1];
#pragma unroll
                    for (int e = 0; e < 4; ++e) { const float a = fmaxf(v0[e], 0.f), b = fmaxf(v1[e], 0.f); v0[e] = a * a; v1[e] = b * b; }
                    u32x4 w; w.x = cvt_pk_bf16(v0[0], v0[1]); w.y = cvt_pk_bf16(v0[2], v0[3]); w.z = cvt_pk_bf16(v1[0], v1[1]); w.w = cvt_pk_bf16(v1[2], v1[3]);
                    *(u32x4*)(rowp + bj * HALF) = w; } }
    }
};
template <class Epi, class Sched, bool ALIGN_EPI = false, bool SP2 = false>
__device__ __forceinline__ void gemm_phase(PG8_LAS unsigned char* lds, const Gemm g, const Sched& S, const Epi& E) {
    const int tid = threadIdx.x, wid = __builtin_amdgcn_readfirstlane(tid >> 6), lane = tid & 63, wr = wid >> 2, wc = wid & 3, fr = lane & 15, fq = lane >> 4;
    const int K = g.K, nt = K / BK;
    unsigned voffA[2], voffB[2];
#pragma unroll
    for (int i = 0; i < 2; ++i) { int R, C; stage_rc(tid * 16 + i * 8192, R, C); const int Rb = Epi::PERM ? ((R & ~31) + perm32(R & 31)) : R;
        voffA[i] = (unsigned)(R * K + C) * 2u; voffB[i] = (unsigned)(Rb * K + C) * 2u; }
    const size_t kstep = (size_t)(BK * 2);
    const size_t hstep = (size_t)HALF * K * 2;
    const size_t tstep = 2 * hstep;
    const unsigned ldsw = (unsigned)wid * 1024u;
    const int aoff = lds_byte(wr * 64 + fr, fq * 8), boff = lds_byte(wc * 32 + fr, fq * 8);
#define PG8_SA(b, h) (((b) * 2 + (h)) * HTB)
#define PG8_SB(b, h) ((4 + (b) * 2 + (h)) * HTB)
#define PG8_STAGE(bufoff, gbase, voff) do { _Pragma("unroll") for (int _i = 0; _i < 2; ++_i) \
        __builtin_amdgcn_global_load_lds((const unsigned*)((const char*)(gbase) + (voff)[_i]), (PG8_LAS unsigned*)(lds + (bufoff) + ldsw + _i * 8192), 16, 0, 0); } while (0)
#define PG8_LDA(dst, b, h) do { _Pragma("unroll") for (int m = 0; m < 4; ++m) _Pragma("unroll") for (int k = 0; k < 2; ++k) dst[m][k] = *(const PG8_LAS bf16x8*)(lds + PG8_SA(b, h) + aoff + m * 2048 + k * 1024); } while (0)
#define PG8_LDB(dst, b, h) do { _Pragma("unroll") for (int n = 0; n < 2; ++n) _Pragma("unroll") for (int k = 0; k < 2; ++k) dst[n][k] = *(const PG8_LAS bf16x8*)(lds + PG8_SB(b, h) + boff + n * 2048 + k * 1024); } while (0)
#define PG8_MMA(ai, bj, At, Bt) do { __builtin_amdgcn_s_setprio(1); _Pragma("unroll") for (int m = 0; m < 4; ++m) _Pragma("unroll") for (int n = 0; n < 2; ++n) _Pragma("unroll") for (int k = 0; k < 2; ++k) \
        acc[ai][bj][m][n] = __builtin_amdgcn_mfma_f32_16x16x32_bf16(Bt[n][k], At[m][k], acc[ai][bj][m][n], 0, 0, 0); __builtin_amdgcn_s_setprio(0); } while (0)
#define PG8_WAIT_V(n) asm volatile("s_waitcnt vmcnt(" #n ")" ::: "memory")
#define PG8_WAIT_L(n) asm volatile("s_waitcnt lgkmcnt(" #n ")" ::: "memory")
#define PG8_BAR __builtin_amdgcn_s_barrier()
#define PG8_SCHED __builtin_amdgcn_sched_barrier(0)
    Unit cur, nxt; int ui = 0;
    if (!S.next(0, cur)) return;
    f32x4 acc[2][2][4][2];
#pragma unroll
    for (int a = 0; a < 2; ++a)
#pragma unroll
        for (int b = 0; b < 2; ++b)
#pragma unroll
            for (int m = 0; m < 4; ++m)
#pragma unroll
                for (int n = 0; n < 2; ++n) acc[a][b][m][n] = (f32x4){0.f, 0.f, 0.f, 0.f};
    bf16x8 At[4][2], B0[2][2], B1[2][2];
    const char* cA = (const char*)g.A + (size_t)cur.pm * tstep; const char* cB = (const char*)g.Bt + (size_t)cur.pn * tstep;
    S.a_ready(cur);
    if constexpr (SP2) {
        PG8_STAGE(PG8_SB(0, 0), cB, voffB); PG8_STAGE(PG8_SB(0, 1), cB + hstep, voffB); PG8_STAGE(PG8_SA(0, 0), cA, voffA); PG8_STAGE(PG8_SA(0, 1), cA + hstep, voffA);
        if (wr == 1) PG8_BAR;
        PG8_WAIT_V(2); PG8_BAR;
        PG8_STAGE(PG8_SB(1, 0), cB + kstep, voffB); PG8_STAGE(PG8_SA(1, 0), cA + kstep, voffA); PG8_STAGE(PG8_SB(1, 1), cB + hstep + kstep, voffB);
        PG8_WAIT_V(6); PG8_BAR;
    } else {
        PG8_STAGE(PG8_SB(0, 0), cB, voffB); PG8_STAGE(PG8_SA(0, 0), cA, voffA); PG8_STAGE(PG8_SB(0, 1), cB + hstep, voffB); PG8_STAGE(PG8_SA(0, 1), cA + hstep, voffA);
        if (wr == 1) PG8_BAR;
        PG8_WAIT_V(4); PG8_BAR;
        PG8_STAGE(PG8_SB(1, 0), cB + kstep, voffB); PG8_STAGE(PG8_SA(1, 0), cA + kstep, voffA); PG8_STAGE(PG8_SB(1, 1), cB + hstep + kstep, voffB);
        PG8_WAIT_V(6); PG8_BAR;
    }
    for (;;) {
        const bool has_next = S.next(ui + 1, nxt);
        const char* nA = has_next ? (const char*)g.A + (size_t)nxt.pm * tstep : cA; const char* nB = has_next ? (const char*)g.Bt + (size_t)nxt.pn * tstep : cB;
        for (int t = 0; t < nt; t += 2) {
            const bool last = (t == nt - 2);
            const char* a1 = cA + (size_t)(t + 1) * kstep;
            const char* a2 = last ? nA : cA + (size_t)(t + 2) * kstep; const char* b2 = last ? nB : cB + (size_t)(t + 2) * kstep;
            const char* a3 = a2 + kstep; const char* b3 = b2 + kstep;
            if (last && has_next) S.a_ready(nxt);
            if constexpr (SP2) {
            PG8_LDB(B0, 0, 0); PG8_LDB(B1, 0, 1); PG8_SCHED; PG8_LDA(At, 0, 0); PG8_STAGE(PG8_SA(1, 1), a1 + hstep, voffA);
            PG8_WAIT_V(8); PG8_WAIT_L(0); PG8_BAR; PG8_MMA(0, 0, At, B0); PG8_MMA(0, 1, At, B1); PG8_BAR; PG8_SCHED;
            PG8_LDA(At, 0, 1); PG8_STAGE(PG8_SB(0, 0), b2, voffB); PG8_STAGE(PG8_SB(0, 1), b2 + hstep, voffB); PG8_STAGE(PG8_SA(0, 0), a2, voffA);
            PG8_WAIT_V(8); PG8_WAIT_L(0); PG8_BAR; PG8_MMA(1, 0, At, B0); PG8_MMA(1, 1, At, B1); PG8_BAR; PG8_SCHED;
            PG8_LDB(B0, 1, 0); PG8_LDB(B1, 1, 1); PG8_SCHED; PG8_LDA(At, 1, 0); PG8_STAGE(PG8_SA(0, 1), a2 + hstep, voffA);
            PG8_WAIT_V(8); PG8_WAIT_L(0); PG8_BAR; PG8_MMA(0, 0, At, B0); PG8_MMA(0, 1, At, B1); PG8_BAR; PG8_SCHED;
            PG8_LDA(At, 1, 1); PG8_STAGE(PG8_SB(1, 0), b3, voffB); PG8_STAGE(PG8_SB(1, 1), b3 + hstep, voffB); PG8_STAGE(PG8_SA(1, 0), a3, voffA);
            PG8_WAIT_V(8); PG8_WAIT_L(0); PG8_BAR; PG8_MMA(1, 0, At, B0); PG8_MMA(1, 1, At, B1); PG8_BAR; PG8_SCHED;
            } else {
            PG8_LDB(B0, 0, 0); PG8_SCHED; PG8_LDA(At, 0, 0); PG8_STAGE(PG8_SA(1, 1), a1 + hstep, voffA);
            PG8_WAIT_L(8); PG8_BAR; PG8_WAIT_L(0); PG8_MMA(0, 0, At, B0); PG8_BAR; PG8_SCHED;
            PG8_LDB(B1, 0, 1); PG8_STAGE(PG8_SB(0, 0), b2, voffB);
            PG8_BAR; PG8_WAIT_L(0); PG8_MMA(0, 1, At, B1); PG8_BAR;
            PG8_LDA(At, 0, 1); PG8_STAGE(PG8_SA(0, 0), a2, voffA);
            PG8_BAR; PG8_WAIT_L(0); PG8_MMA(1, 0, At, B0); PG8_BAR; PG8_SCHED;
            PG8_STAGE(PG8_SB(0, 1), b2 + hstep, voffB);
            PG8_WAIT_V(6); PG8_BAR; PG8_MMA(1, 1, At, B1); PG8_BAR;
            PG8_LDB(B0, 1, 0); PG8_SCHED; PG8_LDA(At, 1, 0); PG8_STAGE(PG8_SA(0, 1), a2 + hstep, voffA);
            PG8_WAIT_L(8); PG8_BAR; PG8_WAIT_L(0); PG8_MMA(0, 0, At, B0); PG8_BAR; PG8_SCHED;
            PG8_LDB(B1, 1, 1); PG8_STAGE(PG8_SB(1, 0), b3, voffB);
            PG8_BAR; PG8_WAIT_L(0); PG8_MMA(0, 1, At, B1); PG8_BAR;
            PG8_LDA(At, 1, 1); PG8_STAGE(PG8_SA(1, 0), a3, voffA);
            PG8_BAR; PG8_WAIT_L(0); PG8_MMA(1, 0, At, B0); PG8_BAR; PG8_SCHED;
            PG8_STAGE(PG8_SB(1, 1), b3 + hstep, voffB);
            PG8_WAIT_V(6); PG8_BAR; PG8_MMA(1, 1, At, B1); PG8_BAR;
            }
        }
        if constexpr (ALIGN_EPI) { if (wr == 0) PG8_BAR; }
        if constexpr (!Epi::AFTER_DRAIN) { E(acc, cur, wr, wc, fr, fq); S.done(cur); }
        if (!has_next) break;
#pragma unroll
        for (int a = 0; a < 2; ++a)
#pragma unroll
            for (int b = 0; b < 2; ++b)
#pragma unroll
                for (int m = 0; m < 4; ++m)
#pragma unroll
                    for (int n = 0; n < 2; ++n) acc[a][b][m][n] = (f32x4){0.f, 0.f, 0.f, 0.f};
        cur = nxt; cA = nA; cB = nB; ++ui;
        if constexpr (ALIGN_EPI) { if (wr == 1) PG8_BAR; }
    }
    PG8_WAIT_V(0);
    if constexpr (!ALIGN_EPI) { if (wr == 0) PG8_BAR; }
    PG8_BAR;
    if constexpr (Epi::AFTER_DRAIN) { E.fused(acc, cur, wr, wc, fr, fq, lds, wid, lane); S.done(cur); }
#undef PG8_SA
#undef PG8_SB
#undef PG8_STAGE
#undef PG8_LDA
#undef PG8_LDB
#undef PG8_MMA
#undef PG8_WAIT_V
#undef PG8_WAIT_L
#undef PG8_BAR
#undef PG8_SCHED
}
}
constexpr int NWAVES = 8;
constexpr int N_LAUNCHES = MK_N_LAUNCHES;
constexpr int PER_PHASE = 11;
constexpr int SEQ = 2048, DM = 2048, DFF = 8192, NPROJ_IN = 11312, NPROJ_PAD = 11520;
constexpr float RMS_EPS = 1e-6f;
constexpr size_t MiB = 1u << 20;
constexpr size_t BLK = (size_t)MROWS * 256;
constexpr size_t WS_CTL = 0, CTL_ZERO_BYTES = 1 * MiB;
constexpr size_t WS_GATES = 1 * MiB, WS_WBM = 5 * MiB, WS_WBD = 9 * MiB, WS_WOUT = 13 * MiB, WS_PROJ = 21 * MiB, WS_WIN = 373 * MiB, WS_XN = 418 * MiB;
constexpr size_t WS_DQ = 373 * MiB, WS_DK = 405 * MiB, WS_DV = 437 * MiB;
constexpr size_t WS_HM = 117 * MiB, WS_ODF = 181 * MiB, WS_ODB = 469 * MiB;
constexpr size_t WS_YM = 21 * MiB, WS_YD = 53 * MiB, WS_MIX = 373 * MiB;
constexpr size_t WS_XN2 = 437 * MiB, WS_W1T = 21 * MiB, WS_W2T = 53 * MiB, WS_HFF = 117 * MiB, WS_END = 509 * MiB;
constexpr int CW_BAR = 4096;
constexpr int LDS_BYTES = 163840;
constexpr int MISC_OFF = LDS_BYTES - 256;

#define GAS __attribute__((address_space(1)))
#define LAS __attribute__((address_space(3)))
typedef unsigned short bf16;
typedef unsigned v4u __attribute__((ext_vector_type(4)));
typedef unsigned v2u __attribute__((ext_vector_type(2)));
typedef float f32x4 __attribute__((ext_vector_type(4)));
typedef short bf16x8 __attribute__((ext_vector_type(8)));
typedef GAS unsigned gu32;
#define RLX_AGENT __ATOMIC_RELAXED, __HIP_MEMORY_SCOPE_AGENT
#define LDS_WAIT() asm volatile("s_waitcnt lgkmcnt(0)" ::: "memory")
#define VM_WAIT() asm volatile("s_waitcnt vmcnt(0)" ::: "memory")
__device__ __forceinline__ unsigned f2bf(float f) { unsigned u = __builtin_bit_cast(unsigned, f); return (u + 0x7fffu + ((u >> 16) & 1u)) >> 16; }
__device__ __forceinline__ unsigned pk2(float lo, float hi) { return f2bf(lo) | (f2bf(hi) << 16); }
__device__ __forceinline__ float bflo(unsigned w) { return __uint_as_float(w << 16); }
__device__ __forceinline__ float bfhi(unsigned w) { return __uint_as_float(w & 0xffff0000u); }
__device__ __forceinline__ float bfel(const v4u& v, int i) { const unsigned w = v[i >> 1]; return (i & 1) ? bfhi(w) : bflo(w); }
#define MFMA16(a, b, c) __builtin_amdgcn_mfma_f32_16x16x32_bf16((a), (b), (c), 0, 0, 0)
__device__ __forceinline__ bf16x8 ldfrag(const LAS unsigned char* p) { return *(const LAS bf16x8*)p; }
__device__ __forceinline__ void st8(LAS unsigned char* p, const f32x4& v) { v2u w; w.x = pk2(v[0], v[1]); w.y = pk2(v[2], v[3]); *(LAS v2u*)p = w; }
#define XB_TMO      128
#define XB_XCNT(j)  (256  + 64 * (j))
#define XB_XSUB(j)  (1280 + 64 * (j))
#define XB_XGEN(j)  (2304 + 64 * (j))
#define XB_TOP      3328
#define XB_TOPGEN   3392
#define XCD_BAR_WORDS 3456
#define XB_SPIN_CAP (1u << 18)

__device__ __forceinline__ unsigned xb_ld(unsigned* p)              { return __hip_atomic_load(p, __ATOMIC_RELAXED, __HIP_MEMORY_SCOPE_AGENT); }
__device__ __forceinline__ unsigned xb_add(unsigned* p, unsigned v) { return __hip_atomic_fetch_add(p, v, __ATOMIC_RELAXED, __HIP_MEMORY_SCOPE_AGENT); }
__device__ __forceinline__ unsigned xb_xcc_id() { return (unsigned)__builtin_amdgcn_s_getreg((3 << 11) | 20) & 0xFu; }
#define XB_SPIN(cond, bar) do { unsigned _sp = 0; while (cond) { __builtin_amdgcn_s_sleep(1); \
    if ((++_sp & 255u) == 0u) { if (xb_ld(&(bar)[XB_TMO])) break; if (_sp > XB_SPIN_CAP) { atomicAdd(&(bar)[XB_TMO], 1u); break; } } } } while (0)

struct XcdBarrier {
    unsigned* bar; unsigned x;
    volatile LAS unsigned* st;
};

__device__ __forceinline__ XcdBarrier xcd_barrier_post(unsigned* bar, volatile LAS unsigned* st) {
    XcdBarrier b; b.bar = bar; b.x = xb_xcc_id(); b.st = st;
    if (threadIdx.x == 0) (void)xb_add(&bar[XB_XCNT(b.x)], 1u);
    return b;
}
__device__ __forceinline__ void xcd_barrier_complete(unsigned* bar, unsigned x, unsigned& nloc, unsigned& nx) {
    const unsigned G = gridDim.x * gridDim.y * gridDim.z;
    unsigned sum, cnt, mine, sp = 0u;
    for (;;) {
        sum = 0u; cnt = 0u; mine = 0u;
#pragma unroll
        for (unsigned j = 0; j < 16; ++j) { const unsigned c = xb_ld(&bar[XB_XCNT(j)]); sum += c; cnt += (c > 0u) ? 1u : 0u; mine = (j == x) ? c : mine; }
        if (sum == G) break;
        __builtin_amdgcn_s_sleep(1);
        if ((++sp & 255u) == 0u) { if (xb_ld(&bar[XB_TMO])) break; if (sp > XB_SPIN_CAP) { atomicAdd(&bar[XB_TMO], 1u); break; } }
    }
    nloc = mine > 0u ? mine : 1u; nx = cnt > 0u ? cnt : 1u;
}

__device__ __forceinline__ void xcd_barrier(const XcdBarrier& b) {
    asm volatile("s_waitcnt vmcnt(0)" ::: "memory");
    __syncthreads();
    if (threadIdx.x == 0) {
        unsigned* bar = b.bar;
        __builtin_amdgcn_s_waitcnt(0);
        unsigned nloc = b.st[0], nx = b.st[1];
        if (nloc == 0u) { xcd_barrier_complete(bar, b.x, nloc, nx); b.st[0] = nloc; b.st[1] = nx; }
        const unsigned old = xb_add(&bar[XB_XSUB(b.x)], 1u);
        const unsigned gen = old / nloc;
        if (old + 1u == (gen + 1u) * nloc) {
            __builtin_amdgcn_fence(__ATOMIC_RELEASE, "agent");
            asm volatile("s_waitcnt vmcnt(0)" ::: "memory");
            const unsigned og = xb_add(&bar[XB_TOP], 1u);
            const unsigned tg = og / nx;
            if (og + 1u == (tg + 1u) * nx) xb_add(&bar[XB_TOPGEN], 1u);
            else XB_SPIN(xb_ld(&bar[XB_TOPGEN]) == tg, bar);
            __builtin_amdgcn_fence(__ATOMIC_ACQUIRE, "agent");
            xb_add(&bar[XB_XGEN(b.x)], 1u);
            asm volatile("s_waitcnt vmcnt(0)" ::: "memory");
        } else {
            XB_SPIN(xb_ld(&bar[XB_XGEN(b.x)]) == gen, bar);
            __builtin_amdgcn_fence(__ATOMIC_ACQUIRE, "agent");
            asm volatile("s_waitcnt vmcnt(0)" ::: "memory");
        }
    }
    __syncthreads();
}
struct Frame {
    LAS unsigned char* lds;
    volatile LAS unsigned* MISC;
    gu32* ctl;
    int tid, lane, wave;
    int vcu, G;
    float* out;
    unsigned char* ws;
};
__device__ __forceinline__ float wave_sum(float v) {
#pragma unroll
    for (int o = 1; o < 64; o <<= 1) v += __shfl_xor(v, o);
    return v;
}
__device__ __forceinline__ int win_map(int n) {
    if (n < 3072) return n;
    if (n < 3088) return 11264 + (n - 3072);
    if (n < 7184) return n - 16;
    if (n < 7216) return 11264 + 16 + (n - 7184);
    return n - 48;
}
constexpr int TR_SCR = 64 * 65 * 4;
__device__ __forceinline__ void tr_item(const float* W, int K, int N, bf16* WT, LAS float* scr, int item, int lane, bool remap) {
    const int nblk = (N + 63) / 64, kb = item / nblk, nb = item % nblk, k0 = 64 * kb, n0 = 64 * nb;
    const int kr = lane >> 4, c4 = lane & 15, nn = n0 + 4 * c4; const bool okc = nn < N;
    f32x4 v[16];
#pragma unroll
    for (int i = 0; i < 16; ++i) v[i] = okc ? *(const f32x4*)(W + (size_t)(k0 + 4 * i + kr) * N + nn) : (f32x4){0.f, 0.f, 0.f, 0.f};
#pragma unroll
    for (int i = 0; i < 16; ++i) { LAS float* s = scr + (4 * i + kr) * 65 + 4 * c4; s[0] = v[i].x; s[1] = v[i].y; s[2] = v[i].z; s[3] = v[i].w; }
    LDS_WAIT(); asm volatile("" ::: "memory");
    const int j = lane >> 3, n8 = lane & 7;
#pragma unroll
    for (int p = 0; p < 8; ++p) { const int n = 8 * p + n8; const LAS float* s = scr + (8 * j) * 65 + n;
        v4u o; o.x = pk2(s[0 * 65], s[1 * 65]); o.y = pk2(s[2 * 65], s[3 * 65]); o.z = pk2(s[4 * 65], s[5 * 65]); o.w = pk2(s[6 * 65], s[7 * 65]);
        if (n0 + n < N) { const int row = remap ? win_map(n0 + n) : (n0 + n); *(v4u*)(WT + (size_t)row * K + k0 + 8 * j) = o; } }
    LDS_WAIT(); asm volatile("" ::: "memory");
}
__device__ __forceinline__ void rms_row_bf16(int lane, const float* xrow, const float* g, bf16* orow) {
    const f32x4* xr = (const f32x4*)xrow + lane; const f32x4* gr = (const f32x4*)g + lane;
    f32x4 v[8]; float s = 0.f;
#pragma unroll
    for (int j = 0; j < 8; ++j) { v[j] = xr[64 * j]; s += (v[j].x * v[j].x + v[j].y * v[j].y) + (v[j].z * v[j].z + v[j].w * v[j].w); }
    const float r = 1.0f / sqrtf(wave_sum(s) * (1.f / 2048.f) + RMS_EPS);
    v2u* o8 = (v2u*)orow + lane;
#pragma unroll
    for (int j = 0; j < 8; ++j) { const f32x4 gg = gr[64 * j]; v2u w; w.x = pk2(v[j].x * r * gg.x, v[j].y * r * gg.y); w.y = pk2(v[j].z * r * gg.z, v[j].w * r * gg.w); o8[64 * j] = w; }
}
__device__ __forceinline__ void rms_row_f32(int lane, const float* xrow, const float* g, float* orow) {
    const f32x4* xr = (const f32x4*)xrow + lane; const f32x4* gr = (const f32x4*)g + lane;
    f32x4 v[8]; float s = 0.f;
#pragma unroll
    for (int j = 0; j < 8; ++j) { v[j] = xr[64 * j]; s += (v[j].x * v[j].x + v[j].y * v[j].y) + (v[j].z * v[j].z + v[j].w * v[j].w); }
    const float r = 1.0f / sqrtf(wave_sum(s) * (1.f / 2048.f) + RMS_EPS);
    f32x4* o = (f32x4*)orow + lane;
#pragma unroll
    for (int j = 0; j < 8; ++j) { const f32x4 gg = gr[64 * j]; o[64 * j] = (v[j] * r) * gg; }
}

__device__ __forceinline__ void p0_prologue(Frame& F, const float* x, const float* n1g, const float* w_in, const float* w_bm, const float* w_bd, const float* w_out) {
    LAS float* scr = (LAS float*)(F.lds + F.wave * TR_SCR);
    const int gw = F.vcu * NWAVES + F.wave, NGW = F.G * NWAVES;
    bf16* WIN = (bf16*)(F.ws + WS_WIN); bf16* WBM = (bf16*)(F.ws + WS_WBM); bf16* WBD = (bf16*)(F.ws + WS_WBD); bf16* WOUT = (bf16*)(F.ws + WS_WOUT); bf16* XN = (bf16*)(F.ws + WS_XN);
    constexpr int I_IN = (DM / 64) * ((NPROJ_IN + 63) / 64), I_B = (1024 / 64) * (DM / 64), I_O = (DM / 64) * (DM / 64);
    constexpr int NITEMS = I_IN + 2 * I_B + I_O;
    for (int it = gw; it < NITEMS; it += NGW) {
        int r = it;
        if (r < I_IN) { tr_item(w_in, DM, NPROJ_IN, WIN, scr, r, F.lane, true); continue; } r -= I_IN;
        if (r < I_B) { tr_item(w_bm, 1024, DM, WBM, scr, r, F.lane, false); continue; } r -= I_B;
        if (r < I_B) { tr_item(w_bd, 1024, DM, WBD, scr, r, F.lane, false); continue; } r -= I_B;
        tr_item(w_out, DM, DM, WOUT, scr, r, F.lane, false);
    }
    { v4u* z = (v4u*)(WIN + (size_t)(11264 + 48) * DM); const int nz = (NPROJ_PAD - 11264 - 48) * DM / 8;
      for (int i = gw * 64 + F.lane; i < nz; i += NGW * 64) z[i] = (v4u){0u, 0u, 0u, 0u}; }
    for (int m = gw; m < MROWS; m += NGW) rms_row_bf16(F.lane, x + (size_t)m * DM, n1g, XN + (size_t)m * DM);
}

__device__ __forceinline__ void p2_conv(Frame& F, const float* convw) {
    const int gw = F.vcu * NWAVES + F.wave, NGW = F.G * NWAVES, lane = F.lane, c = lane & 15, r4 = lane >> 4;
    const bf16* PROJ = (const bf16*)(F.ws + WS_PROJ);
    bf16* DQ = (bf16*)(F.ws + WS_DQ); bf16* DK = (bf16*)(F.ws + WS_DK); bf16* DV = (bf16*)(F.ws + WS_DV);
    constexpr int NIT = 24 * (MROWS / 32);
    for (int it = gw; it < NIT; it += NGW) {
        const int gI = it % 24, tb32 = it / 24, m0 = tb32 * 32 + r4 * 8, b = m0 >> 11, t0 = m0 & 2047;
        const int c0 = gI * 128;
        const bf16* src = PROJ + (size_t)(12 + (c0 >> 8)) * BLK + (c0 & 255) + 8 * c;
        v4u xr[12];
#pragma unroll
        for (int i = 0; i < 12; ++i) { const int tp = t0 - 2 + i; xr[i] = (v4u){0u, 0u, 0u, 0u};
            if (tp >= 0 && tp < SEQ) xr[i] = *(const v4u*)(src + (size_t)(b * SEQ + tp) * 256); }
        f32x4 cwl[5], cwh[5];
#pragma unroll
        for (int i = 0; i < 5; ++i) { const float* cp = convw + (size_t)i * 3072 + c0 + 8 * c; cwl[i] = *(const f32x4*)cp; cwh[i] = *(const f32x4*)(cp + 4); }
        bf16* dst = (gI < 8 ? DQ : (gI < 16 ? DK : DV)) + (size_t)m0 * 1024 + (c0 & 1023) + 8 * c;
#pragma unroll
        for (int o = 0; o < 8; ++o) {
            float y[8];
#pragma unroll
            for (int e = 0; e < 8; ++e) y[e] = 0.f;
#pragma unroll
            for (int i = 0; i < 5; ++i) { const v4u xv = xr[o + i];
                y[0] += cwl[i][0] * bflo(xv.x); y[1] += cwl[i][1] * bfhi(xv.x); y[2] += cwl[i][2] * bflo(xv.y); y[3] += cwl[i][3] * bfhi(xv.y);
                y[4] += cwh[i][0] * bflo(xv.z); y[5] += cwh[i][1] * bfhi(xv.z); y[6] += cwh[i][2] * bflo(xv.w); y[7] += cwh[i][3] * bfhi(xv.w); }
            float ss = 0.f;
#pragma unroll
            for (int e = 0; e < 8; ++e) { y[e] = y[e] / (1.0f + __expf(-y[e])); ss += y[e] * y[e]; }
            if (gI < 16) { ss += __shfl_xor(ss, 1); ss += __shfl_xor(ss, 2); ss += __shfl_xor(ss, 4); ss += __shfl_xor(ss, 8);
                float r = 1.0f / sqrtf(ss + 1e-6f); if (gI < 8) r *= 0.08838834764831845f;
#pragma unroll
                for (int e = 0; e < 8; ++e) y[e] *= r; }
            v4u ov; ov.x = pk2(y[0], y[1]); ov.y = pk2(y[2], y[3]); ov.z = pk2(y[4], y[5]); ov.w = pk2(y[6], y[7]);
            *(v4u*)(dst + (size_t)o * 1024) = ov;
        }
    }
}

#define WG_BAR() do { asm volatile("s_waitcnt lgkmcnt(0)" ::: "memory"); __builtin_amdgcn_s_barrier(); asm volatile("" ::: "memory"); } while (0)
typedef short s16x4 __attribute__((ext_vector_type(4)));
__device__ __forceinline__ bf16x8 ldfrag_tr(const LAS unsigned char* p, int RS) {
    const s16x4 lo = __builtin_amdgcn_ds_read_tr16_b64_v4i16((LAS s16x4*)p);
    const s16x4 hi = __builtin_amdgcn_ds_read_tr16_b64_v4i16((LAS s16x4*)(p + 4 * RS));
    return __builtin_shufflevector(lo, hi, 0, 1, 2, 3, 4, 5, 6, 7);
}
__device__ __forceinline__ int trofs(int lane, int RS) { const int i = lane & 15, g = lane >> 4; return (8 * g + (i >> 2)) * RS + 8 * (i & 3); }
template <int CTRL, int ROWMASK> __device__ __forceinline__ float dppf(float old, float src) {
    return __builtin_bit_cast(float, __builtin_amdgcn_update_dpp(__builtin_bit_cast(int, old), __builtin_bit_cast(int, src), CTRL, ROWMASK, 0xf, false)); }
__device__ __forceinline__ float wave_incl_sum(float v) {
    v += dppf<0x111, 0xf>(0.f, v); v += dppf<0x112, 0xf>(0.f, v); v += dppf<0x114, 0xf>(0.f, v); v += dppf<0x118, 0xf>(0.f, v);
    v += dppf<0x142, 0xa>(0.f, v); v += dppf<0x143, 0xc>(0.f, v); return v; }
__device__ __forceinline__ float wave_incl_max(float v) {
    const float NI = -3.0e38f;
    v = fmaxf(v, dppf<0x111, 0xf>(NI, v)); v = fmaxf(v, dppf<0x112, 0xf>(NI, v)); v = fmaxf(v, dppf<0x114, 0xf>(NI, v)); v = fmaxf(v, dppf<0x118, 0xf>(NI, v));
    v = fmaxf(v, dppf<0x142, 0xa>(NI, v)); v = fmaxf(v, dppf<0x143, 0xc>(NI, v)); return v; }
__device__ __forceinline__ float lane63(float v) { return __builtin_bit_cast(float, __builtin_amdgcn_readlane(__builtin_bit_cast(int, v), 63)); }
__device__ __forceinline__ v4u scale8(const v4u& v, float s) { v4u o; o.x = pk2(bflo(v.x) * s, bfhi(v.x) * s); o.y = pk2(bflo(v.y) * s, bfhi(v.y) * s); o.z = pk2(bflo(v.z) * s, bfhi(v.z) * s); o.w = pk2(bflo(v.w) * s, bfhi(v.w) * s); return o; }

#ifdef PROBE_SEG
#define TP(k) do { if (PROBE_SEG == (k)) tp0 = __builtin_amdgcn_s_memtime(); if (PROBE_SEG + PROBE_LEN == (k)) tpacc += __builtin_amdgcn_s_memtime() - tp0; } while (0)
#define TP_DECL unsigned long long tp0 = 0, tpacc = 0;
#define TP_SPIN(isunit0) do { if ((isunit0) && tid == 0) { const unsigned long long t1 = __builtin_amdgcn_s_memtime(), dt = (PROBE_SEG == 99) ? 1000000ull * PROBE_AMP : tpacc * PROBE_AMP; while (__builtin_amdgcn_s_memtime() - t1 < dt) __builtin_amdgcn_s_sleep(8); } } while (0)
#else
#define TP(k) do {} while (0)
#define TP_DECL
#define TP_SPIN(x) do {} while (0)
#endif
constexpr int ML_QP = 0, ML_KS = 25600, ML_KW = 43008, ML_VX = 60416, ML_CT = 79872, ML_CT_BYTES = 39168, ML_VEC = 119040, ML_VECN = 336;
constexpr float ML_SCALE = 0.08838834764831845f;
__device__ __forceinline__ void mlstm_unit(Frame& F, int unit, const float* m_ib, const float* m_fb) {
    const int tid = F.tid, lane = F.lane, w = F.wave, fr = lane & 15, fq = lane >> 4;
    const int half = unit & 1, dir = (unit >> 1) & 1, h = (unit >> 2) & 3, b = unit >> 4;
    LAS unsigned char* L = F.lds;
    LAS float* vec = (LAS float*)(L + ML_VEC);
    const int tro272 = trofs(lane, 272), tro304 = trofs(lane, 304);
    for (int i = tid; i < ML_CT_BYTES / 16; i += 512) ((LAS v4u*)(L + ML_CT))[i] = (v4u){0u, 0u, 0u, 0u};
    if (tid < 64) { *(LAS v4u*)(L + ML_VX + tid * 304 + 256) = (v4u){0x00003f80u, 0u, 0u, 0u}; *(LAS v4u*)(L + ML_VX + tid * 304 + 272) = (v4u){0u, 0u, 0u, 0u}; }
    f32x4 accS[9];
#pragma unroll
    for (int t = 0; t < 9; ++t) accS[t] = (f32x4){0.f, 0.f, 0.f, 0.f};
    float m_st = -1e30f;
    const bf16* PROJ = (const bf16*)(F.ws + WS_PROJ);
    const float* GATES = (const float*)(F.ws + WS_GATES);
    const bf16* Qg = PROJ + (size_t)(h >> 1) * BLK + (h & 1) * 128;
    const bf16* Kg = PROJ + (size_t)(2 + (h >> 1)) * BLK + (h & 1) * 128;
    const bf16* Vg = PROJ + (size_t)(4 + h) * BLK + half * 128;
    bf16* Hout = (bf16*)(F.ws + WS_HM) + (size_t)dir * MROWS * 1024 + h * 256 + half * 128;
    const float ib = m_ib[dir * 4 + h], fb = m_fb[dir * 4 + h];
    const int sr = tid >> 4, sc = tid & 15;
    v4u q[2], k[2], v[2];
    float g_i = 0.f, g_f = 0.f;
#define ML_GATES(vb_, ig_raw, f_raw) do { \
        const float ig_ = (ig_raw) + ib, fp_ = (f_raw) + fb; \
        const float lf_ = fp_ >= 0.f ? -__logf(1.0f + __expf(-fp_)) : fp_ - __logf(1.0f + __expf(fp_)); \
        const float bc_ = wave_incl_sum(lf_), a_ = ig_ - bc_, am_ = wave_incl_max(a_); \
        const float Ml_ = fmaxf(m_st, am_), M63_ = lane63(Ml_), bl_ = lane63(bc_); \
        (vb_)[lane] = a_; (vb_)[64 + lane] = Ml_; (vb_)[128 + lane] = __expf(-(bc_ + Ml_)); (vb_)[192 + lane] = __expf(m_st - Ml_) * ML_SCALE; (vb_)[256 + lane] = __expf(a_ - M63_); \
        if (lane == 0) (vb_)[320] = __expf(m_st - M63_); \
        m_st = bl_ + M63_; } while (0)
#define ML_LOADQKV(jj) do { _Pragma("unroll") for (int p = 0; p < 2; ++p) { const int tt_ = (jj) * 64 + sr + 32 * p, t_ = dir ? (SEQ - 1 - tt_) : tt_; const size_t mr_ = (size_t)(b * SEQ + t_); \
        q[p] = *(const v4u*)(Qg + mr_ * 256 + sc * 8); k[p] = *(const v4u*)(Kg + mr_ * 256 + sc * 8); v[p] = *(const v4u*)(Vg + mr_ * 256 + sc * 8); } } while (0)
#define ML_LOADG(jj) do { const int tt_ = (jj) * 64 + lane, t_ = dir ? (SEQ - 1 - tt_) : tt_; const size_t mr_ = (size_t)(b * SEQ + t_); g_i = GATES[mr_ * 64 + dir * 4 + h]; g_f = GATES[mr_ * 64 + 8 + dir * 4 + h]; } while (0)
    ML_LOADQKV(0);
    if (w == 0) { ML_LOADG(0); ML_GATES(vec, g_i, g_f); ML_LOADG(1); }
    __syncthreads();
    TP_DECL
    for (int j = 0; j < 32; ++j) {
        TP(0);
        LAS float* vb = vec + (j & 1) * ML_VECN;
#pragma unroll
        for (int p = 0; p < 2; ++p) { const int r = sr + 32 * p; const float wsr = vb[256 + r];
            *(LAS v4u*)(L + ML_QP + r * 400 + 128 + sc * 16) = q[p]; *(LAS v4u*)(L + ML_KS + r * 272 + sc * 16) = k[p];
            *(LAS v4u*)(L + ML_KW + r * 272 + sc * 16) = scale8(k[p], wsr); *(LAS v4u*)(L + ML_VX + r * 304 + sc * 16) = v[p]; }
        if (j + 1 < 32) ML_LOADQKV(j + 1);
        if (w == 0 && j + 1 < 32) { LAS float* vn = vec + ((j + 1) & 1) * ML_VECN; ML_GATES(vn, g_i, g_f); if (j + 2 < 32) ML_LOADG(j + 2); }
        TP(1); WG_BAR(); TP(2);
        {
            const int lt = w & 3, l = lt * 16 + fr; const float Ml = vb[64 + l];
#pragma unroll
            for (int s2 = 0; s2 < 2; ++s2) { const int st = (w >> 2) * 2 + s2;
                f32x4 acc = (f32x4){0.f, 0.f, 0.f, 0.f};
                if (st <= lt) {
#pragma unroll
                    for (int ks = 0; ks < 4; ++ks) acc = MFMA16(ldfrag(L + ML_KS + (st * 16 + fr) * 272 + ks * 64 + fq * 16), ldfrag(L + ML_QP + l * 400 + 128 + ks * 64 + fq * 16), acc); }
                f32x4 pv;
#pragma unroll
                for (int r = 0; r < 4; ++r) { const int s = st * 16 + 4 * fq + r; pv[r] = (s <= l) ? acc[r] * ML_SCALE * __expf(fminf(vb[s] - Ml, 0.f)) : 0.f; }
                st8(L + ML_QP + l * 400 + (st * 16 + 4 * fq) * 2, pv); }
        }
        TP(3); WG_BAR(); TP(4);
        {
            const int lt = w & 3, dq = w >> 2, l = lt * 16 + fr;
            f32x4 aPV[5], aQC[5];
#pragma unroll
            for (int t = 0; t < 5; ++t) { aPV[t] = (f32x4){0.f, 0.f, 0.f, 0.f}; aQC[t] = (f32x4){0.f, 0.f, 0.f, 0.f}; }
            bf16x8 bq[6];
#pragma unroll
            for (int ks = 0; ks < 6; ++ks) bq[ks] = ldfrag(L + ML_QP + l * 400 + ks * 64 + fq * 16);
#pragma unroll
            for (int t = 0; t < 5; ++t) { const int tile = (t < 4) ? (dq * 4 + t) : 8;
#pragma unroll
                for (int ks = 0; ks < 2; ++ks) aPV[t] = MFMA16(ldfrag_tr(L + ML_VX + (ks * 32) * 304 + tile * 32 + tro304, 304), bq[ks], aPV[t]);
#pragma unroll
                for (int ks = 0; ks < 4; ++ks) aQC[t] = MFMA16(ldfrag(L + ML_CT + (tile * 16 + fr) * 272 + ks * 64 + fq * 16), bq[2 + ks], aQC[t]); }
            const float wi = vb[192 + l], eml = vb[128 + l];
            float den = aPV[4][0] + wi * aQC[4][0];
            den = __shfl(den, fr);
            const float inv = 1.0f / fmaxf(fabsf(den), eml);
            const int tt = j * 64 + l, t = dir ? (SEQ - 1 - tt) : tt; const size_t mrow = (size_t)(b * SEQ + t);
#pragma unroll
            for (int t4 = 0; t4 < 4; ++t4) { const f32x4 nv = (aPV[t4] + aQC[t4] * wi) * inv; v2u o; o.x = pk2(nv[0], nv[1]); o.y = pk2(nv[2], nv[3]);
                *(v2u*)(Hout + mrow * 1024 + (dq * 4 + t4) * 16 + 4 * fq) = o; }
        }
        TP(5);
        {
            const float decay = vb[320];
            bf16x8 ak[2];
#pragma unroll
            for (int ks = 0; ks < 2; ++ks) ak[ks] = ldfrag_tr(L + ML_KW + (ks * 32) * 272 + w * 32 + tro272, 272);
#pragma unroll
            for (int t = 0; t < 9; ++t) { accS[t] = accS[t] * decay;
#pragma unroll
                for (int ks = 0; ks < 2; ++ks) accS[t] = MFMA16(ak[ks], ldfrag_tr(L + ML_VX + (ks * 32) * 304 + t * 32 + tro304, 304), accS[t]); }
        }
        TP(6); WG_BAR(); TP(7);
#pragma unroll
        for (int t = 0; t < 9; ++t) st8(L + ML_CT + (t * 16 + fr) * 272 + (w * 16 + 4 * fq) * 2, accS[t]);
        TP(8);
    }
    TP_SPIN(unit == 0);
    __syncthreads();
#undef ML_GATES
#undef ML_LOADQKV
#undef ML_LOADG
}

constexpr int DN_ST = 0, DN_QS = 34816, DN_KS = 52224, DN_KD = 69632, DN_VS = 87040, DN_T1 = 104448, DN_T2 = 113664, DN_AT = 122880, DN_WL = 132096;
constexpr int DN_VN = DN_VS;
constexpr int DN_WREG = 19456;
constexpr int DN_VEC = 8 * DN_WREG, DN_VECN = 264;
constexpr size_t WS_TSCR = 501 * MiB;
__device__ __forceinline__ void delta_unit(Frame& F, int unit, const float* d_alog, const float* d_dtb) {
    const int tid = F.tid, lane = F.lane, w = F.wave, fr0 = lane & 15, fq0 = lane >> 4;
    const int dir = unit & 1, h = (unit >> 1) & 7, b = unit >> 4;
    LAS unsigned char* L = F.lds;
    LAS float* vec = (LAS float*)(L + DN_VEC);
    f32x4 accS[8];
#pragma unroll
    for (int t = 0; t < 8; ++t) accS[t] = (f32x4){0.f, 0.f, 0.f, 0.f};
    const float* Ga = (const float*)(F.ws + WS_GATES) + 16 + dir * 8 + h; const float* Gb = Ga + 16;
    const bf16* Qg = (const bf16*)(F.ws + WS_DQ) + h * 128; const bf16* Kg = (const bf16*)(F.ws + WS_DK) + h * 128; const bf16* Vg = (const bf16*)(F.ws + WS_DV) + h * 128;
    bf16* Oout = (bf16*)(F.ws + (dir ? WS_ODB : WS_ODF)) + h * 128;
    bf16* Tg = (bf16*)(F.ws + WS_TSCR) + (size_t)unit * (8 * 4096);
    const float Aexp = __expf(d_alog[dir * 8 + h]), dtb = d_dtb[dir * 8 + h];
    const int sr = tid >> 4, sc = tid & 15;
    v4u q[2], k[2], v[2], tT;
    float g_a = 0.f, g_b = 0.f;
#define DN_GB(a_raw, b_raw, gq_, beta_) const float ap_ = (a_raw) + dtb; const float sp_ = ap_ > 0.f ? ap_ + __logf(1.0f + __expf(-ap_)) : __logf(1.0f + __expf(ap_)); \
        const float gq_ = -Aexp * sp_, beta_ = 1.0f / (1.0f + __expf(-(b_raw)));
#define DN_GATES(vb_, a_raw, b_raw) do { DN_GB(a_raw, b_raw, gq__, beta__) const float gc_ = wave_incl_sum(gq__), gl_ = lane63(gc_); \
        (vb_)[lane] = gc_; (vb_)[64 + lane] = beta__; (vb_)[128 + lane] = __expf(gc_); (vb_)[192 + lane] = __expf(gl_ - gc_); if (lane == 0) (vb_)[256] = __expf(gl_); } while (0)
#define DN_LOADG(jj) do { const int tt_ = (jj) * 64 + lane, t_ = dir ? (SEQ - 1 - tt_) : tt_; const unsigned go_ = (unsigned)(b * SEQ + t_) * 256u; g_a = *(const float*)((const char*)Ga + go_); g_b = *(const float*)((const char*)Gb + go_); } while (0)
#define DN_LOADQKV(jj) do { _Pragma("unroll") for (int p = 0; p < 2; ++p) { const int tt_ = (jj) * 64 + sr + 32 * p, t_ = dir ? (SEQ - 1 - tt_) : tt_; const unsigned ro_ = (unsigned)(b * SEQ + t_) * 2048u + (unsigned)sc * 16u; \
        q[p] = *(const v4u*)((const char*)Qg + ro_); k[p] = *(const v4u*)((const char*)Kg + ro_); v[p] = *(const v4u*)((const char*)Vg + ro_); } \
        tT = __builtin_nontemporal_load((const v4u*)((const char*)Tg + (unsigned)(((jj) & 7) * 8192 + tid * 16))); } while (0)
    if (w == 0) { DN_LOADG(0); DN_GATES(vec, g_a, g_b); DN_LOADG(1); }
    TP_DECL
    for (int grp = 0; grp < 4; ++grp) {
        TP(20);
        int fr = fr0, fq = fq0; asm volatile("" : "+v"(fr), "+v"(fq));
        __syncthreads();
        {
            const int c = grp * 8 + w; const int tro144 = trofs(fq * 16 + fr, 144);
            LAS unsigned char* PA = L + w * DN_WREG; LAS unsigned char* XA = PA + 9216; LAS float* gv = (LAS float*)(PA + 18432);
            { const int tt = c * 64 + lane, t = dir ? (SEQ - 1 - tt) : tt; const unsigned go = (unsigned)(b * SEQ + t) * 256u;
              const float ar = *(const float*)((const char*)Ga + go), brw = *(const float*)((const char*)Gb + go);
              DN_GB(ar, brw, gq, beta) gv[lane] = wave_incl_sum(gq); gv[64 + lane] = beta; }
            f32x4 accX[4][4];
#pragma unroll
            for (int tb = 0; tb < 4; ++tb)
#pragma unroll
                for (int ta = 0; ta < 4; ++ta) accX[ta][tb] = (f32x4){0.f, 0.f, 0.f, 0.f};
#pragma unroll
            for (int kh = 0; kh < 2; ++kh) {
                bf16x8 kf[4][2];
#pragma unroll
                for (int t4 = 0; t4 < 4; ++t4) { const int tt = c * 64 + t4 * 16 + fr, t = dir ? (SEQ - 1 - tt) : tt; const unsigned ro = (unsigned)(b * SEQ + t) * 2048u + (unsigned)fq * 16u;
#pragma unroll
                    for (int ks = 0; ks < 2; ++ks) kf[t4][ks] = *(const bf16x8*)((const char*)Kg + ro + (kh * 2 + ks) * 64); }
#pragma unroll
                for (int tb = 0; tb < 4; ++tb)
#pragma unroll
                    for (int ta = 0; ta < 4; ++ta) if (ta <= tb) {
#pragma unroll
                        for (int ks = 0; ks < 2; ++ks) accX[ta][tb] = MFMA16(kf[ta][ks], kf[tb][ks], accX[ta][tb]); }
            }
#pragma unroll
            for (int tb = 0; tb < 4; ++tb)
#pragma unroll
                for (int ta = 0; ta < 4; ++ta) {
                    const int bI = tb * 16 + fr, a0 = ta * 16 + 4 * fq;
                    if (ta <= tb) {
                        const f32x4 acc = accX[ta][tb];
                        const float gcb = gv[bI], betab = gv[64 + bI];
                        f32x4 vna, vxa;
#pragma unroll
                        for (int r = 0; r < 4; ++r) { const int aI = a0 + r; const float e = -betab * acc[r] * __expf(fminf(gcb - gv[aI], 0.f));
                            if (ta == tb) { const int dd = (4 * fq + r) - fr; vna[r] = dd < 0 ? e : 0.f; vxa[r] = dd < 0 ? e : (dd == 0 ? 1.0f : 0.f); }
                            else { vna[r] = e; vxa[r] = e; } }
                        accX[ta][tb] = vxa;
                        st8(PA + bI * 144 + a0 * 2, vna); st8(XA + bI * 144 + a0 * 2, vxa);
                    } else { const f32x4 z = (f32x4){0.f, 0.f, 0.f, 0.f}; st8(PA + bI * 144 + a0 * 2, z); st8(XA + bI * 144 + a0 * 2, z); }
                }
#pragma unroll 1
            for (int kk = 1; kk <= 6; ++kk) {
                f32x4 accP[4][4];
                bf16x8 fA[4][2];
#pragma unroll
                for (int ta = 0; ta < 4; ++ta)
#pragma unroll
                    for (int ks = 0; ks < 2; ++ks) if (ks >= (ta >> 1)) fA[ta][ks] = ldfrag_tr(PA + (ks * 32) * 144 + ta * 32 + tro144, 144);
#pragma unroll
                for (int tb = 0; tb < 4; ++tb) {
                    bf16x8 pb[2], xb[2];
#pragma unroll
                    for (int ks = 0; ks < 2; ++ks) if (ks <= (tb >> 1)) { pb[ks] = ldfrag(PA + (tb * 16 + fr) * 144 + ks * 64 + fq * 16); xb[ks] = ldfrag(XA + (tb * 16 + fr) * 144 + ks * 64 + fq * 16); }
#pragma unroll
                    for (int ta = 0; ta < 4; ++ta) if (ta <= tb) {
                        accP[ta][tb] = (f32x4){0.f, 0.f, 0.f, 0.f};
#pragma unroll
                        for (int ks = 0; ks < 2; ++ks) if (ks >= (ta >> 1) && ks <= (tb >> 1)) {
                            if (kk <= 5) accP[ta][tb] = MFMA16(fA[ta][ks], pb[ks], accP[ta][tb]);
                            if (kk >= 2) accX[ta][tb] = MFMA16(fA[ta][ks], xb[ks], accX[ta][tb]); } }
                }
#pragma unroll
                for (int tb = 0; tb < 4; ++tb)
#pragma unroll
                    for (int ta = 0; ta < 4; ++ta) if (ta <= tb) { const int off = (tb * 16 + fr) * 144 + (ta * 16 + 4 * fq) * 2;
                        if (kk <= 5) st8(PA + off, accP[ta][tb]);
                        if (kk >= 2) st8(XA + off, accX[ta][tb]); }
            }
            bf16* Tc = Tg + (size_t)w * 4096;
#pragma unroll
            for (int tb = 0; tb < 4; ++tb)
#pragma unroll
                for (int ta = 0; ta < 4; ++ta) { v2u o; if (ta <= tb) { o.x = pk2(accX[ta][tb][0], accX[ta][tb][1]); o.y = pk2(accX[ta][tb][2], accX[ta][tb][3]); } else { o.x = 0u; o.y = 0u; }
                    *(v2u*)((char*)Tc + (unsigned)(((tb * 16 + fr) * 64 + ta * 16 + 4 * fq) * 2)) = o; }
        }
        __syncthreads();
#pragma unroll
        for (int t8 = 0; t8 < 8; ++t8) st8(L + DN_ST + (t8 * 16 + fr) * 272 + (w * 16 + 4 * fq) * 2, accS[t8]);
        DN_LOADQKV(grp * 8);
        TP(21);
        for (int jc = 0; jc < 8; ++jc) {
            TP(22);
            const int j = grp * 8 + jc; asm volatile("" : "+v"(fr), "+v"(fq)); const int tro272 = trofs(fq * 16 + fr, 272);
            LAS float* vb = vec + (j & 1) * DN_VECN;
#pragma unroll
            for (int p = 0; p < 2; ++p) { const int r = sr + 32 * p; const float kds = vb[192 + r];
                *(LAS v4u*)(L + DN_QS + r * 272 + sc * 16) = q[p]; *(LAS v4u*)(L + DN_KS + r * 272 + sc * 16) = k[p];
                *(LAS v4u*)(L + DN_KD + r * 272 + sc * 16) = scale8(k[p], kds); *(LAS v4u*)(L + DN_VS + r * 272 + sc * 16) = v[p]; }
            {
                const int tr = tid >> 3, c0 = (tid & 7) * 8; v4u t1, t2;
#pragma unroll
                for (int i = 0; i < 4; ++i) { const float b0 = vb[64 + c0 + 2 * i], b1 = vb[64 + c0 + 2 * i + 1], e0 = vb[128 + c0 + 2 * i], e1 = vb[128 + c0 + 2 * i + 1];
                    const float x0 = bflo(tT[i]) * b0, x1 = bfhi(tT[i]) * b1; t1[i] = pk2(x0, x1); t2[i] = pk2(x0 * e0, x1 * e1); }
                *(LAS v4u*)(L + DN_T1 + tr * 144 + c0 * 2) = t1; *(LAS v4u*)(L + DN_T2 + tr * 144 + c0 * 2) = t2; }
            if (jc + 1 < 8) DN_LOADQKV(j + 1);
            if (w == 0 && j + 1 < 32) { LAS float* vn = vec + ((j + 1) & 1) * DN_VECN; DN_GATES(vn, g_a, g_b); if (j + 2 < 32) DN_LOADG(j + 2); }
            TP(23); WG_BAR(); TP(24);
            f32x4 accU[4];
            {
                const int tb = w & 3, bI = tb * 16 + fr; const float gcb = vb[bI];
#pragma unroll
                for (int x = 0; x < 2; ++x) { const int ta = (w >> 2) * 2 + x, a0 = ta * 16 + 4 * fq;
                    f32x4 acc = (f32x4){0.f, 0.f, 0.f, 0.f};
                    if (ta <= tb) {
#pragma unroll
                        for (int ks = 0; ks < 4; ++ks) acc = MFMA16(ldfrag(L + DN_KS + (ta * 16 + fr) * 272 + ks * 64 + fq * 16), ldfrag(L + DN_QS + bI * 272 + ks * 64 + fq * 16), acc); }
                    f32x4 vat;
#pragma unroll
                    for (int r = 0; r < 4; ++r) { const int aI = a0 + r; const float e = acc[r] * __expf(fminf(gcb - vb[aI], 0.f)); vat[r] = (ta < tb || (ta == tb && 4 * fq + r <= fr)) ? e : 0.f; }
                    st8(L + DN_AT + bI * 144 + a0 * 2, vat); }
                f32x4 accW[4];
#pragma unroll
                for (int lt = 0; lt < 4; ++lt) { accU[lt] = (f32x4){0.f, 0.f, 0.f, 0.f}; accW[lt] = (f32x4){0.f, 0.f, 0.f, 0.f}; }
#pragma unroll
                for (int ks = 0; ks < 2; ++ks) {
                    const bf16x8 vtr = ldfrag_tr(L + DN_VS + (ks * 32) * 272 + w * 32 + tro272, 272), ktr = ldfrag_tr(L + DN_KS + (ks * 32) * 272 + w * 32 + tro272, 272);
#pragma unroll
                    for (int lt = 0; lt < 4; ++lt) if (ks <= (lt >> 1)) {
                        accU[lt] = MFMA16(ldfrag(L + DN_T1 + (lt * 16 + fr) * 144 + ks * 64 + fq * 16), vtr, accU[lt]);
                        accW[lt] = MFMA16(ktr, ldfrag(L + DN_T2 + (lt * 16 + fr) * 144 + ks * 64 + fq * 16), accW[lt]); } }
#pragma unroll
                for (int lt = 0; lt < 4; ++lt) { const f32x4 nw = -accW[lt]; st8(L + DN_WL + (lt * 16 + fr) * 272 + (w * 16 + 4 * fq) * 2, nw); }
            }
            TP(25); WG_BAR(); TP(26);
            {
#pragma unroll
                for (int ks = 0; ks < 4; ++ks) { const int ko = ks * 64 + fq * 16;
                    const bf16x8 sb = ldfrag(L + DN_ST + (w * 16 + fr) * 272 + ko);
#pragma unroll
                    for (int lt = 0; lt < 4; ++lt) accU[lt] = MFMA16(ldfrag(L + DN_WL + (lt * 16 + fr) * 272 + ko), sb, accU[lt]); }
#pragma unroll
                for (int lt = 0; lt < 4; ++lt) st8(L + DN_VN + (w * 16 + fr) * 144 + (lt * 16 + 4 * fq) * 2, accU[lt]);
            }
            TP(27); WG_BAR(); TP(28);
            {
                const int lt = w & 3, dq = w >> 2, l = lt * 16 + fr;
                f32x4 aOA[4], aOQ[4];
#pragma unroll
                for (int t = 0; t < 4; ++t) { aOA[t] = (f32x4){0.f, 0.f, 0.f, 0.f}; aOQ[t] = (f32x4){0.f, 0.f, 0.f, 0.f}; }
#pragma unroll
                for (int ks = 0; ks < 2; ++ks) { const int ko = ks * 64 + fq * 16; const bf16x8 ab = ldfrag(L + DN_AT + l * 144 + ko);
#pragma unroll
                    for (int t = 0; t < 4; ++t) aOA[t] = MFMA16(ldfrag(L + DN_VN + ((dq * 4 + t) * 16 + fr) * 144 + ko), ab, aOA[t]); }
#pragma unroll
                for (int ks = 0; ks < 4; ++ks) { const int ko = ks * 64 + fq * 16; const bf16x8 qb = ldfrag(L + DN_QS + l * 272 + ko);
#pragma unroll
                    for (int t = 0; t < 4; ++t) aOQ[t] = MFMA16(ldfrag(L + DN_ST + ((dq * 4 + t) * 16 + fr) * 272 + ko), qb, aOQ[t]); }
                const float egl_l = vb[128 + l];
                const int tt = j * 64 + l, t = dir ? (SEQ - 1 - tt) : tt; const unsigned oo = (unsigned)(b * SEQ + t) * 2048u + (unsigned)(dq * 64 + 4 * fq) * 2u;
#pragma unroll
                for (int t4 = 0; t4 < 4; ++t4) { const f32x4 ov = aOA[t4] + aOQ[t4] * egl_l; v2u o; o.x = pk2(ov[0], ov[1]); o.y = pk2(ov[2], ov[3]);
                    *(v2u*)((char*)Oout + oo + t4 * 32) = o; }
                const float egl = vb[256];
                bf16x8 ak[2];
#pragma unroll
                for (int ks = 0; ks < 2; ++ks) ak[ks] = ldfrag_tr(L + DN_KD + (ks * 32) * 272 + w * 32 + tro272, 272);
#pragma unroll
                for (int t8 = 0; t8 < 8; ++t8) { accS[t8] = accS[t8] * egl;
#pragma unroll
                    for (int ks = 0; ks < 2; ++ks) accS[t8] = MFMA16(ak[ks], ldfrag(L + DN_VN + (t8 * 16 + fr) * 144 + ks * 64 + fq * 16), accS[t8]); }
            }
            TP(29); WG_BAR();
#pragma unroll
            for (int t8 = 0; t8 < 8; ++t8) st8(L + DN_ST + (t8 * 16 + fr) * 272 + (w * 16 + 4 * fq) * 2, accS[t8]);
            TP(30);
        }
    }
    TP_SPIN(unit == 0);
    __syncthreads();
#undef DN_GB
#undef DN_GATES
#undef DN_LOADG
#undef DN_LOADQKV
}

__device__ __forceinline__ void p4_combine(Frame& F, const float* m_ng, const float* d_ng) {
    const int gw = F.vcu * NWAVES + F.wave, NGW = F.G * NWAVES, lane = F.lane;
    const bf16* PROJ = (const bf16*)(F.ws + WS_PROJ);
    const bf16* HMf = (const bf16*)(F.ws + WS_HM); const bf16* HMb = HMf + (size_t)MROWS * 1024;
    const bf16* ODf = (const bf16*)(F.ws + WS_ODF); const bf16* ODb = (const bf16*)(F.ws + WS_ODB);
    bf16* YM = (bf16*)(F.ws + WS_YM); bf16* YD = (bf16*)(F.ws + WS_YD);
    for (int m = gw; m < MROWS; m += NGW) {
        v2u hf[4], hb[4], mo[4]; unsigned of[8], ob[8], dz[8];
#pragma unroll
        for (int h = 0; h < 4; ++h) { hf[h] = *(const v2u*)(HMf + (size_t)m * 1024 + h * 256 + 4 * lane); hb[h] = *(const v2u*)(HMb + (size_t)m * 1024 + h * 256 + 4 * lane);
            mo[h] = *(const v2u*)(PROJ + (size_t)(8 + h) * BLK + (size_t)m * 256 + 4 * lane); }
#pragma unroll
        for (int h = 0; h < 8; ++h) { of[h] = *(const unsigned*)(ODf + (size_t)m * 1024 + h * 128 + 2 * lane); ob[h] = *(const unsigned*)(ODb + (size_t)m * 1024 + h * 128 + 2 * lane);
            dz[h] = *(const unsigned*)(PROJ + (size_t)(24 + (h >> 1)) * BLK + (size_t)m * 256 + (h & 1) * 128 + 2 * lane); }
#pragma unroll
        for (int h = 0; h < 4; ++h) {
            const float a0 = bflo(hf[h].x) + bflo(hb[h].x), a1 = bfhi(hf[h].x) + bfhi(hb[h].x), a2 = bflo(hf[h].y) + bflo(hb[h].y), a3 = bfhi(hf[h].y) + bfhi(hb[h].y);
            const float ss = wave_sum((a0 * a0 + a1 * a1) + (a2 * a2 + a3 * a3));
            const float r = 1.0f / sqrtf(ss * (1.f / 256.f) + RMS_EPS);
            const f32x4 g = *(const f32x4*)(m_ng + h * 256 + 4 * lane);
            const float o0 = bflo(mo[h].x), o1 = bfhi(mo[h].x), o2 = bflo(mo[h].y), o3 = bfhi(mo[h].y);
            v2u y; y.x = pk2(a0 * r * g.x / (1.f + expf(-o0)), a1 * r * g.y / (1.f + expf(-o1))); y.y = pk2(a2 * r * g.z / (1.f + expf(-o2)), a3 * r * g.w / (1.f + expf(-o3)));
            *(v2u*)(YM + (size_t)m * 1024 + h * 256 + 4 * lane) = y;
        }
        const float g0 = d_ng[2 * lane], g1 = d_ng[2 * lane + 1];
#pragma unroll
        for (int h = 0; h < 8; ++h) {
            const float a0 = bflo(of[h]) + bflo(ob[h]), a1 = bfhi(of[h]) + bfhi(ob[h]);
            const float ss = wave_sum(a0 * a0 + a1 * a1);
            const float r = 1.0f / sqrtf(ss * (1.f / 128.f) + RMS_EPS);
            const float z0 = bflo(dz[h]), z1 = bfhi(dz[h]);
            *(unsigned*)(YD + (size_t)m * 1024 + h * 128 + 2 * lane) = pk2(a0 * r * g0 * z0 / (1.f + expf(-z0)), a1 * r * g1 * z1 / (1.f + expf(-z1)));
        }
    }
}

__device__ __forceinline__ void p7_norm2(Frame& F, const float* n2g, const float* w_ff1, const float* w_ff2) {
    LAS float* scr = (LAS float*)(F.lds + F.wave * TR_SCR);
    const int gw = F.vcu * NWAVES + F.wave, NGW = F.G * NWAVES;
    bf16* W1T = (bf16*)(F.ws + WS_W1T); bf16* W2T = (bf16*)(F.ws + WS_W2T); bf16* XN2 = (bf16*)(F.ws + WS_XN2);
    constexpr int I_1 = (DM / 64) * (DFF / 64), I_2 = (DFF / 64) * (DM / 64);
    for (int it = gw; it < I_1 + I_2; it += NGW) {
        if (it < I_1) tr_item(w_ff1, DM, DFF, W1T, scr, it, F.lane, false); else tr_item(w_ff2, DFF, DM, W2T, scr, it - I_1, F.lane, false);
    }
    for (int m = gw; m < MROWS; m += NGW) rms_row_bf16(F.lane, F.out + (size_t)m * DM, n2g, XN2 + (size_t)m * DM);
}
__device__ __forceinline__ void p10_final(Frame& F, const float* nfg) {
    const int gw = F.vcu * NWAVES + F.wave, NGW = F.G * NWAVES;
    for (int m = gw; m < MROWS; m += NGW) rms_row_f32(F.lane, F.out + (size_t)m * DM, nfg, F.out + (size_t)m * DM);
}
struct Args { const float* in[17]; float* out; unsigned char* ws; int ph_lo, ph_hi, li, pad; };
__global__ void __launch_bounds__(NWAVES * 64, 2) hybrid_fwd(Args args) {
    extern __shared__ __attribute__((aligned(16))) unsigned char lds[];
    Frame F;
    F.lds = (LAS unsigned char*)lds;
    F.MISC = (volatile LAS unsigned*)(F.lds + MISC_OFF);
    F.tid = threadIdx.x; F.lane = F.tid & 63; F.wave = __builtin_amdgcn_readfirstlane(F.tid >> 6);
    F.G = gridDim.x; { const int bx = blockIdx.x; F.vcu = (F.G % 8 == 0) ? (bx % 8) * (F.G / 8) + bx / 8 : bx; }
    F.ws = args.ws; F.ctl = (gu32*)(args.ws + WS_CTL);
    F.out = args.out;
    if (F.tid < 64) ((LAS unsigned*)(F.lds + MISC_OFF))[F.tid] = 0u;
    __syncthreads();
    XcdBarrier bar; bar.bar = (unsigned*)(F.ctl + CW_BAR); bar.x = 0; bar.st = nullptr;
    if (N_LAUNCHES != PER_PHASE) bar = xcd_barrier_post((unsigned*)(F.ctl + CW_BAR), F.MISC + 8);
#define GRID_BAR() do { if (N_LAUNCHES != PER_PHASE) xcd_barrier(bar); } while (0)
    const int lo = args.ph_lo, hi = args.ph_hi;
#ifndef PHASE_MASK
#define PHASE_MASK 0x7ff
#endif
#define IN(k) (((PHASE_MASK >> (k)) & 1) && lo <= (k) && (k) < hi)
#define BOTH(k) (IN(k) && IN((k) + 1))
    bf16* PROJ = (bf16*)(F.ws + WS_PROJ);

    if (IN(0)) { p0_prologue(F, args.in[0], args.in[1], args.in[2], args.in[10], args.in[11], args.in[12]); if (BOTH(0)) GRID_BAR(); }
    if (IN(1)) {
        pg8::Gemm g{(const bf16*)(F.ws + WS_XN), (const bf16*)(F.ws + WS_WIN), MROWS, NPROJ_PAD, DM}; pg8::StaticOrder S; S.init(MROWS, NPROJ_PAD, F.G, (int)blockIdx.x);
        pg8::EpiProj E{PROJ, (float*)(F.ws + WS_GATES)};
        pg8::gemm_phase<pg8::EpiProj, pg8::StaticOrder, true, true>(F.lds, g, S, E);
        if (BOTH(1)) GRID_BAR();
    }
    if (IN(2)) { p2_conv(F, args.in[6]); if (BOTH(2)) GRID_BAR(); }
    if (IN(3)) {
        const int u = F.vcu;
        if (u < 128) { if (args.pad != 2) mlstm_unit(F, u, args.in[3], args.in[4]); }
        else if (u < 256) { if (args.pad != 1) delta_unit(F, u - 128, args.in[7], args.in[8]); }
        if (BOTH(3)) GRID_BAR();
    }
    if (IN(4)) { p4_combine(F, args.in[5], args.in[9]); if (BOTH(4)) GRID_BAR(); }
    if (IN(5)) {
        pg8::Gemm g{(const bf16*)(F.ws + WS_YM), (const bf16*)(F.ws + WS_WBM), 2 * MROWS, 4096, 1024}; pg8::BranchOrder S; S.init(F.G, (int)blockIdx.x);
        pg8::EpiBranch E{PROJ, (bf16*)(F.ws + WS_MIX)};
        pg8::gemm_phase<pg8::EpiBranch, pg8::BranchOrder, true, true>(F.lds, g, S, E);
        if (BOTH(5)) GRID_BAR();
    }
    if (IN(6)) {
        pg8::Gemm g{(const bf16*)(F.ws + WS_MIX), (const bf16*)(F.ws + WS_WOUT), MROWS, DM, DM}; pg8::StaticOrder S; S.init(MROWS, DM, F.G, (int)blockIdx.x);
        pg8::EpiResid E{args.in[0], F.out, DM};
        pg8::gemm_phase<pg8::EpiResid, pg8::StaticOrder, true, true>(F.lds, g, S, E);
        if (BOTH(6)) GRID_BAR();
    }
    if (IN(7)) { p7_norm2(F, args.in[13], args.in[14], args.in[15]); if (BOTH(7)) GRID_BAR(); }
    if (IN(8)) {
        pg8::Gemm g{(const bf16*)(F.ws + WS_XN2), (const bf16*)(F.ws + WS_W1T), MROWS, DFF, DM}; pg8::StaticOrder S; S.init(MROWS, DFF, F.G, (int)blockIdx.x);
        pg8::EpiRelu2 E{(bf16*)(F.ws + WS_HFF), DFF};
        pg8::gemm_phase<pg8::EpiRelu2, pg8::StaticOrder, true, true>(F.lds, g, S, E);
        if (BOTH(8)) GRID_BAR();
    }
    if (IN(9)) {
        pg8::Gemm g{(const bf16*)(F.ws + WS_HFF), (const bf16*)(F.ws + WS_W2T), MROWS, DM, DFF}; pg8::StaticOrder S; S.init(MROWS, DM, F.G, (int)blockIdx.x);
        pg8::EpiResid E{F.out, F.out, DM};
        pg8::gemm_phase<pg8::EpiResid, pg8::StaticOrder, true, true>(F.lds, g, S, E);
        if (BOTH(9)) GRID_BAR();
    }
    if (IN(10)) { p10_final(F, args.in[16]); }
#undef IN
#undef BOTH
}

extern "C" void kernel_launch(void* const* d_in, const int* in_sizes, int n_in, void* d_out, int out_size, void* d_ws, size_t ws_size, hipStream_t stream) {
    static int grid = 0;
    if (grid == 0) {
        if (n_in != 17 || in_sizes[0] != MROWS * DM || out_size != MROWS * DM || ws_size < WS_END) {
            fprintf(stderr, "kernel_launch: unexpected problem: n_in %d, in0 %d, out %d, ws %zu (need %zu); nothing launched\n", n_in, n_in > 0 ? in_sizes[0] : -1, out_size, ws_size, (size_t)WS_END); grid = -1; return; }
        int dev = 0, cus = 0, per_cu = 0;
        if (hipGetDevice(&dev) != hipSuccess || hipDeviceGetAttribute(&cus, hipDeviceAttributeMultiprocessorCount, dev) != hipSuccess) { fprintf(stderr, "kernel_launch: device query failed\n"); grid = -1; return; }
        if (hipFuncSetAttribute((const void*)hybrid_fwd, hipFuncAttributeMaxDynamicSharedMemorySize, LDS_BYTES) != hipSuccess) { fprintf(stderr, "kernel_launch: hipFuncSetAttribute failed\n"); grid = -1; return; }
        if (hipOccupancyMaxActiveBlocksPerMultiprocessor(&per_cu, (const void*)hybrid_fwd, NWAVES * 64, LDS_BYTES) != hipSuccess || per_cu < 1)
            fprintf(stderr, "kernel_launch: note: occupancy query reports %d workgroups per CU\n", per_cu);
        (void)hipGetLastError();
        grid = cus;
    }
    if (grid < 0) return;
    if (hipMemsetAsync((char*)d_ws + WS_CTL, 0, CTL_ZERO_BYTES, stream) != hipSuccess) { fprintf(stderr, "kernel_launch: memset failed\n"); return; }
    Args a{};
    for (int i = 0; i < 17; ++i) a.in[i] = (const float*)d_in[i];
    a.out = (float*)d_out; a.ws = (unsigned char*)d_ws;
#ifdef PROBE_PH
    const int nl = 2; const int plo[2] = {0, PROBE_PH}, phi[2] = {PROBE_PH + 1, PER_PHASE};
#else
    const int nl = N_LAUNCHES; const int plo[2] = {0, 0}, phi[2] = {PER_PHASE, PER_PHASE};
#endif
    for (int li = 0; li < nl; ++li) {
        if (li > 0 && N_LAUNCHES != PER_PHASE) (void)hipMemsetAsync((char*)d_ws + WS_CTL, 0, CTL_ZERO_BYTES, stream);
#ifdef PROBE_SKIP
        a.pad = (li == 1) ? PROBE_SKIP : 0;
#endif
        a.ph_lo = (N_LAUNCHES == PER_PHASE) ? li : plo[li & 1]; a.ph_hi = (N_LAUNCHES == PER_PHASE) ? li + 1 : phi[li & 1]; a.li = li;
        hipLaunchKernelGGL(hybrid_fwd, dim3(grid), dim3(NWAVES * 64), LDS_BYTES, stream, a);
        const hipError_t le = hipPeekAtLastError();
        if (le != hipSuccess) { fprintf(stderr, "kernel_launch: launch %d failed: %s\n", li, hipGetErrorName(le)); break; }
    }
}
```

```cpp
#include <hip/hip_runtime.h>
#include <cstdio>
#include <cstdint>

#ifndef MK_N_LAUNCHES
#define MK_N_LAUNCHES 1
#endif
constexpr int MROWS = 16384;
namespace pg8 {
#define PG8_LAS __attribute__((address_space(3)))
typedef unsigned short bf16_t;
typedef short bf16x8 __attribute__((ext_vector_type(8)));
typedef float f32x4 __attribute__((ext_vector_type(4)));
typedef unsigned u32x4 __attribute__((ext_vector_type(4)));
constexpr int BM = 256, BK = 64, HALF = 128, HTB = HALF * BK * 2  , STAGE_BYTES = 8 * HTB, NXCD = 8, WGM = 8;

__host__ __device__ __forceinline__ int lds_byte(int r, int c) { const int st = (r >> 4) * 2 + (c >> 5), rr = r & 15, cc = c & 31, ob = rr * 64 + cc * 2; return st * 1024 + (ob ^ (((ob >> 9) & 1) << 5)); }
__host__ __device__ __forceinline__ void stage_rc(int b, int& R, int& C) { const int st = b / 1024, sb = b % 1024, swz = sb ^ (((sb >> 9) & 1) << 5); R = (st >> 1) * 16 + swz / 64; C = (st & 1) * 32 + (swz % 64) / 2; }
__host__ __device__ __forceinline__ int perm32(int rho) { const int n = rho >> 4, i = rho & 15; return 8 * (i >> 2) + 4 * n + (i & 3); }

struct Unit { int pm, pn; };
struct Gemm { const bf16_t* A; const bf16_t* Bt; int M, N, K; };

struct StaticOrder {
    int nM, nN, nwg, G, c;
    __host__ __device__ void init(int M, int N, int G_, int c_) { nM = M / BM; nN = N / BM; nwg = nM * nN; G = G_; c = c_; }
    __host__ __device__ bool next(int i, Unit& u) const {
        const long L = (long)i * G + c; if (L >= nwg) return false;
        int wgid = (int)L; { const int q = nwg / NXCD, r = nwg % NXCD, xcd = wgid % NXCD, off = wgid / NXCD; wgid = (xcd < r ? xcd * (q + 1) : r * (q + 1) + (xcd - r) * q) + off; }
        const int nig = WGM * nN, gid = wgid / nig, fm = gid * WGM, gsz = (nM - fm) < WGM ? (nM - fm) : WGM;
        u.pm = fm + ((wgid % nig) % gsz); u.pn = (wgid % nig) / gsz; return true;
    }
    __device__ __forceinline__ void a_ready(const Unit&) const {}
    __device__ __forceinline__ void done(const Unit&) const {}
};

__device__ __forceinline__ unsigned cvt_pk_bf16(float lo, float hi) { unsigned r; asm volatile("v_cvt_pk_bf16_f32 %0, %1, %2" : "=v"(r) : "v"(lo), "v"(hi)); return r; }
typedef float f32x2 __attribute__((ext_vector_type(2)));
typedef unsigned u32x2 __attribute__((ext_vector_type(2)));
__device__ __forceinline__ float bf_lo(unsigned w) { return __uint_as_float(w << 16); }
__device__ __forceinline__ float bf_hi(unsigned w) { return __uint_as_float(w & 0xffff0000u); }
__device__ __forceinline__ float fsigmoid(float x) { return __builtin_amdgcn_rcpf(1.0f + __expf(-x)); }

struct EpiProj {
    static constexpr bool PERM = true, AFTER_DRAIN = false;
    bf16_t* P; float* gates;
    __device__ __forceinline__ void operator()(const f32x4 (&acc)[2][2][4][2], const Unit& u, int wr, int wc, int fr, int fq) const {
        const int row0 = u.pm * BM + wr * 64 + fr;
        if (u.pn < 44) {
            bf16_t* base = P + (size_t)u.pn * ((size_t)MROWS * 256) + wc * 32 + 8 * fq;
#pragma unroll
            for (int ai = 0; ai < 2; ++ai)
#pragma unroll
                for (int m = 0; m < 4; ++m) { bf16_t* rowp = base + (size_t)(row0 + ai * HALF + m * 16) * 256;
#pragma unroll
                    for (int bj = 0; bj < 2; ++bj) { const f32x4 v0 = acc[ai][bj][m][0], v1 = acc[ai][bj][m][1];
                        u32x4 w; w.x = cvt_pk_bf16(v0[0], v0[1]); w.y = cvt_pk_bf16(v0[2], v0[3]); w.z = cvt_pk_bf16(v1[0], v1[1]); w.w = cvt_pk_bf16(v1[2], v1[3]);
                        *(u32x4*)(rowp + bj * HALF) = w; } }
        } else if (wc < 2) {
#pragma unroll
            for (int ai = 0; ai < 2; ++ai)
#pragma unroll
                for (int m = 0; m < 4; ++m) { float* rp = gates + (size_t)(row0 + ai * HALF + m * 16) * 64 + wc * 32 + 8 * fq;
                    *(f32x4*)rp = acc[ai][0][m][0]; *(f32x4*)(rp + 4) = acc[ai][0][m][1]; }
        }
    }
};

struct EpiBranch {
    static constexpr bool PERM = true, AFTER_DRAIN = false;
    const bf16_t* G; bf16_t* O;
    __device__ __forceinline__ void operator()(const f32x4 (&acc)[2][2][4][2], const Unit& u, int wr, int wc, int fr, int fq) const {
        const int br = u.pn >> 3, pn = u.pn & 7, pm = u.pm & 63;
        const int row0 = pm * BM + wr * 64 + fr, cl = wc * 32 + 8 * fq;
        const bf16_t* gbase = G + (size_t)(28 + 8 * br + pn) * ((size_t)MROWS * 256) + cl;
        bf16_t* obase = O + pn * 256 + cl;
#pragma unroll
        for (int ai = 0; ai < 2; ++ai)
#pragma unroll
            for (int m = 0; m < 4; ++m) { const size_t r = (size_t)(row0 + ai * HALF + m * 16);
#pragma unroll
                for (int bj = 0; bj < 2; ++bj) {
                    const u32x4 gv = *(const u32x4*)(gbase + r * 256 + bj * HALF);
                    const f32x4 a0 = acc[ai][bj][m][0], a1 = acc[ai][bj][m][1];
                    float v[8];
                    v[0] = a0[0] * fsigmoid(bf_lo(gv.x)); v[1] = a0[1] * fsigmoid(bf_hi(gv.x)); v[2] = a0[2] * fsigmoid(bf_lo(gv.y)); v[3] = a0[3] * fsigmoid(bf_hi(gv.y));
                    v[4] = a1[0] * fsigmoid(bf_lo(gv.z)); v[5] = a1[1] * fsigmoid(bf_hi(gv.z)); v[6] = a1[2] * fsigmoid(bf_lo(gv.w)); v[7] = a1[3] * fsigmoid(bf_hi(gv.w));
                    bf16_t* op = obase + r * 2048 + bj * HALF;
                    if (br) { const u32x4 pv = *(const u32x4*)op;
                        v[0] += bf_lo(pv.x); v[1] += bf_hi(pv.x); v[2] += bf_lo(pv.y); v[3] += bf_hi(pv.y); v[4] += bf_lo(pv.z); v[5] += bf_hi(pv.z); v[6] += bf_lo(pv.w); v[7] += bf_hi(pv.w); }
                    u32x4 w; w.x = cvt_pk_bf16(v[0], v[1]); w.y = cvt_pk_bf16(v[2], v[3]); w.z = cvt_pk_bf16(v[4], v[5]); w.w = cvt_pk_bf16(v[6], v[7]);
                    *(u32x4*)op = w; } }
    }
};
struct BranchOrder {
    StaticOrder so;
    __host__ __device__ void init(int G_, int c_) { so.init(MROWS, 2048, G_, c_); }
    __host__ __device__ bool next(int i, Unit& u) const { Unit t; if (!so.next(i >> 1, t)) return false; const int br = i & 1; u.pm = t.pm + 64 * br; u.pn = t.pn + 8 * br; return true; }
    __device__ __forceinline__ void a_ready(const Unit&) const {}
    __device__ __forceinline__ void done(const Unit&) const {}
};

struct EpiResid {
    static constexpr bool PERM = false, AFTER_DRAIN = false;
    const float* base; float* out; int ldc;
    __device__ __forceinline__ void operator()(const f32x4 (&acc)[2][2][4][2], const Unit& u, int wr, int wc, int fr, int fq) const {
        const int col0 = u.pn * BM + wc * 32 + 4 * fq;
#pragma unroll
        for (int ai = 0; ai < 2; ++ai)
#pragma unroll
            for (int m = 0; m < 4; ++m) { const size_t off = (size_t)(u.pm * BM + ai * HALF + wr * 64 + m * 16 + fr) * ldc + col0;
#pragma unroll
                for (int bj = 0; bj < 2; ++bj)
#pragma unroll
                    for (int n = 0; n < 2; ++n) { const f32x4 bs = *(const f32x4*)(base + off + bj * HALF + n * 16); *(f32x4*)(out + off + bj * HALF + n * 16) = bs + acc[ai][bj][m][n]; } }
    }
};

struct EpiRelu2 {
    static constexpr bool PERM = true, AFTER_DRAIN = false;
    bf16_t* O; int ldc;
    __device__ __forceinline__ void operator()(const f32x4 (&acc)[2][2][4][2], const Unit& u, int wr, int wc, int fr, int fq) const {
        const int row0 = u.pm * BM + wr * 64 + fr, col0 = u.pn * BM + wc * 32 + 8 * fq;
#pragma unroll
        for (int ai = 0; ai < 2; ++ai)
#pragma unroll
            for (int m = 0; m < 4; ++m) { bf16_t* rowp = O + (size_t)(row0 + ai * HALF + m * 16) * ldc + col0;
#pragma unroll
                for (int bj = 0; bj < 2; ++bj) { f32x4 v0 = acc[ai][bj][m][0], v1 = acc[ai][bj][m][1];
#pragma unroll
                    for (int e = 0; e < 4; ++e) { const float a = fmaxf(v0[e], 0.f), b = fmaxf(v1[e], 0.f); v0[e] = a * a; v1[e] = b * b; }
                    u32x4 w; w.x = cvt_pk_bf16(v0[0], v0[1]); w.y = cvt_pk_bf16(v0[2], v0[3]); w.z = cvt_pk_bf16(v1[0], v1[1]); w.w = cvt_pk_bf16(v1[2], v1[3]);
                    *(u32x4*)(rowp + bj * HALF) = w; } }
    }
};
template <class Epi, class Sched, bool ALIGN_EPI = false, bool SP2 = false>
__device__ __forceinline__ void gemm_phase(PG8_LAS unsigned char* lds, const Gemm g, const Sched& S, const Epi& E) {
    const int tid = threadIdx.x, wid = __builtin_amdgcn_readfirstlane(tid >> 6), lane = tid & 63, wr = wid >> 2, wc = wid & 3, fr = lane & 15, fq = lane >> 4;
    const int K = g.K, nt = K / BK;
    unsigned voffA[2], voffB[2];
#pragma unroll
    for (int i = 0; i < 2; ++i) { int R, C; stage_rc(tid * 16 + i * 8192, R, C); const int Rb = Epi::PERM ? ((R & ~31) + perm32(R & 31)) : R;
        voffA[i] = (unsigned)(R * K + C) * 2u; voffB[i] = (unsigned)(Rb * K + C) * 2u; }
    const size_t kstep = (size_t)(BK * 2);
    const size_t hstep = (size_t)HALF * K * 2;
    const size_t tstep = 2 * hstep;
    const unsigned ldsw = (unsigned)wid * 1024u;
    const int aoff = lds_byte(wr * 64 + fr, fq * 8), boff = lds_byte(wc * 32 + fr, fq * 8);
#define PG8_SA(b, h) (((b) * 2 + (h)) * HTB)
#define PG8_SB(b, h) ((4 + (b) * 2 + (h)) * HTB)
#define PG8_STAGE(bufoff, gbase, voff) do { _Pragma("unroll") for (int _i = 0; _i < 2; ++_i) \
        __builtin_amdgcn_global_load_lds((const unsigned*)((const char*)(gbase) + (voff)[_i]), (PG8_LAS unsigned*)(lds + (bufoff) + ldsw + _i * 8192), 16, 0, 0); } while (0)
#define PG8_LDA(dst, b, h) do { _Pragma("unroll") for (int m = 0; m < 4; ++m) _Pragma("unroll") for (int k = 0; k < 2; ++k) dst[m][k] = *(const PG8_LAS bf16x8*)(lds + PG8_SA(b, h) + aoff + m * 2048 + k * 1024); } while (0)
#define PG8_LDB(dst, b, h) do { _Pragma("unroll") for (int n = 0; n < 2; ++n) _Pragma("unroll") for (int k = 0; k < 2; ++k) dst[n][k] = *(const PG8_LAS bf16x8*)(lds + PG8_SB(b, h) + boff + n * 2048 + k * 1024); } while (0)
#define PG8_MMA(ai, bj, At, Bt) do { __builtin_amdgcn_s_setprio(1); _Pragma("unroll") for (int m = 0; m < 4; ++m) _Pragma("unroll") for (int n = 0; n < 2; ++n) _Pragma("unroll") for (int k = 0; k < 2; ++k) \
        acc[ai][bj][m][n] = __builtin_amdgcn_mfma_f32_16x16x32_bf16(Bt[n][k], At[m][k], acc[ai][bj][m][n], 0, 0, 0); __builtin_amdgcn_s_setprio(0); } while (0)
#define PG8_WAIT_V(n) asm volatile("s_waitcnt vmcnt(" #n ")" ::: "memory")
#define PG8_WAIT_L(n) asm volatile("s_waitcnt lgkmcnt(" #n ")" ::: "memory")
#define PG8_BAR __builtin_amdgcn_s_barrier()
#define PG8_SCHED __builtin_amdgcn_sched_barrier(0)
    Unit cur, nxt; int ui = 0;
    if (!S.next(0, cur)) return;
    f32x4 acc[2][2][4][2];
#pragma unroll
    for (int a = 0; a < 2; ++a)
#pragma unroll
        for (int b = 0; b < 2; ++b)
#pragma unroll
            for (int m = 0; m < 4; ++m)
#pragma unroll
                for (int n = 0; n < 2; ++n) acc[a][b][m][n] = (f32x4){0.f, 0.f, 0.f, 0.f};
    bf16x8 At[4][2], B0[2][2], B1[2][2];
    const char* cA = (const char*)g.A + (size_t)cur.pm * tstep; const char* cB = (const char*)g.Bt + (size_t)cur.pn * tstep;
    S.a_ready(cur);
    if constexpr (SP2) {
        PG8_STAGE(PG8_SB(0, 0), cB, voffB); PG8_STAGE(PG8_SB(0, 1), cB + hstep, voffB); PG8_STAGE(PG8_SA(0, 0), cA, voffA); PG8_STAGE(PG8_SA(0, 1), cA + hstep, voffA);
        if (wr == 1) PG8_BAR;
        PG8_WAIT_V(2); PG8_BAR;
        PG8_STAGE(PG8_SB(1, 0), cB + kstep, voffB); PG8_STAGE(PG8_SA(1, 0), cA + kstep, voffA); PG8_STAGE(PG8_SB(1, 1), cB + hstep + kstep, voffB);
        PG8_WAIT_V(6); PG8_BAR;
    } else {
        PG8_STAGE(PG8_SB(0, 0), cB, voffB); PG8_STAGE(PG8_SA(0, 0), cA, voffA); PG8_STAGE(PG8_SB(0, 1), cB + hstep, voffB); PG8_STAGE(PG8_SA(0, 1), cA + hstep, voffA);
        if (wr == 1) PG8_BAR;
        PG8_WAIT_V(4); PG8_BAR;
        PG8_STAGE(PG8_SB(1, 0), cB + kstep, voffB); PG8_STAGE(PG8_SA(1, 0), cA + kstep, voffA); PG8_STAGE(PG8_SB(1, 1), cB + hstep + kstep, voffB);
        PG8_WAIT_V(6); PG8_BAR;
    }
    for (;;) {
        const bool has_next = S.next(ui + 1, nxt);
        const char* nA = has_next ? (const char*)g.A + (size_t)nxt.pm * tstep : cA; const char* nB = has_next ? (const char*)g.Bt + (size_t)nxt.pn * tstep : cB;
        for (int t = 0; t < nt; t += 2) {
            const bool last = (t == nt - 2);
            const char* a1 = cA + (size_t)(t + 1) * kstep;
            const char* a2 = last ? nA : cA + (size_t)(t + 2) * kstep; const char* b2 = last ? nB : cB + (size_t)(t + 2) * kstep;
            const char* a3 = a2 + kstep; const char* b3 = b2 + kstep;
            if (last && has_next) S.a_ready(nxt);
            if constexpr (SP2) {
            PG8_LDB(B0, 0, 0); PG8_LDB(B1, 0, 1); PG8_SCHED; PG8_LDA(At, 0, 0); PG8_STAGE(PG8_SA(1, 1), a1 + hstep, voffA);
            PG8_WAIT_V(8); PG8_WAIT_L(0); PG8_BAR; PG8_MMA(0, 0, At, B0); PG8_MMA(0, 1, At, B1); PG8_BAR; PG8_SCHED;
            PG8_LDA(At, 0, 1); PG8_STAGE(PG8_SB(0, 0), b2, voffB); PG8_STAGE(PG8_SB(0, 1), b2 + hstep, voffB); PG8_STAGE(PG8_SA(0, 0), a2, voffA);
            PG8_WAIT_V(8); PG8_WAIT_L(0); PG8_BAR; PG8_MMA(1, 0, At, B0); PG8_MMA(1, 1, At, B1); PG8_BAR; PG8_SCHED;
            PG8_LDB(B0, 1, 0); PG8_LDB(B1, 1, 1); PG8_SCHED; PG8_LDA(At, 1, 0); PG8_STAGE(PG8_SA(0, 1), a2 + hstep, voffA);
            PG8_WAIT_V(8); PG8_WAIT_L(0); PG8_BAR; PG8_MMA(0, 0, At, B0); PG8_MMA(0, 1, At, B1); PG8_BAR; PG8_SCHED;
            PG8_LDA(At, 1, 1); PG8_STAGE(PG8_SB(1, 0), b3, voffB); PG8_STAGE(PG8_SB(1, 1), b3 + hstep, voffB); PG8_STAGE(PG8_SA(1, 0), a3, voffA);
            PG8_WAIT_V(8); PG8_WAIT_L(0); PG8_BAR; PG8_MMA(1, 0, At, B0); PG8_MMA(1, 1, At, B1); PG8_BAR; PG8_SCHED;
            } else {
            PG8_LDB(B0, 0, 0); PG8_SCHED; PG8_LDA(At, 0, 0); PG8_STAGE(PG8_SA(1, 1), a1 + hstep, voffA);
            PG8_WAIT_L(8); PG8_BAR; PG8_WAIT_L(0); PG8_MMA(0, 0, At, B0); PG8_BAR; PG8_SCHED;
            PG8_LDB(B1, 0, 1); PG8_STAGE(PG8_SB(0, 0), b2, voffB);
            PG8_BAR; PG8_WAIT_L(0); PG8_MMA(0, 1, At, B1); PG8_BAR;
            PG8_LDA(At, 0, 1); PG8_STAGE(PG8_SA(0, 0), a2, voffA);
            PG8_BAR; PG8_WAIT_L(0); PG8_MMA(1, 0, At, B0); PG8_BAR; PG8_SCHED;
            PG8_STAGE(PG8_SB(0, 1), b2 + hstep, voffB);
            PG8_WAIT_V(6); PG8_BAR; PG8_MMA(1, 1, At, B1); PG8_BAR;
            PG8_LDB(B0, 1, 0); PG8_SCHED; PG8_LDA(At, 1, 0); PG8_STAGE(PG8_SA(0, 1), a2 + hstep, voffA);
            PG8_WAIT_L(8); PG8_BAR; PG8_WAIT_L(0); PG8_MMA(0, 0, At, B0); PG8_BAR; PG8_SCHED;
            PG8_LDB(B1, 1, 1); PG8_STAGE(PG8_SB(1, 0), b3, voffB);
            PG8_BAR; PG8_WAIT_L(0); PG8_MMA(0, 1, At, B1); PG8_BAR;
            PG8_LDA(At, 1, 1); PG8_STAGE(PG8_SA(1, 0), a3, voffA);
            PG8_BAR; PG8_WAIT_L(0); PG8_MMA(1, 0, At, B0); PG8_BAR; PG8_SCHED;
            PG8_STAGE(PG8_SB(1, 1), b3 + hstep, voffB);
            PG8_WAIT_V(6); PG8_BAR; PG8_MMA(1, 1, At, B1); PG8_BAR;
            }
        }
        if constexpr (ALIGN_EPI) { if (wr == 0) PG8_BAR; }
        if constexpr (!Epi::AFTER_DRAIN) { E(acc, cur, wr, wc, fr, fq); S.done(cur); }
        if (!has_next) break;
#pragma unroll
        for (int a = 0; a < 2; ++a)
#pragma unroll
            for (int b = 0; b < 2; ++b)
#pragma unroll
                for (int m = 0; m < 4; ++m)
#pragma unroll
                    for (int n = 0; n < 2; ++n) acc[a][b][m][n] = (f32x4){0.f, 0.f, 0.f, 0.f};
        cur = nxt; cA = nA; cB = nB; ++ui;
        if constexpr (ALIGN_EPI) { if (wr == 1) PG8_BAR; }
    }
    PG8_WAIT_V(0);
    if constexpr (!ALIGN_EPI) { if (wr == 0) PG8_BAR; }
    PG8_BAR;
    if constexpr (Epi::AFTER_DRAIN) { E.fused(acc, cur, wr, wc, fr, fq, lds, wid, lane); S.done(cur); }
#undef PG8_SA
#undef PG8_SB
#undef PG8_STAGE
#undef PG8_LDA
#undef PG8_LDB
#undef PG8_MMA
#undef PG8_WAIT_V
#undef PG8_WAIT_L
#undef PG8_BAR
#undef PG8_SCHED
}
}
constexpr int NWAVES = 8;
constexpr int N_LAUNCHES = MK_N_LAUNCHES;
constexpr int PER_PHASE = 11;
constexpr int SEQ = 2048, DM = 2048, DFF = 8192, NPROJ_IN = 11312, NPROJ_PAD = 11520;
constexpr float RMS_EPS = 1e-6f;
constexpr size_t MiB = 1u << 20;
constexpr size_t BLK = (size_t)MROWS * 256;
constexpr size_t WS_CTL = 0, CTL_ZERO_BYTES = 1 * MiB;
constexpr size_t WS_GATES = 1 * MiB, WS_WBM = 5 * MiB, WS_WBD = 9 * MiB, WS_WOUT = 13 * MiB, WS_PROJ = 21 * MiB, WS_WIN = 373 * MiB, WS_XN = 418 * MiB;
constexpr size_t WS_DQ = 373 * MiB, WS_DK = 405 * MiB, WS_DV = 437 * MiB;
constexpr size_t WS_HM = 117 * MiB, WS_ODF = 181 * MiB, WS_ODB = 469 * MiB;
constexpr size_t WS_YM = 21 * MiB, WS_YD = 53 * MiB, WS_MIX = 373 * MiB;
constexpr size_t WS_XN2 = 437 * MiB, WS_W1T = 21 * MiB, WS_W2T = 53 * MiB, WS_HFF = 117 * MiB, WS_END = 509 * MiB;
constexpr int CW_BAR = 4096;
constexpr int LDS_BYTES = 163840;
constexpr int MISC_OFF = LDS_BYTES - 256;

#define GAS __attribute__((address_space(1)))
#define LAS __attribute__((address_space(3)))
typedef unsigned short bf16;
typedef unsigned v4u __attribute__((ext_vector_type(4)));
typedef unsigned v2u __attribute__((ext_vector_type(2)));
typedef float f32x4 __attribute__((ext_vector_type(4)));
typedef short bf16x8 __attribute__((ext_vector_type(8)));
typedef GAS unsigned gu32;
#define RLX_AGENT __ATOMIC_RELAXED, __HIP_MEMORY_SCOPE_AGENT
#define LDS_WAIT() asm volatile("s_waitcnt lgkmcnt(0)" ::: "memory")
#define VM_WAIT() asm volatile("s_waitcnt vmcnt(0)" ::: "memory")
__device__ __forceinline__ unsigned f2bf(float f) { unsigned u = __builtin_bit_cast(unsigned, f); return (u + 0x7fffu + ((u >> 16) & 1u)) >> 16; }
typedef float f32x2v_ __attribute__((ext_vector_type(2)));
typedef __bf16 bf16x2v_ __attribute__((ext_vector_type(2)));
__device__ __forceinline__ unsigned pk2(float lo, float hi) { const f32x2v_ v = {lo, hi}; return __builtin_bit_cast(unsigned, __builtin_convertvector(v, bf16x2v_)); }
__device__ __forceinline__ float bflo(unsigned w) { return __uint_as_float(w << 16); }
__device__ __forceinline__ float bfhi(unsigned w) { return __uint_as_float(w & 0xffff0000u); }
__device__ __forceinline__ float bfel(const v4u& v, int i) { const unsigned w = v[i >> 1]; return (i & 1) ? bfhi(w) : bflo(w); }
#define MFMA16(a, b, c) __builtin_amdgcn_mfma_f32_16x16x32_bf16((a), (b), (c), 0, 0, 0)
__device__ __forceinline__ bf16x8 ldfrag(const LAS unsigned char* p) { return *(const LAS bf16x8*)p; }
__device__ __forceinline__ void st8(LAS unsigned char* p, const f32x4& v) { v2u w; w.x = pk2(v[0], v[1]); w.y = pk2(v[2], v[3]); *(LAS v2u*)p = w; }
#define XB_TMO      128
#define XB_XCNT(j)  (256  + 64 * (j))
#define XB_XSUB(j)  (1280 + 64 * (j))
#define XB_XGEN(j)  (2304 + 64 * (j))
#define XB_TOP      3328
#define XB_TOPGEN   3392
#define XCD_BAR_WORDS 3456
#define XB_SPIN_CAP (1u << 18)

__device__ __forceinline__ unsigned xb_ld(unsigned* p)              { return __hip_atomic_load(p, __ATOMIC_RELAXED, __HIP_MEMORY_SCOPE_AGENT); }
__device__ __forceinline__ unsigned xb_add(unsigned* p, unsigned v) { return __hip_atomic_fetch_add(p, v, __ATOMIC_RELAXED, __HIP_MEMORY_SCOPE_AGENT); }
__device__ __forceinline__ unsigned xb_xcc_id() { return (unsigned)__builtin_amdgcn_s_getreg((3 << 11) | 20) & 0xFu; }
#define XB_SPIN(cond, bar) do { unsigned _sp = 0; while (cond) { __builtin_amdgcn_s_sleep(1); \
    if ((++_sp & 255u) == 0u) { if (xb_ld(&(bar)[XB_TMO])) break; if (_sp > XB_SPIN_CAP) { atomicAdd(&(bar)[XB_TMO], 1u); break; } } } } while (0)

struct XcdBarrier {
    unsigned* bar; unsigned x;
    volatile LAS unsigned* st;
};

__device__ __forceinline__ XcdBarrier xcd_barrier_post(unsigned* bar, volatile LAS unsigned* st) {
    XcdBarrier b; b.bar = bar; b.x = xb_xcc_id(); b.st = st;
    if (threadIdx.x == 0) (void)xb_add(&bar[XB_XCNT(b.x)], 1u);
    return b;
}
__device__ __forceinline__ void xcd_barrier_complete(unsigned* bar, unsigned x, unsigned& nloc, unsigned& nx) {
    const unsigned G = gridDim.x * gridDim.y * gridDim.z;
    unsigned sum, cnt, mine, sp = 0u;
    for (;;) {
        sum = 0u; cnt = 0u; mine = 0u;
#pragma unroll
        for (unsigned j = 0; j < 16; ++j) { const unsigned c = xb_ld(&bar[XB_XCNT(j)]); sum += c; cnt += (c > 0u) ? 1u : 0u; mine = (j == x) ? c : mine; }
        if (sum == G) break;
        __builtin_amdgcn_s_sleep(1);
        if ((++sp & 255u) == 0u) { if (xb_ld(&bar[XB_TMO])) break; if (sp > XB_SPIN_CAP) { atomicAdd(&bar[XB_TMO], 1u); break; } }
    }
    nloc = mine > 0u ? mine : 1u; nx = cnt > 0u ? cnt : 1u;
}

__device__ __forceinline__ void xcd_barrier(const XcdBarrier& b) {
    asm volatile("s_waitcnt vmcnt(0)" ::: "memory");
    __syncthreads();
    if (threadIdx.x == 0) {
        unsigned* bar = b.bar;
        __builtin_amdgcn_s_waitcnt(0);
        unsigned nloc = b.st[0], nx = b.st[1];
        if (nloc == 0u) { xcd_barrier_complete(bar, b.x, nloc, nx); b.st[0] = nloc; b.st[1] = nx; }
        const unsigned old = xb_add(&bar[XB_XSUB(b.x)], 1u);
        const unsigned gen = old / nloc;
        if (old + 1u == (gen + 1u) * nloc) {
            __builtin_amdgcn_fence(__ATOMIC_RELEASE, "agent");
            asm volatile("s_waitcnt vmcnt(0)" ::: "memory");
            const unsigned og = xb_add(&bar[XB_TOP], 1u);
            const unsigned tg = og / nx;
            if (og + 1u == (tg + 1u) * nx) xb_add(&bar[XB_TOPGEN], 1u);
            else XB_SPIN(xb_ld(&bar[XB_TOPGEN]) == tg, bar);
            __builtin_amdgcn_fence(__ATOMIC_ACQUIRE, "agent");
            xb_add(&bar[XB_XGEN(b.x)], 1u);
            asm volatile("s_waitcnt vmcnt(0)" ::: "memory");
        } else {
            XB_SPIN(xb_ld(&bar[XB_XGEN(b.x)]) == gen, bar);
            __builtin_amdgcn_fence(__ATOMIC_ACQUIRE, "agent");
            asm volatile("s_waitcnt vmcnt(0)" ::: "memory");
        }
    }
    __syncthreads();
}
struct Frame {
    LAS unsigned char* lds;
    volatile LAS unsigned* MISC;
    gu32* ctl;
    int tid, lane, wave;
    int vcu, G;
    float* out;
    unsigned char* ws;
};
__device__ __forceinline__ float wave_sum(float v) {
#pragma unroll
    for (int o = 1; o < 64; o <<= 1) v += __shfl_xor(v, o);
    return v;
}
__device__ __forceinline__ int win_map(int n) {
    if (n < 3072) return n;
    if (n < 3088) return 11264 + (n - 3072);
    if (n < 7184) return n - 16;
    if (n < 7216) return 11264 + 16 + (n - 7184);
    return n - 48;
}
constexpr int TR_SCR = 64 * 65 * 4;
__device__ __forceinline__ void tr_item(const float* W, int K, int N, bf16* WT, LAS float* scr, int item, int lane, bool remap) {
    const int nblk = (N + 63) / 64, kb = item / nblk, nb = item % nblk, k0 = 64 * kb, n0 = 64 * nb;
    const int kr = lane >> 4, c4 = lane & 15, nn = n0 + 4 * c4; const bool okc = nn < N;
    f32x4 v[16];
#pragma unroll
    for (int i = 0; i < 16; ++i) v[i] = okc ? *(const f32x4*)(W + (size_t)(k0 + 4 * i + kr) * N + nn) : (f32x4){0.f, 0.f, 0.f, 0.f};
#pragma unroll
    for (int i = 0; i < 16; ++i) { LAS float* s = scr + (4 * i + kr) * 65 + 4 * c4; s[0] = v[i].x; s[1] = v[i].y; s[2] = v[i].z; s[3] = v[i].w; }
    LDS_WAIT(); asm volatile("" ::: "memory");
    const int j = lane >> 3, n8 = lane & 7;
#pragma unroll
    for (int p = 0; p < 8; ++p) { const int n = 8 * p + n8; const LAS float* s = scr + (8 * j) * 65 + n;
        v4u o; o.x = pk2(s[0 * 65], s[1 * 65]); o.y = pk2(s[2 * 65], s[3 * 65]); o.z = pk2(s[4 * 65], s[5 * 65]); o.w = pk2(s[6 * 65], s[7 * 65]);
        if (n0 + n < N) { const int row = remap ? win_map(n0 + n) : (n0 + n); *(v4u*)(WT + (size_t)row * K + k0 + 8 * j) = o; } }
    LDS_WAIT(); asm volatile("" ::: "memory");
}
__device__ __forceinline__ void rms_row_bf16(int lane, const float* xrow, const float* g, bf16* orow) {
    const f32x4* xr = (const f32x4*)xrow + lane; const f32x4* gr = (const f32x4*)g + lane;
    f32x4 v[8]; float s = 0.f;
#pragma unroll
    for (int j = 0; j < 8; ++j) { v[j] = xr[64 * j]; s += (v[j].x * v[j].x + v[j].y * v[j].y) + (v[j].z * v[j].z + v[j].w * v[j].w); }
    const float r = 1.0f / sqrtf(wave_sum(s) * (1.f / 2048.f) + RMS_EPS);
    v2u* o8 = (v2u*)orow + lane;
#pragma unroll
    for (int j = 0; j < 8; ++j) { const f32x4 gg = gr[64 * j]; v2u w; w.x = pk2(v[j].x * r * gg.x, v[j].y * r * gg.y); w.y = pk2(v[j].z * r * gg.z, v[j].w * r * gg.w); o8[64 * j] = w; }
}
__device__ __forceinline__ void rms_row_f32(int lane, const float* xrow, const float* g, float* orow) {
    const f32x4* xr = (const f32x4*)xrow + lane; const f32x4* gr = (const f32x4*)g + lane;
    f32x4 v[8]; float s = 0.f;
#pragma unroll
    for (int j = 0; j < 8; ++j) { v[j] = xr[64 * j]; s += (v[j].x * v[j].x + v[j].y * v[j].y) + (v[j].z * v[j].z + v[j].w * v[j].w); }
    const float r = 1.0f / sqrtf(wave_sum(s) * (1.f / 2048.f) + RMS_EPS);
    f32x4* o = (f32x4*)orow + lane;
#pragma unroll
    for (int j = 0; j < 8; ++j) { const f32x4 gg = gr[64 * j]; o[64 * j] = (v[j] * r) * gg; }
}

__device__ __forceinline__ void p0_prologue(Frame& F, const float* x, const float* n1g, const float* w_in, const float* w_bm, const float* w_bd, const float* w_out) {
    LAS float* scr = (LAS float*)(F.lds + F.wave * TR_SCR);
    const int gw = F.vcu * NWAVES + F.wave, NGW = F.G * NWAVES;
    bf16* WIN = (bf16*)(F.ws + WS_WIN); bf16* WBM = (bf16*)(F.ws + WS_WBM); bf16* WBD = (bf16*)(F.ws + WS_WBD); bf16* WOUT = (bf16*)(F.ws + WS_WOUT); bf16* XN = (bf16*)(F.ws + WS_XN);
    constexpr int I_IN = (DM / 64) * ((NPROJ_IN + 63) / 64), I_B = (1024 / 64) * (DM / 64), I_O = (DM / 64) * (DM / 64);
    constexpr int NITEMS = I_IN + 2 * I_B + I_O;
    for (int it = gw; it < NITEMS; it += NGW) {
        int r = it;
        if (r < I_IN) { tr_item(w_in, DM, NPROJ_IN, WIN, scr, r, F.lane, true); continue; } r -= I_IN;
        if (r < I_B) { tr_item(w_bm, 1024, DM, WBM, scr, r, F.lane, false); continue; } r -= I_B;
        if (r < I_B) { tr_item(w_bd, 1024, DM, WBD, scr, r, F.lane, false); continue; } r -= I_B;
        tr_item(w_out, DM, DM, WOUT, scr, r, F.lane, false);
    }
    { v4u* z = (v4u*)(WIN + (size_t)(11264 + 48) * DM); const int nz = (NPROJ_PAD - 11264 - 48) * DM / 8;
      for (int i = gw * 64 + F.lane; i < nz; i += NGW * 64) z[i] = (v4u){0u, 0u, 0u, 0u}; }
    for (int m = gw; m < MROWS; m += NGW) rms_row_bf16(F.lane, x + (size_t)m * DM, n1g, XN + (size_t)m * DM);
}

__device__ __forceinline__ void p2_conv(Frame& F, const float* convw) {
    const int gw = F.vcu * NWAVES + F.wave, NGW = F.G * NWAVES, lane = F.lane, c = lane & 15, r4 = lane >> 4;
    const bf16* PROJ = (const bf16*)(F.ws + WS_PROJ);
    bf16* DQ = (bf16*)(F.ws + WS_DQ); bf16* DK = (bf16*)(F.ws + WS_DK); bf16* DV = (bf16*)(F.ws + WS_DV);
    constexpr int NIT = 24 * (MROWS / 32);
    for (int it = gw; it < NIT; it += NGW) {
        const int gI = it % 24, tb32 = it / 24, m0 = tb32 * 32 + r4 * 8, b = m0 >> 11, t0 = m0 & 2047;
        const int c0 = gI * 128;
        const bf16* src = PROJ + (size_t)(12 + (c0 >> 8)) * BLK + (c0 & 255) + 8 * c;
        v4u xr[12];
#pragma unroll
        for (int i = 0; i < 12; ++i) { const int tp = t0 - 2 + i; xr[i] = (v4u){0u, 0u, 0u, 0u};
            if (tp >= 0 && tp < SEQ) xr[i] = *(const v4u*)(src + (size_t)(b * SEQ + tp) * 256); }
        f32x4 cwl[5], cwh[5];
#pragma unroll
        for (int i = 0; i < 5; ++i) { const float* cp = convw + (size_t)i * 3072 + c0 + 8 * c; cwl[i] = *(const f32x4*)cp; cwh[i] = *(const f32x4*)(cp + 4); }
        bf16* dst = (gI < 8 ? DQ : (gI < 16 ? DK : DV)) + (size_t)m0 * 1024 + (c0 & 1023) + 8 * c;
#pragma unroll
        for (int o = 0; o < 8; ++o) {
            float y[8];
#pragma unroll
            for (int e = 0; e < 8; ++e) y[e] = 0.f;
#pragma unroll
            for (int i = 0; i < 5; ++i) { const v4u xv = xr[o + i];
                y[0] += cwl[i][0] * bflo(xv.x); y[1] += cwl[i][1] * bfhi(xv.x); y[2] += cwl[i][2] * bflo(xv.y); y[3] += cwl[i][3] * bfhi(xv.y);
                y[4] += cwh[i][0] * bflo(xv.z); y[5] += cwh[i][1] * bfhi(xv.z); y[6] += cwh[i][2] * bflo(xv.w); y[7] += cwh[i][3] * bfhi(xv.w); }
            float ss = 0.f;
#pragma unroll
            for (int e = 0; e < 8; ++e) { y[e] = y[e] / (1.0f + __expf(-y[e])); ss += y[e] * y[e]; }
            if (gI < 16) { ss += __shfl_xor(ss, 1); ss += __shfl_xor(ss, 2); ss += __shfl_xor(ss, 4); ss += __shfl_xor(ss, 8);
                float r = 1.0f / sqrtf(ss + 1e-6f); if (gI < 8) r *= 0.08838834764831845f;
#pragma unroll
                for (int e = 0; e < 8; ++e) y[e] *= r; }
            v4u ov; ov.x = pk2(y[0], y[1]); ov.y = pk2(y[2], y[3]); ov.z = pk2(y[4], y[5]); ov.w = pk2(y[6], y[7]);
            *(v4u*)(dst + (size_t)o * 1024) = ov;
        }
    }
}

#define WG_BAR() do { asm volatile("s_waitcnt lgkmcnt(0)" ::: "memory"); __builtin_amdgcn_s_barrier(); asm volatile("" ::: "memory"); } while (0)
typedef short s16x4 __attribute__((ext_vector_type(4)));
__device__ __forceinline__ bf16x8 ldfrag_tr(const LAS unsigned char* p, int RS) {
    const s16x4 lo = __builtin_amdgcn_ds_read_tr16_b64_v4i16((LAS s16x4*)p);
    const s16x4 hi = __builtin_amdgcn_ds_read_tr16_b64_v4i16((LAS s16x4*)(p + 4 * RS));
    return __builtin_shufflevector(lo, hi, 0, 1, 2, 3, 4, 5, 6, 7);
}
__device__ __forceinline__ int trofs(int lane, int RS) { const int i = lane & 15, g = lane >> 4; return (8 * g + (i >> 2)) * RS + 8 * (i & 3); }
template <int CTRL, int ROWMASK> __device__ __forceinline__ float dppf(float old, float src) {
    return __builtin_bit_cast(float, __builtin_amdgcn_update_dpp(__builtin_bit_cast(int, old), __builtin_bit_cast(int, src), CTRL, ROWMASK, 0xf, false)); }
__device__ __forceinline__ float wave_incl_sum(float v) {
    v += dppf<0x111, 0xf>(0.f, v); v += dppf<0x112, 0xf>(0.f, v); v += dppf<0x114, 0xf>(0.f, v); v += dppf<0x118, 0xf>(0.f, v);
    v += dppf<0x142, 0xa>(0.f, v); v += dppf<0x143, 0xc>(0.f, v); return v; }
__device__ __forceinline__ float wave_incl_max(float v) {
    const float NI = -3.0e38f;
    v = fmaxf(v, dppf<0x111, 0xf>(NI, v)); v = fmaxf(v, dppf<0x112, 0xf>(NI, v)); v = fmaxf(v, dppf<0x114, 0xf>(NI, v)); v = fmaxf(v, dppf<0x118, 0xf>(NI, v));
    v = fmaxf(v, dppf<0x142, 0xa>(NI, v)); v = fmaxf(v, dppf<0x143, 0xc>(NI, v)); return v; }
__device__ __forceinline__ float lane63(float v) { return __builtin_bit_cast(float, __builtin_amdgcn_readlane(__builtin_bit_cast(int, v), 63)); }
__device__ __forceinline__ v4u scale8(const v4u& v, float s) { v4u o; o.x = pk2(bflo(v.x) * s, bfhi(v.x) * s); o.y = pk2(bflo(v.y) * s, bfhi(v.y) * s); o.z = pk2(bflo(v.z) * s, bfhi(v.z) * s); o.w = pk2(bflo(v.w) * s, bfhi(v.w) * s); return o; }

#ifdef PROBE_SEG
#define TP(k) do { if (PROBE_SEG == (k)) tp0 = __builtin_amdgcn_s_memtime(); if (PROBE_SEG + PROBE_LEN == (k)) tpacc += __builtin_amdgcn_s_memtime() - tp0; } while (0)
#define TP_DECL unsigned long long tp0 = 0, tpacc = 0;
#define TP_SPIN(isunit0) do { if ((isunit0) && tid == 0) { const unsigned long long t1 = __builtin_amdgcn_s_memtime(), dt = (PROBE_SEG == 99) ? 1000000ull * PROBE_AMP : tpacc * PROBE_AMP; while (__builtin_amdgcn_s_memtime() - t1 < dt) __builtin_amdgcn_s_sleep(8); } } while (0)
#else
#define TP(k) do {} while (0)
#define TP_DECL
#define TP_SPIN(x) do {} while (0)
#endif
constexpr int ML_QP = 0, ML_KS = 25600, ML_KW = 43008, ML_VX = 60416, ML_CT = 79872, ML_CT_BYTES = 39168, ML_VEC = 119040, ML_VECN = 336;
constexpr float ML_SCALE = 0.08838834764831845f;
__device__ __forceinline__ void mlstm_unit(Frame& F, int unit, const float* m_ib, const float* m_fb) {
    const int tid = F.tid, lane = F.lane, w = F.wave, fr = lane & 15, fq = lane >> 4;
    const int half = unit & 1, dir = (unit >> 1) & 1, h = (unit >> 2) & 3, b = unit >> 4;
    LAS unsigned char* L = F.lds;
    LAS float* vec = (LAS float*)(L + ML_VEC);
    const int tro272 = trofs(lane, 272), tro304 = trofs(lane, 304);
    for (int i = tid; i < ML_CT_BYTES / 16; i += 512) ((LAS v4u*)(L + ML_CT))[i] = (v4u){0u, 0u, 0u, 0u};
    if (tid < 64) { *(LAS v4u*)(L + ML_VX + tid * 304 + 256) = (v4u){0x00003f80u, 0u, 0u, 0u}; *(LAS v4u*)(L + ML_VX + tid * 304 + 272) = (v4u){0u, 0u, 0u, 0u}; }
    f32x4 accS[9];
#pragma unroll
    for (int t = 0; t < 9; ++t) accS[t] = (f32x4){0.f, 0.f, 0.f, 0.f};
    float m_st = -1e30f;
    const bf16* PROJ = (const bf16*)(F.ws + WS_PROJ);
    const float* GATES = (const float*)(F.ws + WS_GATES);
    const bf16* Qg = PROJ + (size_t)(h >> 1) * BLK + (h & 1) * 128;
    const bf16* Kg = PROJ + (size_t)(2 + (h >> 1)) * BLK + (h & 1) * 128;
    const bf16* Vg = PROJ + (size_t)(4 + h) * BLK + half * 128;
    bf16* Hout = (bf16*)(F.ws + WS_HM) + (size_t)dir * MROWS * 1024 + h * 256 + half * 128;
    const float ib = m_ib[dir * 4 + h], fb = m_fb[dir * 4 + h];
    const int sr = tid >> 4, sc = tid & 15;
    v4u q[2], k[2], v[2];
    float g_i = 0.f, g_f = 0.f;
#define ML_GATES(vb_, ig_raw, f_raw) do { \
        const float ig_ = (ig_raw) + ib, fp_ = (f_raw) + fb; \
        const float lf_ = fp_ >= 0.f ? -__logf(1.0f + __expf(-fp_)) : fp_ - __logf(1.0f + __expf(fp_)); \
        const float bc_ = wave_incl_sum(lf_), a_ = ig_ - bc_, am_ = wave_incl_max(a_); \
        const float Ml_ = fmaxf(m_st, am_), M63_ = lane63(Ml_), bl_ = lane63(bc_); \
        (vb_)[lane] = a_; (vb_)[64 + lane] = Ml_; (vb_)[128 + lane] = __expf(-(bc_ + Ml_)); (vb_)[192 + lane] = __expf(m_st - Ml_) * ML_SCALE; (vb_)[256 + lane] = __expf(a_ - M63_); \
        if (lane == 0) (vb_)[320] = __expf(m_st - M63_); \
        m_st = bl_ + M63_; } while (0)
#define ML_LOADQKV(jj) do { _Pragma("unroll") for (int p = 0; p < 2; ++p) { const int tt_ = (jj) * 64 + sr + 32 * p, t_ = dir ? (SEQ - 1 - tt_) : tt_; const size_t mr_ = (size_t)(b * SEQ + t_); \
        q[p] = *(const v4u*)(Qg + mr_ * 256 + sc * 8); k[p] = *(const v4u*)(Kg + mr_ * 256 + sc * 8); v[p] = *(const v4u*)(Vg + mr_ * 256 + sc * 8); } } while (0)
#define ML_LOADG(jj) do { const int tt_ = (jj) * 64 + lane, t_ = dir ? (SEQ - 1 - tt_) : tt_; const size_t mr_ = (size_t)(b * SEQ + t_); g_i = GATES[mr_ * 64 + dir * 4 + h]; g_f = GATES[mr_ * 64 + 8 + dir * 4 + h]; } while (0)
    ML_LOADQKV(0);
    if (w == 0) { ML_LOADG(0); ML_GATES(vec, g_i, g_f); ML_LOADG(1); }
    __syncthreads();
    TP_DECL
    for (int j = 0; j < 32; ++j) {
        TP(0);
        LAS float* vb = vec + (j & 1) * ML_VECN;
#pragma unroll
        for (int p = 0; p < 2; ++p) { const int r = sr + 32 * p; const float wsr = vb[256 + r];
            *(LAS v4u*)(L + ML_QP + r * 400 + 128 + sc * 16) = q[p]; *(LAS v4u*)(L + ML_KS + r * 272 + sc * 16) = k[p];
            *(LAS v4u*)(L + ML_KW + r * 272 + sc * 16) = scale8(k[p], wsr); *(LAS v4u*)(L + ML_VX + r * 304 + sc * 16) = v[p]; }
        if (j + 1 < 32) ML_LOADQKV(j + 1);
        if (w == 0 && j + 1 < 32) { LAS float* vn = vec + ((j + 1) & 1) * ML_VECN; ML_GATES(vn, g_i, g_f); if (j + 2 < 32) ML_LOADG(j + 2); }
        TP(1); WG_BAR(); TP(2);
        {
            const int lt = w & 3, l = lt * 16 + fr; const float Ml = vb[64 + l];
#pragma unroll
            for (int s2 = 0; s2 < 2; ++s2) { const int st = (w >> 2) * 2 + s2;
                f32x4 acc = (f32x4){0.f, 0.f, 0.f, 0.f};
                if (st <= lt) {
#pragma unroll
                    for (int ks = 0; ks < 4; ++ks) acc = MFMA16(ldfrag(L + ML_KS + (st * 16 + fr) * 272 + ks * 64 + fq * 16), ldfrag(L + ML_QP + l * 400 + 128 + ks * 64 + fq * 16), acc); }
                f32x4 pv;
#pragma unroll
                for (int r = 0; r < 4; ++r) { const int s = st * 16 + 4 * fq + r; pv[r] = (s <= l) ? acc[r] * ML_SCALE * __expf(fminf(vb[s] - Ml, 0.f)) : 0.f; }
                st8(L + ML_QP + l * 400 + (st * 16 + 4 * fq) * 2, pv); }
        }
        TP(3); WG_BAR(); TP(4);
        {
            const int lt = w & 3, dq = w >> 2, l = lt * 16 + fr;
            f32x4 aPV[5], aQC[5];
#pragma unroll
            for (int t = 0; t < 5; ++t) { aPV[t] = (f32x4){0.f, 0.f, 0.f, 0.f}; aQC[t] = (f32x4){0.f, 0.f, 0.f, 0.f}; }
            bf16x8 bq[6];
#pragma unroll
            for (int ks = 0; ks < 6; ++ks) bq[ks] = ldfrag(L + ML_QP + l * 400 + ks * 64 + fq * 16);
#pragma unroll
            for (int t = 0; t < 5; ++t) { const int tile = (t < 4) ? (dq * 4 + t) : 8;
#pragma unroll
                for (int ks = 0; ks < 2; ++ks) aPV[t] = MFMA16(ldfrag_tr(L + ML_VX + (ks * 32) * 304 + tile * 32 + tro304, 304), bq[ks], aPV[t]);
#pragma unroll
                for (int ks = 0; ks < 4; ++ks) aQC[t] = MFMA16(ldfrag(L + ML_CT + (tile * 16 + fr) * 272 + ks * 64 + fq * 16), bq[2 + ks], aQC[t]); }
            const float wi = vb[192 + l], eml = vb[128 + l];
            float den = aPV[4][0] + wi * aQC[4][0];
            den = __shfl(den, fr);
            const float inv = 1.0f / fmaxf(fabsf(den), eml);
            const int tt = j * 64 + l, t = dir ? (SEQ - 1 - tt) : tt; const size_t mrow = (size_t)(b * SEQ + t);
#pragma unroll
            for (int t4 = 0; t4 < 4; ++t4) { const f32x4 nv = (aPV[t4] + aQC[t4] * wi) * inv; v2u o; o.x = pk2(nv[0], nv[1]); o.y = pk2(nv[2], nv[3]);
                *(v2u*)(Hout + mrow * 1024 + (dq * 4 + t4) * 16 + 4 * fq) = o; }
        }
        TP(5);
        {
            const float decay = vb[320];
            bf16x8 ak[2];
#pragma unroll
            for (int ks = 0; ks < 2; ++ks) ak[ks] = ldfrag_tr(L + ML_KW + (ks * 32) * 272 + w * 32 + tro272, 272);
#pragma unroll
            for (int t = 0; t < 9; ++t) { accS[t] = accS[t] * decay;
#pragma unroll
                for (int ks = 0; ks < 2; ++ks) accS[t] = MFMA16(ak[ks], ldfrag_tr(L + ML_VX + (ks * 32) * 304 + t * 32 + tro304, 304), accS[t]); }
        }
        TP(6); WG_BAR(); TP(7);
#pragma unroll
        for (int t = 0; t < 9; ++t) st8(L + ML_CT + (t * 16 + fr) * 272 + (w * 16 + 4 * fq) * 2, accS[t]);
        TP(8);
    }
    TP_SPIN(unit == 0);
    __syncthreads();
#undef ML_GATES
#undef ML_LOADQKV
#undef ML_LOADG
}

constexpr int DN_QS = 0, DN_KD = 34816, DN_KS = 69632, DN_VS = 87040, DN_T1 = 104448, DN_T2 = 113664, DN_AT = 122880, DN_WL = 132096;
constexpr int DN_WREG = 18432;
constexpr int DN_VEC = 149504, DN_VECN = 264;
constexpr size_t WS_TSCR = 501 * MiB;
__device__ __forceinline__ bf16x8 packacc(const f32x4& a, const f32x4& b) { v4u o; o.x = pk2(a[0], a[1]); o.y = pk2(a[2], a[3]); o.z = pk2(b[0], b[1]); o.w = pk2(b[2], b[3]); return __builtin_bit_cast(bf16x8, o); }
__device__ __forceinline__ bf16x8 ldfrag_pk(const LAS unsigned char* p) {
    const s16x4 lo = *(const LAS s16x4*)p, hi = *(const LAS s16x4*)(p + 32); return __builtin_shufflevector(lo, hi, 0, 1, 2, 3, 4, 5, 6, 7); }
__device__ __forceinline__ bf16x8 ldfrag_trp(const LAS unsigned char* p, int RS) {
    const s16x4 lo = __builtin_amdgcn_ds_read_tr16_b64_v4i16((LAS s16x4*)p);
    const s16x4 hi = __builtin_amdgcn_ds_read_tr16_b64_v4i16((LAS s16x4*)(p + 16 * RS));
    return __builtin_shufflevector(lo, hi, 0, 1, 2, 3, 4, 5, 6, 7); }
__device__ __forceinline__ int trofs_p(int fr, int fq, int RS) { return (4 * fq + (fr >> 2)) * RS + 8 * (fr & 3); }
__device__ __forceinline__ void delta_unit(Frame& F, int unit, const float* d_alog, const float* d_dtb) {
    const int tid = F.tid, lane = F.lane, w = F.wave, fr0 = lane & 15, fq0 = lane >> 4;
    const int dir = unit & 1, h = (unit >> 1) & 7, b = unit >> 4;
    LAS unsigned char* L = F.lds;
    LAS float* vec = (LAS float*)(L + DN_VEC);
    f32x4 accS[8];
#pragma unroll
    for (int t = 0; t < 8; ++t) accS[t] = (f32x4){0.f, 0.f, 0.f, 0.f};
    const float* Ga = (const float*)(F.ws + WS_GATES) + 16 + dir * 8 + h; const float* Gb = Ga + 16;
    const bf16* Qg = (const bf16*)(F.ws + WS_DQ) + h * 128; const bf16* Kg = (const bf16*)(F.ws + WS_DK) + h * 128; const bf16* Vg = (const bf16*)(F.ws + WS_DV) + h * 128;
    bf16* Oout = (bf16*)(F.ws + (dir ? WS_ODB : WS_ODF)) + h * 128;
    bf16* Tg = (bf16*)(F.ws + WS_TSCR) + (size_t)unit * (8 * 4096);
    const float Aexp = __expf(d_alog[dir * 8 + h]), dtb = d_dtb[dir * 8 + h];
    const int sr = tid >> 4, sc = tid & 15;
    v4u q[2], k[2], v[2], tT;
#define DN_LOADQKV(jj) do { _Pragma("unroll") for (int p = 0; p < 2; ++p) { const int tt_ = (jj) * 64 + sr + 32 * p, t_ = dir ? (SEQ - 1 - tt_) : tt_; const unsigned ro_ = (unsigned)(b * SEQ + t_) * 2048u + (unsigned)sc * 16u; \
        q[p] = *(const v4u*)((const char*)Qg + ro_); k[p] = *(const v4u*)((const char*)Kg + ro_); v[p] = *(const v4u*)((const char*)Vg + ro_); } \
        tT = __builtin_nontemporal_load((const v4u*)((const char*)Tg + (unsigned)(((jj) & 7) * 8192 + tid * 16))); } while (0)
    TP_DECL
    for (int grp = 0; grp < 4; ++grp) {
        TP(20);
        int fr = fr0, fq = fq0; asm volatile("" : "+v"(fr), "+v"(fq));
        __syncthreads();
        {
            const int c = grp * 8 + w; const int tro144 = trofs(fq * 16 + fr, 144);
            LAS unsigned char* PA = L + w * DN_WREG; LAS unsigned char* XA = PA + 9216; LAS float* gv = vec + w * DN_VECN;
            { const int tt = c * 64 + lane, t = dir ? (SEQ - 1 - tt) : tt; const unsigned go = (unsigned)(b * SEQ + t) * 256u;
              const float ap = *(const float*)((const char*)Ga + go) + dtb, bp = *(const float*)((const char*)Gb + go);
              const float sp = ap > 0.f ? ap + __logf(1.0f + __expf(-ap)) : __logf(1.0f + __expf(ap));
              const float gq = -Aexp * sp, beta = 1.0f / (1.0f + __expf(-bp)), gc = wave_incl_sum(gq), gl = lane63(gc);
              gv[lane] = gc; gv[64 + lane] = beta; gv[128 + lane] = __expf(gc); gv[192 + lane] = __expf(gl - gc); if (lane == 0) gv[256] = __expf(gl); }
            f32x4 accX[4][4];
#pragma unroll
            for (int tb = 0; tb < 4; ++tb)
#pragma unroll
                for (int ta = 0; ta < 4; ++ta) accX[ta][tb] = (f32x4){0.f, 0.f, 0.f, 0.f};
#pragma unroll
            for (int kh = 0; kh < 2; ++kh) {
                bf16x8 kf[4][2];
#pragma unroll
                for (int t4 = 0; t4 < 4; ++t4) { const int tt = c * 64 + t4 * 16 + fr, t = dir ? (SEQ - 1 - tt) : tt; const unsigned ro = (unsigned)(b * SEQ + t) * 2048u + (unsigned)fq * 16u;
#pragma unroll
                    for (int ks = 0; ks < 2; ++ks) kf[t4][ks] = *(const bf16x8*)((const char*)Kg + ro + (kh * 2 + ks) * 64); }
#pragma unroll
                for (int tb = 0; tb < 4; ++tb)
#pragma unroll
                    for (int ta = 0; ta < 4; ++ta) if (ta <= tb) {
#pragma unroll
                        for (int ks = 0; ks < 2; ++ks) accX[ta][tb] = MFMA16(kf[ta][ks], kf[tb][ks], accX[ta][tb]); }
            }
#pragma unroll
            for (int tb = 0; tb < 4; ++tb)
#pragma unroll
                for (int ta = 0; ta < 4; ++ta) {
                    const int bI = tb * 16 + fr, a0 = ta * 16 + 4 * fq;
                    if (ta <= tb) {
                        const f32x4 acc = accX[ta][tb];
                        const float gcb = gv[bI], betab = gv[64 + bI];
                        f32x4 vna, vxa;
#pragma unroll
                        for (int r = 0; r < 4; ++r) { const int aI = a0 + r; const float e = -betab * acc[r] * __expf(fminf(gcb - gv[aI], 0.f));
                            if (ta == tb) { const int dd = (4 * fq + r) - fr; vna[r] = dd < 0 ? e : 0.f; vxa[r] = dd < 0 ? e : (dd == 0 ? 1.0f : 0.f); }
                            else { vna[r] = e; vxa[r] = e; } }
                        accX[ta][tb] = vxa;
                        st8(PA + bI * 144 + a0 * 2, vna); st8(XA + bI * 144 + a0 * 2, vxa);
                    } else { const f32x4 z = (f32x4){0.f, 0.f, 0.f, 0.f}; st8(PA + bI * 144 + a0 * 2, z); st8(XA + bI * 144 + a0 * 2, z); }
                }
#pragma unroll 1
            for (int kk = 1; kk <= 6; ++kk) {
                f32x4 accP[4][4];
                bf16x8 fA[4][2];
#pragma unroll
                for (int ta = 0; ta < 4; ++ta)
#pragma unroll
                    for (int ks = 0; ks < 2; ++ks) if (ks >= (ta >> 1)) fA[ta][ks] = ldfrag_tr(PA + (ks * 32) * 144 + ta * 32 + tro144, 144);
#pragma unroll
                for (int tb = 0; tb < 4; ++tb) {
                    bf16x8 pb[2], xb[2];
#pragma unroll
                    for (int ks = 0; ks < 2; ++ks) if (ks <= (tb >> 1)) { pb[ks] = ldfrag(PA + (tb * 16 + fr) * 144 + ks * 64 + fq * 16); xb[ks] = ldfrag(XA + (tb * 16 + fr) * 144 + ks * 64 + fq * 16); }
#pragma unroll
                    for (int ta = 0; ta < 4; ++ta) if (ta <= tb) {
                        accP[ta][tb] = (f32x4){0.f, 0.f, 0.f, 0.f};
#pragma unroll
                        for (int ks = 0; ks < 2; ++ks) if (ks >= (ta >> 1) && ks <= (tb >> 1)) {
                            if (kk <= 5) accP[ta][tb] = MFMA16(fA[ta][ks], pb[ks], accP[ta][tb]);
                            if (kk >= 2) accX[ta][tb] = MFMA16(fA[ta][ks], xb[ks], accX[ta][tb]); } }
                }
#pragma unroll
                for (int tb = 0; tb < 4; ++tb)
#pragma unroll
                    for (int ta = 0; ta < 4; ++ta) if (ta <= tb) { const int off = (tb * 16 + fr) * 144 + (ta * 16 + 4 * fq) * 2;
                        if (kk <= 5) st8(PA + off, accP[ta][tb]);
                        if (kk >= 2) st8(XA + off, accX[ta][tb]); }
            }
            bf16* Tc = Tg + (size_t)w * 4096;
#pragma unroll
            for (int tb = 0; tb < 4; ++tb)
#pragma unroll
                for (int ta = 0; ta < 4; ++ta) { v2u o; if (ta <= tb) { o.x = pk2(accX[ta][tb][0], accX[ta][tb][1]); o.y = pk2(accX[ta][tb][2], accX[ta][tb][3]); } else { o.x = 0u; o.y = 0u; }
                    *(v2u*)((char*)Tc + (unsigned)(((tb * 16 + fr) * 64 + ta * 16 + 4 * fq) * 2)) = o; }
        }
        __syncthreads();
        DN_LOADQKV(grp * 8);
        TP(21);
        for (int jc = 0; jc < 8; ++jc) {
            TP(22);
            const int j = grp * 8 + jc; asm volatile("" : "+v"(fr), "+v"(fq)); const int tro272 = trofs(fq * 16 + fr, 272);
            LAS float* vb = vec + jc * DN_VECN;
            const int pb = (j & 1) * 17408;
            const int pcA = ((sc >> 2) * 32 + 16 * (sc & 1) + 4 * ((sc >> 1) & 1)) * 2, pcB = pcA + 16;
#pragma unroll
            for (int p = 0; p < 2; ++p) { const int r = sr + 32 * p; const float kds = vb[192 + r];
                *(LAS v2u*)(L + DN_QS + pb + r * 272 + pcA) = (v2u){q[p].x, q[p].y}; *(LAS v2u*)(L + DN_QS + pb + r * 272 + pcB) = (v2u){q[p].z, q[p].w};
                *(LAS v2u*)(L + DN_KS + r * 272 + pcA) = (v2u){k[p].x, k[p].y}; *(LAS v2u*)(L + DN_KS + r * 272 + pcB) = (v2u){k[p].z, k[p].w};
                *(LAS v4u*)(L + DN_KD + pb + r * 272 + sc * 16) = scale8(k[p], kds); *(LAS v4u*)(L + DN_VS + r * 272 + sc * 16) = v[p]; }
            {
                const int tr = tid >> 3, c0 = (tid & 7) * 8; v4u t1, t2;
#pragma unroll
                for (int i = 0; i < 4; ++i) { const float b0 = vb[64 + c0 + 2 * i], b1 = vb[64 + c0 + 2 * i + 1], e0 = vb[128 + c0 + 2 * i], e1 = vb[128 + c0 + 2 * i + 1];
                    const float x0 = bflo(tT[i]) * b0, x1 = bfhi(tT[i]) * b1; t1[i] = pk2(x0, x1); t2[i] = pk2(x0 * e0, x1 * e1); }
                *(LAS v4u*)(L + DN_T1 + tr * 144 + c0 * 2) = t1; *(LAS v4u*)(L + DN_T2 + tr * 144 + c0 * 2) = t2; }
            if (jc + 1 < 8) DN_LOADQKV(j + 1);
            TP(23); WG_BAR(); TP(24);
            f32x4 accU[4];
            {
                const int tb = w & 3, bI = tb * 16 + fr; const float gcb = vb[bI];
#pragma unroll
                for (int x = 0; x < 2; ++x) { const int ta = (w >> 2) * 2 + x, a0 = ta * 16 + 4 * fq;
                    f32x4 acc = (f32x4){0.f, 0.f, 0.f, 0.f};
                    if (ta <= tb) {
#pragma unroll
                        for (int ks = 0; ks < 4; ++ks) acc = MFMA16(ldfrag(L + DN_KS + (ta * 16 + fr) * 272 + ks * 64 + fq * 16), ldfrag(L + DN_QS + pb + bI * 272 + ks * 64 + fq * 16), acc); }
                    f32x4 vat;
#pragma unroll
                    for (int r = 0; r < 4; ++r) { const int aI = a0 + r; const float e = acc[r] * __expf(fminf(gcb - vb[aI], 0.f)); vat[r] = (ta < tb || (ta == tb && 4 * fq + r <= fr)) ? e : 0.f; }
                    st8(L + DN_AT + bI * 144 + ((ta >> 1) * 32 + 8 * fq + 4 * (ta & 1)) * 2, vat); }
                f32x4 accW[4];
#pragma unroll
                for (int lt = 0; lt < 4; ++lt) { accU[lt] = (f32x4){0.f, 0.f, 0.f, 0.f}; accW[lt] = (f32x4){0.f, 0.f, 0.f, 0.f}; }
#pragma unroll
                for (int ks = 0; ks < 2; ++ks) {
                    const bf16x8 vtr = ldfrag_tr(L + DN_VS + (ks * 32) * 272 + w * 32 + tro272, 272), ktr = ldfrag_tr(L + DN_KS + (ks * 32) * 272 + w * 32 + tro272, 272);
#pragma unroll
                    for (int lt = 0; lt < 4; ++lt) if (ks <= (lt >> 1)) {
                        accU[lt] = MFMA16(ldfrag(L + DN_T1 + (lt * 16 + fr) * 144 + ks * 64 + fq * 16), vtr, accU[lt]);
                        accW[lt] = MFMA16(ktr, ldfrag(L + DN_T2 + (lt * 16 + fr) * 144 + ks * 64 + fq * 16), accW[lt]); } }
#pragma unroll
                for (int lt = 0; lt < 4; ++lt) { const f32x4 nw = -accW[lt]; st8(L + DN_WL + (lt * 16 + fr) * 272 + (w * 16 + 4 * fq) * 2, nw); }
            }
            TP(25); WG_BAR(); TP(26);
            {
                bf16x8 sfr[4];
#pragma unroll
                for (int ks = 0; ks < 4; ++ks) sfr[ks] = packacc(accS[2 * ks], accS[2 * ks + 1]);
                const float egl = vb[256];
                const int tgo = (int)((j * 64) ), trp = trofs_p(fr, fq, 272);
                {
                    bf16x8 wf[4][4];
#pragma unroll
                    for (int ks = 0; ks < 4; ++ks)
#pragma unroll
                        for (int lt = 0; lt < 4; ++lt) wf[ks][lt] = ldfrag(L + DN_WL + (lt * 16 + fr) * 272 + ks * 64 + fq * 16);
                    __builtin_amdgcn_sched_barrier(0);
#pragma unroll
                    for (int ks = 0; ks < 4; ++ks)
#pragma unroll
                        for (int lt = 0; lt < 4; ++lt) accU[lt] = MFMA16(wf[ks][lt], sfr[ks], accU[lt]);
                }
                f32x4 aOQ[4];
                {
                    bf16x8 qf[4][4];
#pragma unroll
                    for (int ks = 0; ks < 4; ++ks)
#pragma unroll
                        for (int lt = 0; lt < 4; ++lt) qf[ks][lt] = ldfrag(L + DN_QS + pb + (lt * 16 + fr) * 272 + ks * 64 + fq * 16);
                    __builtin_amdgcn_sched_barrier(0);
#pragma unroll
                    for (int lt = 0; lt < 4; ++lt) aOQ[lt] = (f32x4){0.f, 0.f, 0.f, 0.f};
#pragma unroll
                    for (int ks = 0; ks < 4; ++ks)
#pragma unroll
                        for (int lt = 0; lt < 4; ++lt) aOQ[lt] = MFMA16(sfr[ks], qf[ks][lt], aOQ[lt]);
                }
                bf16x8 vfr[2];
#pragma unroll
                for (int ks = 0; ks < 2; ++ks) vfr[ks] = packacc(accU[2 * ks], accU[2 * ks + 1]);
                {
                    bf16x8 af[2][4], kd[2][8];
#pragma unroll
                    for (int ks = 0; ks < 2; ++ks)
#pragma unroll
                        for (int lt = 0; lt < 4; ++lt) af[ks][lt] = ldfrag(L + DN_AT + (lt * 16 + fr) * 144 + ks * 64 + fq * 16);
#pragma unroll
                    for (int ks = 0; ks < 2; ++ks)
#pragma unroll
                        for (int t8 = 0; t8 < 8; ++t8) kd[ks][t8] = ldfrag_trp(L + DN_KD + pb + (ks * 32) * 272 + t8 * 32 + trp, 272);
                    __builtin_amdgcn_sched_barrier(0);
#pragma unroll
                    for (int lt = 0; lt < 4; ++lt) {
                        f32x4 aOA = (f32x4){0.f, 0.f, 0.f, 0.f};
#pragma unroll
                        for (int ks = 0; ks < 2; ++ks) aOA = MFMA16(vfr[ks], af[ks][lt], aOA);
                        const int l = lt * 16 + fr; const float egl_l = vb[128 + l];
                        const int tt = tgo + l, t = dir ? (SEQ - 1 - tt) : tt; const unsigned oo = (unsigned)(b * SEQ + t) * 2048u + (unsigned)(w * 16 + 4 * fq) * 2u;
                        const f32x4 ov = aOA + aOQ[lt] * egl_l; v2u o; o.x = pk2(ov[0], ov[1]); o.y = pk2(ov[2], ov[3]);
                        *(v2u*)((char*)Oout + oo) = o; }
#pragma unroll
                    for (int t8 = 0; t8 < 8; ++t8) accS[t8] = accS[t8] * egl;
#pragma unroll
                    for (int ks = 0; ks < 2; ++ks)
#pragma unroll
                        for (int t8 = 0; t8 < 8; ++t8) accS[t8] = MFMA16(kd[ks][t8], vfr[ks], accS[t8]);
                }
            }
            TP(30);
        }
    }
    TP_SPIN(unit == 0);
    __syncthreads();
#undef DN_LOADQKV
}

__device__ __forceinline__ void p4_combine(Frame& F, const float* m_ng, const float* d_ng) {
    const int gw = F.vcu * NWAVES + F.wave, NGW = F.G * NWAVES, lane = F.lane;
    const bf16* PROJ = (const bf16*)(F.ws + WS_PROJ);
    const bf16* HMf = (const bf16*)(F.ws + WS_HM); const bf16* HMb = HMf + (size_t)MROWS * 1024;
    const bf16* ODf = (const bf16*)(F.ws + WS_ODF); const bf16* ODb = (const bf16*)(F.ws + WS_ODB);
    bf16* YM = (bf16*)(F.ws + WS_YM); bf16* YD = (bf16*)(F.ws + WS_YD);
    for (int m = gw; m < MROWS; m += NGW) {
        v2u hf[4], hb[4], mo[4]; unsigned of[8], ob[8], dz[8];
#pragma unroll
        for (int h = 0; h < 4; ++h) { hf[h] = *(const v2u*)(HMf + (size_t)m * 1024 + h * 256 + 4 * lane); hb[h] = *(const v2u*)(HMb + (size_t)m * 1024 + h * 256 + 4 * lane);
            mo[h] = *(const v2u*)(PROJ + (size_t)(8 + h) * BLK + (size_t)m * 256 + 4 * lane); }
#pragma unroll
        for (int h = 0; h < 8; ++h) { of[h] = *(const unsigned*)(ODf + (size_t)m * 1024 + h * 128 + 2 * lane); ob[h] = *(const unsigned*)(ODb + (size_t)m * 1024 + h * 128 + 2 * lane);
            dz[h] = *(const unsigned*)(PROJ + (size_t)(24 + (h >> 1)) * BLK + (size_t)m * 256 + (h & 1) * 128 + 2 * lane); }
#pragma unroll
        for (int h = 0; h < 4; ++h) {
            const float a0 = bflo(hf[h].x) + bflo(hb[h].x), a1 = bfhi(hf[h].x) + bfhi(hb[h].x), a2 = bflo(hf[h].y) + bflo(hb[h].y), a3 = bfhi(hf[h].y) + bfhi(hb[h].y);
            const float ss = wave_sum((a0 * a0 + a1 * a1) + (a2 * a2 + a3 * a3));
            const float r = 1.0f / sqrtf(ss * (1.f / 256.f) + RMS_EPS);
            const f32x4 g = *(const f32x4*)(m_ng + h * 256 + 4 * lane);
            const float o0 = bflo(mo[h].x), o1 = bfhi(mo[h].x), o2 = bflo(mo[h].y), o3 = bfhi(mo[h].y);
            v2u y; y.x = pk2(a0 * r * g.x / (1.f + expf(-o0)), a1 * r * g.y / (1.f + expf(-o1))); y.y = pk2(a2 * r * g.z / (1.f + expf(-o2)), a3 * r * g.w / (1.f + expf(-o3)));
            *(v2u*)(YM + (size_t)m * 1024 + h * 256 + 4 * lane) = y;
        }
        const float g0 = d_ng[2 * lane], g1 = d_ng[2 * lane + 1];
#pragma unroll
        for (int h = 0; h < 8; ++h) {
            const float a0 = bflo(of[h]) + bflo(ob[h]), a1 = bfhi(of[h]) + bfhi(ob[h]);
            const float ss = wave_sum(a0 * a0 + a1 * a1);
            const float r = 1.0f / sqrtf(ss * (1.f / 128.f) + RMS_EPS);
            const float z0 = bflo(dz[h]), z1 = bfhi(dz[h]);
            *(unsigned*)(YD + (size_t)m * 1024 + h * 128 + 2 * lane) = pk2(a0 * r * g0 * z0 / (1.f + expf(-z0)), a1 * r * g1 * z1 / (1.f + expf(-z1)));
        }
    }
}

__device__ __forceinline__ void p7_norm2(Frame& F, const float* n2g, const float* w_ff1, const float* w_ff2) {
    LAS float* scr = (LAS float*)(F.lds + F.wave * TR_SCR);
    const int gw = F.vcu * NWAVES + F.wave, NGW = F.G * NWAVES;
    bf16* W1T = (bf16*)(F.ws + WS_W1T); bf16* W2T = (bf16*)(F.ws + WS_W2T); bf16* XN2 = (bf16*)(F.ws + WS_XN2);
    constexpr int I_1 = (DM / 64) * (DFF / 64), I_2 = (DFF / 64) * (DM / 64);
    for (int it = gw; it < I_1 + I_2; it += NGW) {
        if (it < I_1) tr_item(w_ff1, DM, DFF, W1T, scr, it, F.lane, false); else tr_item(w_ff2, DFF, DM, W2T, scr, it - I_1, F.lane, false);
    }
    for (int m = gw; m < MROWS; m += NGW) rms_row_bf16(F.lane, F.out + (size_t)m * DM, n2g, XN2 + (size_t)m * DM);
}
__device__ __forceinline__ void p10_final(Frame& F, const float* nfg) {
    const int gw = F.vcu * NWAVES + F.wave, NGW = F.G * NWAVES;
    for (int m = gw; m < MROWS; m += NGW) rms_row_f32(F.lane, F.out + (size_t)m * DM, nfg, F.out + (size_t)m * DM);
}
struct Args { const float* in[17]; float* out; unsigned char* ws; int ph_lo, ph_hi, li, pad; };
__global__ void __launch_bounds__(NWAVES * 64, 2) hybrid_fwd(Args args) {
    extern __shared__ __attribute__((aligned(16))) unsigned char lds[];
    Frame F;
    F.lds = (LAS unsigned char*)lds;
    F.MISC = (volatile LAS unsigned*)(F.lds + MISC_OFF);
    F.tid = threadIdx.x; F.lane = F.tid & 63; F.wave = __builtin_amdgcn_readfirstlane(F.tid >> 6);
    F.G = gridDim.x; { const int bx = blockIdx.x; F.vcu = (F.G % 8 == 0) ? (bx % 8) * (F.G / 8) + bx / 8 : bx; }
    F.ws = args.ws; F.ctl = (gu32*)(args.ws + WS_CTL);
    F.out = args.out;
    if (F.tid < 64) ((LAS unsigned*)(F.lds + MISC_OFF))[F.tid] = 0u;
    __syncthreads();
    XcdBarrier bar; bar.bar = (unsigned*)(F.ctl + CW_BAR); bar.x = 0; bar.st = nullptr;
    if (N_LAUNCHES != PER_PHASE) bar = xcd_barrier_post((unsigned*)(F.ctl + CW_BAR), F.MISC + 8);
#define GRID_BAR() do { if (N_LAUNCHES != PER_PHASE) xcd_barrier(bar); } while (0)
    const int lo = args.ph_lo, hi = args.ph_hi;
#ifndef PHASE_MASK
#define PHASE_MASK 0x7ff
#endif
#define IN(k) (((PHASE_MASK >> (k)) & 1) && lo <= (k) && (k) < hi)
#define BOTH(k) (IN(k) && IN((k) + 1))
    bf16* PROJ = (bf16*)(F.ws + WS_PROJ);

    if (IN(0)) { p0_prologue(F, args.in[0], args.in[1], args.in[2], args.in[10], args.in[11], args.in[12]); if (BOTH(0)) GRID_BAR(); }
    if (IN(1)) {
        pg8::Gemm g{(const bf16*)(F.ws + WS_XN), (const bf16*)(F.ws + WS_WIN), MROWS, NPROJ_PAD, DM}; pg8::StaticOrder S; S.init(MROWS, NPROJ_PAD, F.G, (int)blockIdx.x);
        pg8::EpiProj E{PROJ, (float*)(F.ws + WS_GATES)};
        pg8::gemm_phase<pg8::EpiProj, pg8::StaticOrder, true, true>(F.lds, g, S, E);
        if (BOTH(1)) GRID_BAR();
    }
    if (IN(2)) { p2_conv(F, args.in[6]); if (BOTH(2)) GRID_BAR(); }
    if (IN(3)) {
        const int u = F.vcu;
        if (u < 128) { if (args.pad != 2) mlstm_unit(F, u, args.in[3], args.in[4]); }
        else if (u < 256) { if (args.pad != 1) delta_unit(F, u - 128, args.in[7], args.in[8]); }
        if (BOTH(3)) GRID_BAR();
    }
    if (IN(4)) { p4_combine(F, args.in[5], args.in[9]); if (BOTH(4)) GRID_BAR(); }
    if (IN(5)) {
        pg8::Gemm g{(const bf16*)(F.ws + WS_YM), (const bf16*)(F.ws + WS_WBM), 2 * MROWS, 4096, 1024}; pg8::BranchOrder S; S.init(F.G, (int)blockIdx.x);
        pg8::EpiBranch E{PROJ, (bf16*)(F.ws + WS_MIX)};
        pg8::gemm_phase<pg8::EpiBranch, pg8::BranchOrder, true, true>(F.lds, g, S, E);
        if (BOTH(5)) GRID_BAR();
    }
    if (IN(6)) {
        pg8::Gemm g{(const bf16*)(F.ws + WS_MIX), (const bf16*)(F.ws + WS_WOUT), MROWS, DM, DM}; pg8::StaticOrder S; S.init(MROWS, DM, F.G, (int)blockIdx.x);
        pg8::EpiResid E{args.in[0], F.out, DM};
        pg8::gemm_phase<pg8::EpiResid, pg8::StaticOrder, true, true>(F.lds, g, S, E);
        if (BOTH(6)) GRID_BAR();
    }
    if (IN(7)) { p7_norm2(F, args.in[13], args.in[14], args.in[15]); if (BOTH(7)) GRID_BAR(); }
    if (IN(8)) {
        pg8::Gemm g{(const bf16*)(F.ws + WS_XN2), (const bf16*)(F.ws + WS_W1T), MROWS, DFF, DM}; pg8::StaticOrder S; S.init(MROWS, DFF, F.G, (int)blockIdx.x);
        pg8::EpiRelu2 E{(bf16*)(F.ws + WS_HFF), DFF};
        pg8::gemm_phase<pg8::EpiRelu2, pg8::StaticOrder, true, true>(F.lds, g, S, E);
        if (BOTH(8)) GRID_BAR();
    }
    if (IN(9)) {
        pg8::Gemm g{(const bf16*)(F.ws + WS_HFF), (const bf16*)(F.ws + WS_W2T), MROWS, DM, DFF}; pg8::StaticOrder S; S.init(MROWS, DM, F.G, (int)blockIdx.x);
        pg8::EpiResid E{F.out, F.out, DM};
        pg8::gemm_phase<pg8::EpiResid, pg8::StaticOrder, true, true>(F.lds, g, S, E);
        if (BOTH(9)) GRID_BAR();
    }
    if (IN(10)) { p10_final(F, args.in[16]); }
#undef IN
#undef BOTH
}

extern "C" void kernel_launch(void* const* d_in, const int* in_sizes, int n_in, void* d_out, int out_size, void* d_ws, size_t ws_size, hipStream_t stream) {
    static int grid = 0;
    if (grid == 0) {
        if (n_in != 17 || in_sizes[0] != MROWS * DM || out_size != MROWS * DM || ws_size < WS_END) {
            fprintf(stderr, "kernel_launch: unexpected problem: n_in %d, in0 %d, out %d, ws %zu (need %zu); nothing launched\n", n_in, n_in > 0 ? in_sizes[0] : -1, out_size, ws_size, (size_t)WS_END); grid = -1; return; }
        int dev = 0, cus = 0, per_cu = 0;
        if (hipGetDevice(&dev) != hipSuccess || hipDeviceGetAttribute(&cus, hipDeviceAttributeMultiprocessorCount, dev) != hipSuccess) { fprintf(stderr, "kernel_launch: device query failed\n"); grid = -1; return; }
        if (hipFuncSetAttribute((const void*)hybrid_fwd, hipFuncAttributeMaxDynamicSharedMemorySize, LDS_BYTES) != hipSuccess) { fprintf(stderr, "kernel_launch: hipFuncSetAttribute failed\n"); grid = -1; return; }
        if (hipOccupancyMaxActiveBlocksPerMultiprocessor(&per_cu, (const void*)hybrid_fwd, NWAVES * 64, LDS_BYTES) != hipSuccess || per_cu < 1)
            fprintf(stderr, "kernel_launch: note: occupancy query reports %d workgroups per CU\n", per_cu);
        (void)hipGetLastError();
        grid = cus;
    }
    if (grid < 0) return;
    if (hipMemsetAsync((char*)d_ws + WS_CTL, 0, CTL_ZERO_BYTES, stream) != hipSuccess) { fprintf(stderr, "kernel_launch: memset failed\n"); return; }
    Args a{};
    for (int i = 0; i < 17; ++i) a.in[i] = (const float*)d_in[i];
    a.out = (float*)d_out; a.ws = (unsigned char*)d_ws;
#ifdef PROBE_PH
    const int nl = 2; const int plo[2] = {0, PROBE_PH}, phi[2] = {PROBE_PH + 1, PER_PHASE};
#else
    const int nl = N_LAUNCHES; const int plo[2] = {0, 0}, phi[2] = {PER_PHASE, PER_PHASE};
#endif
    for (int li = 0; li < nl; ++li) {
        if (li > 0 && N_LAUNCHES != PER_PHASE) (void)hipMemsetAsync((char*)d_ws + WS_CTL, 0, CTL_ZERO_BYTES, stream);
#ifdef PROBE_SKIP
        a.pad = (li == 1) ? PROBE_SKIP : 0;
#endif
        a.ph_lo = (N_LAUNCHES == PER_PHASE) ? li : plo[li & 1]; a.ph_hi = (N_LAUNCHES == PER_PHASE) ? li + 1 : phi[li & 1]; a.li = li;
        hipLaunchKernelGGL(hybrid_fwd, dim3(grid), dim3(NWAVES * 64), LDS_BYTES, stream, a);
        const hipError_t le = hipPeekAtLastError();
        if (le != hipSuccess) { fprintf(stderr, "kernel_launch: launch %d failed: %s\n", li, hipGetErrorName(le)); break; }
    }
}
```

```cpp
#include <hip/hip_runtime.h>
#include <cstdio>
#include <cstdint>

#ifndef MK_N_LAUNCHES
#define MK_N_LAUNCHES 1
#endif
constexpr int MROWS = 16384;
namespace pg8 {
#define PG8_LAS __attribute__((address_space(3)))
typedef unsigned short bf16_t;
typedef short bf16x8 __attribute__((ext_vector_type(8)));
typedef float f32x4 __attribute__((ext_vector_type(4)));
typedef unsigned u32x4 __attribute__((ext_vector_type(4)));
constexpr int BM = 256, BK = 64, HALF = 128, HTB = HALF * BK * 2  , STAGE_BYTES = 8 * HTB, NXCD = 8, WGM = 8;

__host__ __device__ __forceinline__ int lds_byte(int r, int c) { const int st = (r >> 4) * 2 + (c >> 5), rr = r & 15, cc = c & 31, ob = rr * 64 + cc * 2; return st * 1024 + (ob ^ (((ob >> 9) & 1) << 5)); }
__host__ __device__ __forceinline__ void stage_rc(int b, int& R, int& C) { const int st = b / 1024, sb = b % 1024, swz = sb ^ (((sb >> 9) & 1) << 5); R = (st >> 1) * 16 + swz / 64; C = (st & 1) * 32 + (swz % 64) / 2; }
__host__ __device__ __forceinline__ int perm32(int rho) { const int n = rho >> 4, i = rho & 15; return 8 * (i >> 2) + 4 * n + (i & 3); }

struct Unit { int pm, pn; };
struct Gemm { const bf16_t* A; const bf16_t* Bt; int M, N, K; };

struct StaticOrder {
    int nM, nN, nwg, G, c;
    __host__ __device__ void init(int M, int N, int G_, int c_) { nM = M / BM; nN = N / BM; nwg = nM * nN; G = G_; c = c_; }
    __host__ __device__ bool next(int i, Unit& u) const {
        const long L = (long)i * G + c; if (L >= nwg) return false;
        int wgid = (int)L; { const int q = nwg / NXCD, r = nwg % NXCD, xcd = wgid % NXCD, off = wgid / NXCD; wgid = (xcd < r ? xcd * (q + 1) : r * (q + 1) + (xcd - r) * q) + off; }
        const int nig = WGM * nN, gid = wgid / nig, fm = gid * WGM, gsz = (nM - fm) < WGM ? (nM - fm) : WGM;
        u.pm = fm + ((wgid % nig) % gsz); u.pn = (wgid % nig) / gsz; return true;
    }
    __device__ __forceinline__ void a_ready(const Unit&) const {}
    __device__ __forceinline__ void done(const Unit&) const {}
};

__device__ __forceinline__ unsigned cvt_pk_bf16(float lo, float hi) { unsigned r; asm volatile("v_cvt_pk_bf16_f32 %0, %1, %2" : "=v"(r) : "v"(lo), "v"(hi)); return r; }
typedef float f32x2 __attribute__((ext_vector_type(2)));
typedef unsigned u32x2 __attribute__((ext_vector_type(2)));
__device__ __forceinline__ float bf_lo(unsigned w) { return __uint_as_float(w << 16); }
__device__ __forceinline__ float bf_hi(unsigned w) { return __uint_as_float(w & 0xffff0000u); }
__device__ __forceinline__ float fsigmoid(float x) { return __builtin_amdgcn_rcpf(1.0f + __expf(-x)); }

struct EpiProj {
    static constexpr bool PERM = true, AFTER_DRAIN = false;
    bf16_t* P; float* gates;
    __device__ __forceinline__ void operator()(const f32x4 (&acc)[2][2][4][2], const Unit& u, int wr, int wc, int fr, int fq) const {
        const int row0 = u.pm * BM + wr * 64 + fr;
        if (u.pn < 44) {
            bf16_t* base = P + (size_t)u.pn * ((size_t)MROWS * 256) + wc * 32 + 8 * fq;
#pragma unroll
            for (int ai = 0; ai < 2; ++ai)
#pragma unroll
                for (int m = 0; m < 4; ++m) { bf16_t* rowp = base + (size_t)(row0 + ai * HALF + m * 16) * 256;
#pragma unroll
                    for (int bj = 0; bj < 2; ++bj) { const f32x4 v0 = acc[ai][bj][m][0], v1 = acc[ai][bj][m][1];
                        u32x4 w; w.x = cvt_pk_bf16(v0[0], v0[1]); w.y = cvt_pk_bf16(v0[2], v0[3]); w.z = cvt_pk_bf16(v1[0], v1[1]); w.w = cvt_pk_bf16(v1[2], v1[3]);
                        *(u32x4*)(rowp + bj * HALF) = w; } }
        } else if (wc < 2) {
#pragma unroll
            for (int ai = 0; ai < 2; ++ai)
#pragma unroll
                for (int m = 0; m < 4; ++m) { float* rp = gates + (size_t)(row0 + ai * HALF + m * 16) * 64 + wc * 32 + 8 * fq;
                    *(f32x4*)rp = acc[ai][0][m][0]; *(f32x4*)(rp + 4) = acc[ai][0][m][1]; }
        }
    }
};

struct EpiBranch {
    static constexpr bool PERM = true, AFTER_DRAIN = false;
    const bf16_t* G; bf16_t* O;
    __device__ __forceinline__ void operator()(const f32x4 (&acc)[2][2][4][2], const Unit& u, int wr, int wc, int fr, int fq) const {
        const int br = u.pn >> 3, pn = u.pn & 7, pm = u.pm & 63;
        const int row0 = pm * BM + wr * 64 + fr, cl = wc * 32 + 8 * fq;
        const bf16_t* gbase = G + (size_t)(28 + 8 * br + pn) * ((size_t)MROWS * 256) + cl;
        bf16_t* obase = O + pn * 256 + cl;
#pragma unroll
        for (int ai = 0; ai < 2; ++ai)
#pragma unroll
            for (int m = 0; m < 4; ++m) { const size_t r = (size_t)(row0 + ai * HALF + m * 16);
#pragma unroll
                for (int bj = 0; bj < 2; ++bj) {
                    const u32x4 gv = *(const u32x4*)(gbase + r * 256 + bj * HALF);
                    const f32x4 a0 = acc[ai][bj][m][0], a1 = acc[ai][bj][m][1];
                    float v[8];
                    v[0] = a0[0] * fsigmoid(bf_lo(gv.x)); v[1] = a0[1] * fsigmoid(bf_hi(gv.x)); v[2] = a0[2] * fsigmoid(bf_lo(gv.y)); v[3] = a0[3] * fsigmoid(bf_hi(gv.y));
                    v[4] = a1[0] * fsigmoid(bf_lo(gv.z)); v[5] = a1[1] * fsigmoid(bf_hi(gv.z)); v[6] = a1[2] * fsigmoid(bf_lo(gv.w)); v[7] = a1[3] * fsigmoid(bf_hi(gv.w));
                    bf16_t* op = obase + r * 2048 + bj * HALF;
                    if (br) { const u32x4 pv = *(const u32x4*)op;
                        v[0] += bf_lo(pv.x); v[1] += bf_hi(pv.x); v[2] += bf_lo(pv.y); v[3] += bf_hi(pv.y); v[4] += bf_lo(pv.z); v[5] += bf_hi(pv.z); v[6] += bf_lo(pv.w); v[7] += bf_hi(pv.w); }
                    u32x4 w; w.x = cvt_pk_bf16(v[0], v[1]); w.y = cvt_pk_bf16(v[2], v[3]); w.z = cvt_pk_bf16(v[4], v[5]); w.w = cvt_pk_bf16(v[6], v[7]);
                    *(u32x4*)op = w; } }
    }
};
struct BranchOrder {
    StaticOrder so;
    __host__ __device__ void init(int G_, int c_) { so.init(MROWS, 2048, G_, c_); }
    __host__ __device__ bool next(int i, Unit& u) const { Unit t; if (!so.next(i >> 1, t)) return false; const int br = i & 1; u.pm = t.pm + 64 * br; u.pn = t.pn + 8 * br; return true; }
    __device__ __forceinline__ void a_ready(const Unit&) const {}
    __device__ __forceinline__ void done(const Unit&) const {}
};

struct EpiResid {
    static constexpr bool PERM = false, AFTER_DRAIN = false;
    const float* base; float* out; int ldc;
    __device__ __forceinline__ void operator()(const f32x4 (&acc)[2][2][4][2], const Unit& u, int wr, int wc, int fr, int fq) const {
        const int col0 = u.pn * BM + wc * 32 + 4 * fq;
#pragma unroll
        for (int ai = 0; ai < 2; ++ai)
#pragma unroll
            for (int m = 0; m < 4; ++m) { const size_t off = (size_t)(u.pm * BM + ai * HALF + wr * 64 + m * 16 + fr) * ldc + col0;
#pragma unroll
                for (int bj = 0; bj < 2; ++bj)
#pragma unroll
                    for (int n = 0; n < 2; ++n) { const f32x4 bs = *(const f32x4*)(base + off + bj * HALF + n * 16); *(f32x4*)(out + off + bj * HALF + n * 16) = bs + acc[ai][bj][m][n]; } }
    }
};

struct EpiRelu2 {
    static constexpr bool PERM = true, AFTER_DRAIN = false;
    bf16_t* O; int ldc;
    __device__ __forceinline__ void operator()(const f32x4 (&acc)[2][2][4][2], const Unit& u, int wr, int wc, int fr, int fq) const {
        const int row0 = u.pm * BM + wr * 64 + fr, col0 = u.pn * BM + wc * 32 + 8 * fq;
#pragma unroll
        for (int ai = 0; ai < 2; ++ai)
#pragma unroll
            for (int m = 0; m < 4; ++m) { bf16_t* rowp = O + (size_t)(row0 + ai * HALF + m * 16) * ldc + col0;
#pragma unroll
                for (int bj = 0; bj < 2; ++bj) { f32x4 v0 = acc[ai][bj][m][0], v1 = acc[ai][bj][m][1];
#pragma unroll
                    for (int e = 0; e < 4; ++e) { const float a = fmaxf(v0[e], 0.f), b = fmaxf(v1[e], 0.f); v0[e] = a * a; v1[e] = b * b; }
                    u32x4 w; w.x = cvt_pk_bf16(v0[0], v0[1]); w.y = cvt_pk_bf16(v0[2], v0[3]); w.z = cvt_pk_bf16(v1[0], v1[1]); w.w = cvt_pk_bf16(v1[2], v1[3]);
                    *(u32x4*)(rowp + bj * HALF) = w; } }
    }
};
template <class Epi, class Sched, bool ALIGN_EPI = false, bool SP2 = false>
__device__ __forceinline__ void gemm_phase(PG8_LAS unsigned char* lds, const Gemm g, const Sched& S, const Epi& E) {
    const int tid = threadIdx.x, wid = __builtin_amdgcn_readfirstlane(tid >> 6), lane = tid & 63, wr = wid >> 2, wc = wid & 3, fr = lane & 15, fq = lane >> 4;
    const int K = g.K, nt = K / BK;
    unsigned voffA[2], voffB[2];
#pragma unroll
    for (int i = 0; i < 2; ++i) { int R, C; stage_rc(tid * 16 + i * 8192, R, C); const int Rb = Epi::PERM ? ((R & ~31) + perm32(R & 31)) : R;
        voffA[i] = (unsigned)(R * K + C) * 2u; voffB[i] = (unsigned)(Rb * K + C) * 2u; }
    const size_t kstep = (size_t)(BK * 2);
    const size_t hstep = (size_t)HALF * K * 2;
    const size_t tstep = 2 * hstep;
    const unsigned ldsw = (unsigned)wid * 1024u;
    const int aoff = lds_byte(wr * 64 + fr, fq * 8), boff = lds_byte(wc * 32 + fr, fq * 8);
#define PG8_SA(b, h) (((b) * 2 + (h)) * HTB)
#define PG8_SB(b, h) ((4 + (b) * 2 + (h)) * HTB)
#define PG8_STAGE(bufoff, gbase, voff) do { _Pragma("unroll") for (int _i = 0; _i < 2; ++_i) \
        __builtin_amdgcn_global_load_lds((const unsigned*)((const char*)(gbase) + (voff)[_i]), (PG8_LAS unsigned*)(lds + (bufoff) + ldsw + _i * 8192), 16, 0, 0); } while (0)
#define PG8_LDA(dst, b, h) do { _Pragma("unroll") for (int m = 0; m < 4; ++m) _Pragma("unroll") for (int k = 0; k < 2; ++k) dst[m][k] = *(const PG8_LAS bf16x8*)(lds + PG8_SA(b, h) + aoff + m * 2048 + k * 1024); } while (0)
#define PG8_LDB(dst, b, h) do { _Pragma("unroll") for (int n = 0; n < 2; ++n) _Pragma("unroll") for (int k = 0; k < 2; ++k) dst[n][k] = *(const PG8_LAS bf16x8*)(lds + PG8_SB(b, h) + boff + n * 2048 + k * 1024); } while (0)
#define PG8_MMA(ai, bj, At, Bt) do { __builtin_amdgcn_s_setprio(1); _Pragma("unroll") for (int m = 0; m < 4; ++m) _Pragma("unroll") for (int n = 0; n < 2; ++n) _Pragma("unroll") for (int k = 0; k < 2; ++k) \
        acc[ai][bj][m][n] = __builtin_amdgcn_mfma_f32_16x16x32_bf16(Bt[n][k], At[m][k], acc[ai][bj][m][n], 0, 0, 0); __builtin_amdgcn_s_setprio(0); } while (0)
#define PG8_WAIT_V(n) asm volatile("s_waitcnt vmcnt(" #n ")" ::: "memory")
#define PG8_WAIT_L(n) asm volatile("s_waitcnt lgkmcnt(" #n ")" ::: "memory")
#define PG8_BAR __builtin_amdgcn_s_barrier()
#define PG8_SCHED __builtin_amdgcn_sched_barrier(0)
    Unit cur, nxt; int ui = 0;
    if (!S.next(0, cur)) return;
    f32x4 acc[2][2][4][2];
#pragma unroll
    for (int a = 0; a < 2; ++a)
#pragma unroll
        for (int b = 0; b < 2; ++b)
#pragma unroll
            for (int m = 0; m < 4; ++m)
#pragma unroll
                for (int n = 0; n < 2; ++n) acc[a][b][m][n] = (f32x4){0.f, 0.f, 0.f, 0.f};
    bf16x8 At[4][2], B0[2][2], B1[2][2];
    const char* cA = (const char*)g.A + (size_t)cur.pm * tstep; const char* cB = (const char*)g.Bt + (size_t)cur.pn * tstep;
    S.a_ready(cur);
    if constexpr (SP2) {
        PG8_STAGE(PG8_SB(0, 0), cB, voffB); PG8_STAGE(PG8_SB(0, 1), cB + hstep, voffB); PG8_STAGE(PG8_SA(0, 0), cA, voffA); PG8_STAGE(PG8_SA(0, 1), cA + hstep, voffA);
        if (wr == 1) PG8_BAR;
        PG8_WAIT_V(2); PG8_BAR;
        PG8_STAGE(PG8_SB(1, 0), cB + kstep, voffB); PG8_STAGE(PG8_SA(1, 0), cA + kstep, voffA); PG8_STAGE(PG8_SB(1, 1), cB + hstep + kstep, voffB);
        PG8_WAIT_V(6); PG8_BAR;
    } else {
        PG8_STAGE(PG8_SB(0, 0), cB, voffB); PG8_STAGE(PG8_SA(0, 0), cA, voffA); PG8_STAGE(PG8_SB(0, 1), cB + hstep, voffB); PG8_STAGE(PG8_SA(0, 1), cA + hstep, voffA);
        if (wr == 1) PG8_BAR;
        PG8_WAIT_V(4); PG8_BAR;
        PG8_STAGE(PG8_SB(1, 0), cB + kstep, voffB); PG8_STAGE(PG8_SA(1, 0), cA + kstep, voffA); PG8_STAGE(PG8_SB(1, 1), cB + hstep + kstep, voffB);
        PG8_WAIT_V(6); PG8_BAR;
    }
    for (;;) {
        const bool has_next = S.next(ui + 1, nxt);
        const char* nA = has_next ? (const char*)g.A + (size_t)nxt.pm * tstep : cA; const char* nB = has_next ? (const char*)g.Bt + (size_t)nxt.pn * tstep : cB;
        for (int t = 0; t < nt; t += 2) {
            const bool last = (t == nt - 2);
            const char* a1 = cA + (size_t)(t + 1) * kstep;
            const char* a2 = last ? nA : cA + (size_t)(t + 2) * kstep; const char* b2 = last ? nB : cB + (size_t)(t + 2) * kstep;
            const char* a3 = a2 + kstep; const char* b3 = b2 + kstep;
            if (last && has_next) S.a_ready(nxt);
            if constexpr (SP2) {
            PG8_LDB(B0, 0, 0); PG8_LDB(B1, 0, 1); PG8_SCHED; PG8_LDA(At, 0, 0); PG8_STAGE(PG8_SA(1, 1), a1 + hstep, voffA);
            PG8_WAIT_V(8); PG8_WAIT_L(0); PG8_BAR; PG8_MMA(0, 0, At, B0); PG8_MMA(0, 1, At, B1); PG8_BAR; PG8_SCHED;
            PG8_LDA(At, 0, 1); PG8_STAGE(PG8_SB(0, 0), b2, voffB); PG8_STAGE(PG8_SB(0, 1), b2 + hstep, voffB); PG8_STAGE(PG8_SA(0, 0), a2, voffA);
            PG8_WAIT_V(8); PG8_WAIT_L(0); PG8_BAR; PG8_MMA(1, 0, At, B0); PG8_MMA(1, 1, At, B1); PG8_BAR; PG8_SCHED;
            PG8_LDB(B0, 1, 0); PG8_LDB(B1, 1, 1); PG8_SCHED; PG8_LDA(At, 1, 0); PG8_STAGE(PG8_SA(0, 1), a2 + hstep, voffA);
            PG8_WAIT_V(8); PG8_WAIT_L(0); PG8_BAR; PG8_MMA(0, 0, At, B0); PG8_MMA(0, 1, At, B1); PG8_BAR; PG8_SCHED;
            PG8_LDA(At, 1, 1); PG8_STAGE(PG8_SB(1, 0), b3, voffB); PG8_STAGE(PG8_SB(1, 1), b3 + hstep, voffB); PG8_STAGE(PG8_SA(1, 0), a3, voffA);
            PG8_WAIT_V(8); PG8_WAIT_L(0); PG8_BAR; PG8_MMA(1, 0, At, B0); PG8_MMA(1, 1, At, B1); PG8_BAR; PG8_SCHED;
            } else {
            PG8_LDB(B0, 0, 0); PG8_SCHED; PG8_LDA(At, 0, 0); PG8_STAGE(PG8_SA(1, 1), a1 + hstep, voffA);
            PG8_WAIT_L(8); PG8_BAR; PG8_WAIT_L(0); PG8_MMA(0, 0, At, B0); PG8_BAR; PG8_SCHED;
            PG8_LDB(B1, 0, 1); PG8_STAGE(PG8_SB(0, 0), b2, voffB);
            PG8_BAR; PG8_WAIT_L(0); PG8_MMA(0, 1, At, B1); PG8_BAR;
            PG8_LDA(At, 0, 1); PG8_STAGE(PG8_SA(0, 0), a2, voffA);
            PG8_BAR; PG8_WAIT_L(0); PG8_MMA(1, 0, At, B0); PG8_BAR; PG8_SCHED;
            PG8_STAGE(PG8_SB(0, 1), b2 + hstep, voffB);
            PG8_WAIT_V(6); PG8_BAR; PG8_MMA(1, 1, At, B1); PG8_BAR;
            PG8_LDB(B0, 1, 0); PG8_SCHED; PG8_LDA(At, 1, 0); PG8_STAGE(PG8_SA(0, 1), a2 + hstep, voffA);
            PG8_WAIT_L(8); PG8_BAR; PG8_WAIT_L(0); PG8_MMA(0, 0, At, B0); PG8_BAR; PG8_SCHED;
            PG8_LDB(B1, 1, 1); PG8_STAGE(PG8_SB(1, 0), b3, voffB);
            PG8_BAR; PG8_WAIT_L(0); PG8_MMA(0, 1, At, B1); PG8_BAR;
            PG8_LDA(At, 1, 1); PG8_STAGE(PG8_SA(1, 0), a3, voffA);
            PG8_BAR; PG8_WAIT_L(0); PG8_MMA(1, 0, At, B0); PG8_BAR; PG8_SCHED;
            PG8_STAGE(PG8_SB(1, 1), b3 + hstep, voffB);
            PG8_WAIT_V(6); PG8_BAR; PG8_MMA(1, 1, At, B1); PG8_BAR;
            }
        }
        if constexpr (ALIGN_EPI) { if (wr == 0) PG8_BAR; }
        if constexpr (!Epi::AFTER_DRAIN) { E(acc, cur, wr, wc, fr, fq); S.done(cur); }
        if (!has_next) break;
#pragma unroll
        for (int a = 0; a < 2; ++a)
#pragma unroll
            for (int b = 0; b < 2; ++b)
#pragma unroll
                for (int m = 0; m < 4; ++m)
#pragma unroll
                    for (int n = 0; n < 2; ++n) acc[a][b][m][n] = (f32x4){0.f, 0.f, 0.f, 0.f};
        cur = nxt; cA = nA; cB = nB; ++ui;
        if constexpr (ALIGN_EPI) { if (wr == 1) PG8_BAR; }
    }
    PG8_WAIT_V(0);
    if constexpr (!ALIGN_EPI) { if (wr == 0) PG8_BAR; }
    PG8_BAR;
    if constexpr (Epi::AFTER_DRAIN) { E.fused(acc, cur, wr, wc, fr, fq, lds, wid, lane); S.done(cur); }
#undef PG8_SA
#undef PG8_SB
#undef PG8_STAGE
#undef PG8_LDA
#undef PG8_LDB
#undef PG8_MMA
#undef PG8_WAIT_V
#undef PG8_WAIT_L
#undef PG8_BAR
#undef PG8_SCHED
}
}
constexpr int NWAVES = 8;
constexpr int N_LAUNCHES = MK_N_LAUNCHES;
constexpr int PER_PHASE = 11;
constexpr int SEQ = 2048, DM = 2048, DFF = 8192, NPROJ_IN = 11312, NPROJ_PAD = 11520;
constexpr float RMS_EPS = 1e-6f;
constexpr size_t MiB = 1u << 20;
constexpr size_t BLK = (size_t)MROWS * 256;
constexpr size_t WS_CTL = 0, CTL_ZERO_BYTES = 1 * MiB;
constexpr size_t WS_GATES = 1 * MiB, WS_WBM = 5 * MiB, WS_WBD = 9 * MiB, WS_WOUT = 13 * MiB, WS_PROJ = 21 * MiB, WS_WIN = 373 * MiB, WS_XN = 418 * MiB;
constexpr size_t WS_DQ = 373 * MiB, WS_DK = 405 * MiB, WS_DV = 437 * MiB;
constexpr size_t WS_HM = 117 * MiB, WS_ODF = 181 * MiB, WS_ODB = 469 * MiB;
constexpr size_t WS_YM = 21 * MiB, WS_YD = 53 * MiB, WS_MIX = 373 * MiB;
constexpr size_t WS_XN2 = 437 * MiB, WS_W1T = 21 * MiB, WS_W2T = 53 * MiB, WS_HFF = 117 * MiB, WS_END = 509 * MiB;
constexpr int CW_BAR = 4096;
constexpr int LDS_BYTES = 163840;
constexpr int MISC_OFF = LDS_BYTES - 256;

#define GAS __attribute__((address_space(1)))
#define LAS __attribute__((address_space(3)))
typedef unsigned short bf16;
typedef unsigned v4u __attribute__((ext_vector_type(4)));
typedef unsigned v2u __attribute__((ext_vector_type(2)));
typedef float f32x4 __attribute__((ext_vector_type(4)));
typedef short bf16x8 __attribute__((ext_vector_type(8)));
typedef GAS unsigned gu32;
#define RLX_AGENT __ATOMIC_RELAXED, __HIP_MEMORY_SCOPE_AGENT
#define LDS_WAIT() asm volatile("s_waitcnt lgkmcnt(0)" ::: "memory")
#define VM_WAIT() asm volatile("s_waitcnt vmcnt(0)" ::: "memory")
__device__ __forceinline__ unsigned f2bf(float f) { unsigned u = __builtin_bit_cast(unsigned, f); return (u + 0x7fffu + ((u >> 16) & 1u)) >> 16; }
typedef float f32x2v_ __attribute__((ext_vector_type(2)));
typedef __bf16 bf16x2v_ __attribute__((ext_vector_type(2)));
__device__ __forceinline__ unsigned pk2(float lo, float hi) { const f32x2v_ v = {lo, hi}; return __builtin_bit_cast(unsigned, __builtin_convertvector(v, bf16x2v_)); }
__device__ __forceinline__ float bflo(unsigned w) { return __uint_as_float(w << 16); }
__device__ __forceinline__ float bfhi(unsigned w) { return __uint_as_float(w & 0xffff0000u); }
__device__ __forceinline__ float bfel(const v4u& v, int i) { const unsigned w = v[i >> 1]; return (i & 1) ? bfhi(w) : bflo(w); }
#define MFMA16(a, b, c) __builtin_amdgcn_mfma_f32_16x16x32_bf16((a), (b), (c), 0, 0, 0)
__device__ __forceinline__ bf16x8 ldfrag(const LAS unsigned char* p) { return *(const LAS bf16x8*)p; }
__device__ __forceinline__ void st8(LAS unsigned char* p, const f32x4& v) { v2u w; w.x = pk2(v[0], v[1]); w.y = pk2(v[2], v[3]); *(LAS v2u*)p = w; }
#define XB_TMO      128
#define XB_XCNT(j)  (256  + 64 * (j))
#define XB_XSUB(j)  (1280 + 64 * (j))
#define XB_XGEN(j)  (2304 + 64 * (j))
#define XB_TOP      3328
#define XB_TOPGEN   3392
#define XCD_BAR_WORDS 3456
#define XB_SPIN_CAP (1u << 18)

__device__ __forceinline__ unsigned xb_ld(unsigned* p)              { return __hip_atomic_load(p, __ATOMIC_RELAXED, __HIP_MEMORY_SCOPE_AGENT); }
__device__ __forceinline__ unsigned xb_add(unsigned* p, unsigned v) { return __hip_atomic_fetch_add(p, v, __ATOMIC_RELAXED, __HIP_MEMORY_SCOPE_AGENT); }
__device__ __forceinline__ unsigned xb_xcc_id() { return (unsigned)__builtin_amdgcn_s_getreg((3 << 11) | 20) & 0xFu; }
#define XB_SPIN(cond, bar) do { unsigned _sp = 0; while (cond) { __builtin_amdgcn_s_sleep(1); \
    if ((++_sp & 255u) == 0u) { if (xb_ld(&(bar)[XB_TMO])) break; if (_sp > XB_SPIN_CAP) { atomicAdd(&(bar)[XB_TMO], 1u); break; } } } } while (0)

struct XcdBarrier {
    unsigned* bar; unsigned x;
    volatile LAS unsigned* st;
};

__device__ __forceinline__ XcdBarrier xcd_barrier_post(unsigned* bar, volatile LAS unsigned* st) {
    XcdBarrier b; b.bar = bar; b.x = xb_xcc_id(); b.st = st;
    if (threadIdx.x == 0) (void)xb_add(&bar[XB_XCNT(b.x)], 1u);
    return b;
}
__device__ __forceinline__ void xcd_barrier_complete(unsigned* bar, unsigned x, unsigned& nloc, unsigned& nx) {
    const unsigned G = gridDim.x * gridDim.y * gridDim.z;
    unsigned sum, cnt, mine, sp = 0u;
    for (;;) {
        sum = 0u; cnt = 0u; mine = 0u;
#pragma unroll
        for (unsigned j = 0; j < 16; ++j) { const unsigned c = xb_ld(&bar[XB_XCNT(j)]); sum += c; cnt += (c > 0u) ? 1u : 0u; mine = (j == x) ? c : mine; }
        if (sum == G) break;
        __builtin_amdgcn_s_sleep(1);
        if ((++sp & 255u) == 0u) { if (xb_ld(&bar[XB_TMO])) break; if (sp > XB_SPIN_CAP) { atomicAdd(&bar[XB_TMO], 1u); break; } }
    }
    nloc = mine > 0u ? mine : 1u; nx = cnt > 0u ? cnt : 1u;
}

__device__ __forceinline__ void xcd_barrier(const XcdBarrier& b) {
    asm volatile("s_waitcnt vmcnt(0)" ::: "memory");
    __syncthreads();
    if (threadIdx.x == 0) {
        unsigned* bar = b.bar;
        __builtin_amdgcn_s_waitcnt(0);
        unsigned nloc = b.st[0], nx = b.st[1];
        if (nloc == 0u) { xcd_barrier_complete(bar, b.x, nloc, nx); b.st[0] = nloc; b.st[1] = nx; }
        const unsigned old = xb_add(&bar[XB_XSUB(b.x)], 1u);
        const unsigned gen = old / nloc;
        if (old + 1u == (gen + 1u) * nloc) {
            __builtin_amdgcn_fence(__ATOMIC_RELEASE, "agent");
            asm volatile("s_waitcnt vmcnt(0)" ::: "memory");
            const unsigned og = xb_add(&bar[XB_TOP], 1u);
            const unsigned tg = og / nx;
            if (og + 1u == (tg + 1u) * nx) xb_add(&bar[XB_TOPGEN], 1u);
            else XB_SPIN(xb_ld(&bar[XB_TOPGEN]) == tg, bar);
            __builtin_amdgcn_fence(__ATOMIC_ACQUIRE, "agent");
            xb_add(&bar[XB_XGEN(b.x)], 1u);
            asm volatile("s_waitcnt vmcnt(0)" ::: "memory");
        } else {
            XB_SPIN(xb_ld(&bar[XB_XGEN(b.x)]) == gen, bar);
            __builtin_amdgcn_fence(__ATOMIC_ACQUIRE, "agent");
            asm volatile("s_waitcnt vmcnt(0)" ::: "memory");
        }
    }
    __syncthreads();
}
struct Frame {
    LAS unsigned char* lds;
    volatile LAS unsigned* MISC;
    gu32* ctl;
    int tid, lane, wave;
    int vcu, G;
    float* out;
    unsigned char* ws;
};
__device__ __forceinline__ float wave_sum(float v) {
#pragma unroll
    for (int o = 1; o < 64; o <<= 1) v += __shfl_xor(v, o);
    return v;
}
__device__ __forceinline__ int win_map(int n) {
    if (n < 3072) return n;
    if (n < 3088) return 11264 + (n - 3072);
    if (n < 7184) return n - 16;
    if (n < 7216) return 11264 + 16 + (n - 7184);
    return n - 48;
}
constexpr int TR_SCR = 64 * 65 * 4;
__device__ __forceinline__ void tr_item(const float* W, int K, int N, bf16* WT, LAS float* scr, int item, int lane, bool remap) {
    const int nblk = (N + 63) / 64, kb = item / nblk, nb = item % nblk, k0 = 64 * kb, n0 = 64 * nb;
    const int kr = lane >> 4, c4 = lane & 15, nn = n0 + 4 * c4; const bool okc = nn < N;
    f32x4 v[16];
#pragma unroll
    for (int i = 0; i < 16; ++i) v[i] = okc ? *(const f32x4*)(W + (size_t)(k0 + 4 * i + kr) * N + nn) : (f32x4){0.f, 0.f, 0.f, 0.f};
#pragma unroll
    for (int i = 0; i < 16; ++i) { LAS float* s = scr + (4 * i + kr) * 65 + 4 * c4; s[0] = v[i].x; s[1] = v[i].y; s[2] = v[i].z; s[3] = v[i].w; }
    LDS_WAIT(); asm volatile("" ::: "memory");
    const int j = lane >> 3, n8 = lane & 7;
#pragma unroll
    for (int p = 0; p < 8; ++p) { const int n = 8 * p + n8; const LAS float* s = scr + (8 * j) * 65 + n;
        v4u o; o.x = pk2(s[0 * 65], s[1 * 65]); o.y = pk2(s[2 * 65], s[3 * 65]); o.z = pk2(s[4 * 65], s[5 * 65]); o.w = pk2(s[6 * 65], s[7 * 65]);
        if (n0 + n < N) { const int row = remap ? win_map(n0 + n) : (n0 + n); *(v4u*)(WT + (size_t)row * K + k0 + 8 * j) = o; } }
    LDS_WAIT(); asm volatile("" ::: "memory");
}
__device__ __forceinline__ void rms_row_bf16(int lane, const float* xrow, const float* g, bf16* orow) {
    const f32x4* xr = (const f32x4*)xrow + lane; const f32x4* gr = (const f32x4*)g + lane;
    f32x4 v[8]; float s = 0.f;
#pragma unroll
    for (int j = 0; j < 8; ++j) { v[j] = xr[64 * j]; s += (v[j].x * v[j].x + v[j].y * v[j].y) + (v[j].z * v[j].z + v[j].w * v[j].w); }
    const float r = 1.0f / sqrtf(wave_sum(s) * (1.f / 2048.f) + RMS_EPS);
    v2u* o8 = (v2u*)orow + lane;
#pragma unroll
    for (int j = 0; j < 8; ++j) { const f32x4 gg = gr[64 * j]; v2u w; w.x = pk2(v[j].x * r * gg.x, v[j].y * r * gg.y); w.y = pk2(v[j].z * r * gg.z, v[j].w * r * gg.w); o8[64 * j] = w; }
}
__device__ __forceinline__ void rms_row_f32(int lane, const float* xrow, const float* g, float* orow) {
    const f32x4* xr = (const f32x4*)xrow + lane; const f32x4* gr = (const f32x4*)g + lane;
    f32x4 v[8]; float s = 0.f;
#pragma unroll
    for (int j = 0; j < 8; ++j) { v[j] = xr[64 * j]; s += (v[j].x * v[j].x + v[j].y * v[j].y) + (v[j].z * v[j].z + v[j].w * v[j].w); }
    const float r = 1.0f / sqrtf(wave_sum(s) * (1.f / 2048.f) + RMS_EPS);
    f32x4* o = (f32x4*)orow + lane;
#pragma unroll
    for (int j = 0; j < 8; ++j) { const f32x4 gg = gr[64 * j]; o[64 * j] = (v[j] * r) * gg; }
}

__device__ __forceinline__ void p0_prologue(Frame& F, const float* x, const float* n1g, const float* w_in, const float* w_bm, const float* w_bd, const float* w_out) {
    LAS float* scr = (LAS float*)(F.lds + F.wave * TR_SCR);
    const int gw = F.vcu * NWAVES + F.wave, NGW = F.G * NWAVES;
    bf16* WIN = (bf16*)(F.ws + WS_WIN); bf16* WBM = (bf16*)(F.ws + WS_WBM); bf16* WBD = (bf16*)(F.ws + WS_WBD); bf16* WOUT = (bf16*)(F.ws + WS_WOUT); bf16* XN = (bf16*)(F.ws + WS_XN);
    constexpr int I_IN = (DM / 64) * ((NPROJ_IN + 63) / 64), I_B = (1024 / 64) * (DM / 64), I_O = (DM / 64) * (DM / 64);
    constexpr int NITEMS = I_IN + 2 * I_B + I_O;
    for (int it = gw; it < NITEMS; it += NGW) {
        int r = it;
        if (r < I_IN) { tr_item(w_in, DM, NPROJ_IN, WIN, scr, r, F.lane, true); continue; } r -= I_IN;
        if (r < I_B) { tr_item(w_bm, 1024, DM, WBM, scr, r, F.lane, false); continue; } r -= I_B;
        if (r < I_B) { tr_item(w_bd, 1024, DM, WBD, scr, r, F.lane, false); continue; } r -= I_B;
        tr_item(w_out, DM, DM, WOUT, scr, r, F.lane, false);
    }
    { v4u* z = (v4u*)(WIN + (size_t)(11264 + 48) * DM); const int nz = (NPROJ_PAD - 11264 - 48) * DM / 8;
      for (int i = gw * 64 + F.lane; i < nz; i += NGW * 64) z[i] = (v4u){0u, 0u, 0u, 0u}; }
    for (int m = gw; m < MROWS; m += NGW) rms_row_bf16(F.lane, x + (size_t)m * DM, n1g, XN + (size_t)m * DM);
}

__device__ __forceinline__ void gate_gemm(Frame& F) {
    const int lane = F.lane, w = F.wave, fr = lane & 15, fq = lane >> 4, rt = w & 3, kh = w >> 2;
    const bf16* XN = (const bf16*)(F.ws + WS_XN); const bf16* WG = (const bf16*)(F.ws + WS_WIN) + (size_t)11264 * DM;
    float* GATES = (float*)(F.ws + WS_GATES);
    LAS float* red = (LAS float*)F.lds;
    for (int blk = F.vcu; blk < MROWS / 64; blk += F.G) {
        const int m0 = blk * 64 + rt * 16;
        f32x4 acc[4];
#pragma unroll
        for (int nt = 0; nt < 4; ++nt) acc[nt] = (f32x4){0.f, 0.f, 0.f, 0.f};
        const char* ap = (const char*)XN + (size_t)(m0 + fr) * (DM * 2) + kh * 2048 + fq * 16;
        const char* bp = (const char*)WG + (size_t)fr * (DM * 2) + kh * 2048 + fq * 16;
#pragma unroll 1
        for (int kb = 0; kb < 4; ++kb) {
            bf16x8 af[8], bfr[8][4];
#pragma unroll
            for (int ks = 0; ks < 8; ++ks) { af[ks] = *(const bf16x8*)(ap + (kb * 8 + ks) * 64);
#pragma unroll
                for (int nt = 0; nt < 4; ++nt) bfr[ks][nt] = *(const bf16x8*)(bp + (size_t)nt * 16 * (DM * 2) + (kb * 8 + ks) * 64); }
#pragma unroll
            for (int ks = 0; ks < 8; ++ks)
#pragma unroll
                for (int nt = 0; nt < 4; ++nt) acc[nt] = MFMA16(bfr[ks][nt], af[ks], acc[nt]);
        }
        if (kh == 1) {
#pragma unroll
            for (int nt = 0; nt < 4; ++nt) *(LAS f32x4*)(red + ((rt * 4 + nt) * 64 + lane) * 4) = acc[nt]; }
        __syncthreads();
        if (kh == 0) {
#pragma unroll
            for (int nt = 0; nt < 4; ++nt) { const f32x4 o = acc[nt] + *(const LAS f32x4*)(red + ((rt * 4 + nt) * 64 + lane) * 4);
                *(f32x4*)(GATES + (size_t)(m0 + fr) * 64 + nt * 16 + 4 * fq) = o; } }
        __syncthreads();
    }
}

__device__ __forceinline__ void p2_conv(Frame& F, const float* convw) {
    const int gw = F.vcu * NWAVES + F.wave, NGW = F.G * NWAVES, lane = F.lane, c = lane & 15, r4 = lane >> 4;
    const bf16* PROJ = (const bf16*)(F.ws + WS_PROJ);
    bf16* DQ = (bf16*)(F.ws + WS_DQ); bf16* DK = (bf16*)(F.ws + WS_DK); bf16* DV = (bf16*)(F.ws + WS_DV);
    constexpr int NIT = 24 * (MROWS / 32);
    for (int it = gw; it < NIT; it += NGW) {
        const int gI = it % 24, tb32 = it / 24, m0 = tb32 * 32 + r4 * 8, b = m0 >> 11, t0 = m0 & 2047;
        const int c0 = gI * 128;
        const bf16* src = PROJ + (size_t)(12 + (c0 >> 8)) * BLK + (c0 & 255) + 8 * c;
        v4u xr[12];
#pragma unroll
        for (int i = 0; i < 12; ++i) { const int tp = t0 - 2 + i; xr[i] = (v4u){0u, 0u, 0u, 0u};
            if (tp >= 0 && tp < SEQ) xr[i] = *(const v4u*)(src + (size_t)(b * SEQ + tp) * 256); }
        f32x4 cwl[5], cwh[5];
#pragma unroll
        for (int i = 0; i < 5; ++i) { const float* cp = convw + (size_t)i * 3072 + c0 + 8 * c; cwl[i] = *(const f32x4*)cp; cwh[i] = *(const f32x4*)(cp + 4); }
        bf16* dst = (gI < 8 ? DQ : (gI < 16 ? DK : DV)) + (size_t)m0 * 1024 + (c0 & 1023) + 8 * c;
#pragma unroll
        for (int o = 0; o < 8; ++o) {
            float y[8];
#pragma unroll
            for (int e = 0; e < 8; ++e) y[e] = 0.f;
#pragma unroll
            for (int i = 0; i < 5; ++i) { const v4u xv = xr[o + i];
                y[0] += cwl[i][0] * bflo(xv.x); y[1] += cwl[i][1] * bfhi(xv.x); y[2] += cwl[i][2] * bflo(xv.y); y[3] += cwl[i][3] * bfhi(xv.y);
                y[4] += cwh[i][0] * bflo(xv.z); y[5] += cwh[i][1] * bfhi(xv.z); y[6] += cwh[i][2] * bflo(xv.w); y[7] += cwh[i][3] * bfhi(xv.w); }
            float ss = 0.f;
#pragma unroll
            for (int e = 0; e < 8; ++e) { y[e] = y[e] / (1.0f + __expf(-y[e])); ss += y[e] * y[e]; }
            if (gI < 16) { ss += __shfl_xor(ss, 1); ss += __shfl_xor(ss, 2); ss += __shfl_xor(ss, 4); ss += __shfl_xor(ss, 8);
                float r = 1.0f / sqrtf(ss + 1e-6f); if (gI < 8) r *= 0.08838834764831845f;
#pragma unroll
                for (int e = 0; e < 8; ++e) y[e] *= r; }
            v4u ov; ov.x = pk2(y[0], y[1]); ov.y = pk2(y[2], y[3]); ov.z = pk2(y[4], y[5]); ov.w = pk2(y[6], y[7]);
            *(v4u*)(dst + (size_t)o * 1024) = ov;
        }
    }
}

#define WG_BAR() do { asm volatile("s_waitcnt lgkmcnt(0)" ::: "memory"); __builtin_amdgcn_s_barrier(); asm volatile("" ::: "memory"); } while (0)
typedef short s16x4 __attribute__((ext_vector_type(4)));
__device__ __forceinline__ bf16x8 ldfrag_tr(const LAS unsigned char* p, int RS) {
    const s16x4 lo = __builtin_amdgcn_ds_read_tr16_b64_v4i16((LAS s16x4*)p);
    const s16x4 hi = __builtin_amdgcn_ds_read_tr16_b64_v4i16((LAS s16x4*)(p + 4 * RS));
    return __builtin_shufflevector(lo, hi, 0, 1, 2, 3, 4, 5, 6, 7);
}
__device__ __forceinline__ int trofs(int lane, int RS) { const int i = lane & 15, g = lane >> 4; return (8 * g + (i >> 2)) * RS + 8 * (i & 3); }
template <int CTRL, int ROWMASK> __device__ __forceinline__ float dppf(float old, float src) {
    return __builtin_bit_cast(float, __builtin_amdgcn_update_dpp(__builtin_bit_cast(int, old), __builtin_bit_cast(int, src), CTRL, ROWMASK, 0xf, false)); }
__device__ __forceinline__ float wave_incl_sum(float v) {
    v += dppf<0x111, 0xf>(0.f, v); v += dppf<0x112, 0xf>(0.f, v); v += dppf<0x114, 0xf>(0.f, v); v += dppf<0x118, 0xf>(0.f, v);
    v += dppf<0x142, 0xa>(0.f, v); v += dppf<0x143, 0xc>(0.f, v); return v; }
__device__ __forceinline__ float wave_incl_max(float v) {
    const float NI = -3.0e38f;
    v = fmaxf(v, dppf<0x111, 0xf>(NI, v)); v = fmaxf(v, dppf<0x112, 0xf>(NI, v)); v = fmaxf(v, dppf<0x114, 0xf>(NI, v)); v = fmaxf(v, dppf<0x118, 0xf>(NI, v));
    v = fmaxf(v, dppf<0x142, 0xa>(NI, v)); v = fmaxf(v, dppf<0x143, 0xc>(NI, v)); return v; }
__device__ __forceinline__ float lane63(float v) { return __builtin_bit_cast(float, __builtin_amdgcn_readlane(__builtin_bit_cast(int, v), 63)); }
__device__ __forceinline__ v4u scale8(const v4u& v, float s) { v4u o; o.x = pk2(bflo(v.x) * s, bfhi(v.x) * s); o.y = pk2(bflo(v.y) * s, bfhi(v.y) * s); o.z = pk2(bflo(v.z) * s, bfhi(v.z) * s); o.w = pk2(bflo(v.w) * s, bfhi(v.w) * s); return o; }

#ifdef PROBE_SEG
#define TP(k) do { if (PROBE_SEG == (k)) tp0 = __builtin_amdgcn_s_memtime(); if (PROBE_SEG + PROBE_LEN == (k)) tpacc += __builtin_amdgcn_s_memtime() - tp0; } while (0)
#define TP_DECL unsigned long long tp0 = 0, tpacc = 0;
#define TP_SPIN(isunit0) do { if ((isunit0) && tid == 0) { const unsigned long long t1 = __builtin_amdgcn_s_memtime(), dt = (PROBE_SEG == 99) ? 1000000ull * PROBE_AMP : tpacc * PROBE_AMP; while (__builtin_amdgcn_s_memtime() - t1 < dt) __builtin_amdgcn_s_sleep(8); } } while (0)
#else
#define TP(k) do {} while (0)
#define TP_DECL
#define TP_SPIN(x) do {} while (0)
#endif
constexpr int ML_QP = 0, ML_KS = 25600, ML_KW = 43008, ML_VX = 60416, ML_CT = 79872, ML_CT_BYTES = 39168, ML_VEC = 119040, ML_VECN = 336;
constexpr float ML_SCALE = 0.08838834764831845f;
__device__ __forceinline__ void mlstm_unit(Frame& F, int unit, const float* m_ib, const float* m_fb) {
    const int tid = F.tid, lane = F.lane, w = F.wave, fr = lane & 15, fq = lane >> 4;
    const int half = unit & 1, dir = (unit >> 1) & 1, h = (unit >> 2) & 3, b = unit >> 4;
    LAS unsigned char* L = F.lds;
    LAS float* vec = (LAS float*)(L + ML_VEC);
    const int tro272 = trofs(lane, 272), tro304 = trofs(lane, 304);
    for (int i = tid; i < ML_CT_BYTES / 16; i += 512) ((LAS v4u*)(L + ML_CT))[i] = (v4u){0u, 0u, 0u, 0u};
    if (tid < 64) { *(LAS v4u*)(L + ML_VX + tid * 304 + 256) = (v4u){0x00003f80u, 0u, 0u, 0u}; *(LAS v4u*)(L + ML_VX + tid * 304 + 272) = (v4u){0u, 0u, 0u, 0u}; }
    f32x4 accS[9];
#pragma unroll
    for (int t = 0; t < 9; ++t) accS[t] = (f32x4){0.f, 0.f, 0.f, 0.f};
    float m_st = -1e30f;
    const bf16* PROJ = (const bf16*)(F.ws + WS_PROJ);
    const float* GATES = (const float*)(F.ws + WS_GATES);
    const bf16* Qg = PROJ + (size_t)(h >> 1) * BLK + (h & 1) * 128;
    const bf16* Kg = PROJ + (size_t)(2 + (h >> 1)) * BLK + (h & 1) * 128;
    const bf16* Vg = PROJ + (size_t)(4 + h) * BLK + half * 128;
    bf16* Hout = (bf16*)(F.ws + WS_HM) + (size_t)dir * MROWS * 1024 + h * 256 + half * 128;
    const float ib = m_ib[dir * 4 + h], fb = m_fb[dir * 4 + h];
    const int sr = tid >> 4, sc = tid & 15;
    v4u q[2], k[2], v[2];
    float g_i = 0.f, g_f = 0.f;
#define ML_GATES(vb_, ig_raw, f_raw) do { \
        const float ig_ = (ig_raw) + ib, fp_ = (f_raw) + fb; \
        const float lf_ = fp_ >= 0.f ? -__logf(1.0f + __expf(-fp_)) : fp_ - __logf(1.0f + __expf(fp_)); \
        const float bc_ = wave_incl_sum(lf_), a_ = ig_ - bc_, am_ = wave_incl_max(a_); \
        const float Ml_ = fmaxf(m_st, am_), M63_ = lane63(Ml_), bl_ = lane63(bc_); \
        (vb_)[lane] = a_; (vb_)[64 + lane] = Ml_; (vb_)[128 + lane] = __expf(-(bc_ + Ml_)); (vb_)[192 + lane] = __expf(m_st - Ml_) * ML_SCALE; (vb_)[256 + lane] = __expf(a_ - M63_); \
        if (lane == 0) (vb_)[320] = __expf(m_st - M63_); \
        m_st = bl_ + M63_; } while (0)
#define ML_LOADQKV(jj) do { _Pragma("unroll") for (int p = 0; p < 2; ++p) { const int tt_ = (jj) * 64 + sr + 32 * p, t_ = dir ? (SEQ - 1 - tt_) : tt_; const size_t mr_ = (size_t)(b * SEQ + t_); \
        q[p] = *(const v4u*)(Qg + mr_ * 256 + sc * 8); k[p] = *(const v4u*)(Kg + mr_ * 256 + sc * 8); v[p] = *(const v4u*)(Vg + mr_ * 256 + sc * 8); } } while (0)
#define ML_LOADG(jj) do { const int tt_ = (jj) * 64 + lane, t_ = dir ? (SEQ - 1 - tt_) : tt_; const size_t mr_ = (size_t)(b * SEQ + t_); g_i = GATES[mr_ * 64 + dir * 4 + h]; g_f = GATES[mr_ * 64 + 8 + dir * 4 + h]; } while (0)
    ML_LOADQKV(0);
    if (w == 0) { ML_LOADG(0); ML_GATES(vec, g_i, g_f); ML_LOADG(1); }
    __syncthreads();
    TP_DECL
    for (int j = 0; j < 32; ++j) {
        TP(0);
        LAS float* vb = vec + (j & 1) * ML_VECN;
#pragma unroll
        for (int p = 0; p < 2; ++p) { const int r = sr + 32 * p; const float wsr = vb[256 + r];
            *(LAS v4u*)(L + ML_QP + r * 400 + 128 + sc * 16) = q[p]; *(LAS v4u*)(L + ML_KS + r * 272 + sc * 16) = k[p];
            *(LAS v4u*)(L + ML_KW + r * 272 + sc * 16) = scale8(k[p], wsr); *(LAS v4u*)(L + ML_VX + r * 304 + sc * 16) = v[p]; }
        if (j + 1 < 32) ML_LOADQKV(j + 1);
        if (w == 0 && j + 1 < 32) { LAS float* vn = vec + ((j + 1) & 1) * ML_VECN; ML_GATES(vn, g_i, g_f); if (j + 2 < 32) ML_LOADG(j + 2); }
        TP(1); WG_BAR(); TP(2);
        {
            const int lt = w & 3, l = lt * 16 + fr; const float Ml = vb[64 + l];
#pragma unroll
            for (int s2 = 0; s2 < 2; ++s2) { const int st = (w >> 2) * 2 + s2;
                f32x4 acc = (f32x4){0.f, 0.f, 0.f, 0.f};
                if (st <= lt) {
#pragma unroll
                    for (int ks = 0; ks < 4; ++ks) acc = MFMA16(ldfrag(L + ML_KS + (st * 16 + fr) * 272 + ks * 64 + fq * 16), ldfrag(L + ML_QP + l * 400 + 128 + ks * 64 + fq * 16), acc); }
                f32x4 pv;
#pragma unroll
                for (int r = 0; r < 4; ++r) { const int s = st * 16 + 4 * fq + r; pv[r] = (s <= l) ? acc[r] * ML_SCALE * __expf(fminf(vb[s] - Ml, 0.f)) : 0.f; }
                st8(L + ML_QP + l * 400 + (st * 16 + 4 * fq) * 2, pv); }
        }
        TP(3); WG_BAR(); TP(4);
        {
            const int lt = w & 3, dq = w >> 2, l = lt * 16 + fr;
            f32x4 aPV[5], aQC[5];
#pragma unroll
            for (int t = 0; t < 5; ++t) { aPV[t] = (f32x4){0.f, 0.f, 0.f, 0.f}; aQC[t] = (f32x4){0.f, 0.f, 0.f, 0.f}; }
            bf16x8 bq[6];
#pragma unroll
            for (int ks = 0; ks < 6; ++ks) bq[ks] = ldfrag(L + ML_QP + l * 400 + ks * 64 + fq * 16);
#pragma unroll
            for (int t = 0; t < 5; ++t) { const int tile = (t < 4) ? (dq * 4 + t) : 8;
#pragma unroll
                for (int ks = 0; ks < 2; ++ks) aPV[t] = MFMA16(ldfrag_tr(L + ML_VX + (ks * 32) * 304 + tile * 32 + tro304, 304), bq[ks], aPV[t]);
#pragma unroll
                for (int ks = 0; ks < 4; ++ks) aQC[t] = MFMA16(ldfrag(L + ML_CT + (tile * 16 + fr) * 272 + ks * 64 + fq * 16), bq[2 + ks], aQC[t]); }
            const float wi = vb[192 + l], eml = vb[128 + l];
            float den = aPV[4][0] + wi * aQC[4][0];
            den = __shfl(den, fr);
            const float inv = 1.0f / fmaxf(fabsf(den), eml);
            const int tt = j * 64 + l, t = dir ? (SEQ - 1 - tt) : tt; const size_t mrow = (size_t)(b * SEQ + t);
#pragma unroll
            for (int t4 = 0; t4 < 4; ++t4) { const f32x4 nv = (aPV[t4] + aQC[t4] * wi) * inv; v2u o; o.x = pk2(nv[0], nv[1]); o.y = pk2(nv[2], nv[3]);
                *(v2u*)(Hout + mrow * 1024 + (dq * 4 + t4) * 16 + 4 * fq) = o; }
        }
        TP(5);
        {
            const float decay = vb[320];
            bf16x8 ak[2];
#pragma unroll
            for (int ks = 0; ks < 2; ++ks) ak[ks] = ldfrag_tr(L + ML_KW + (ks * 32) * 272 + w * 32 + tro272, 272);
#pragma unroll
            for (int t = 0; t < 9; ++t) { accS[t] = accS[t] * decay;
#pragma unroll
                for (int ks = 0; ks < 2; ++ks) accS[t] = MFMA16(ak[ks], ldfrag_tr(L + ML_VX + (ks * 32) * 304 + t * 32 + tro304, 304), accS[t]); }
        }
        TP(6); WG_BAR(); TP(7);
#pragma unroll
        for (int t = 0; t < 9; ++t) st8(L + ML_CT + (t * 16 + fr) * 272 + (w * 16 + 4 * fq) * 2, accS[t]);
        TP(8);
    }
    TP_SPIN(unit == 0);
    __syncthreads();
#undef ML_GATES
#undef ML_LOADQKV
#undef ML_LOADG
}

constexpr int DN_QS = 0, DN_KD = 34816, DN_KS = 69632, DN_VS = 87040, DN_T1 = 104448, DN_T2 = 113664, DN_AT = 122880, DN_WL = 132096;
constexpr int DN_WREG = 18432;
constexpr int DN_VEC = 149504, DN_VECN = 264;
constexpr size_t WS_TSCR = 501 * MiB;
__device__ __forceinline__ bf16x8 packacc(const f32x4& a, const f32x4& b) { v4u o; o.x = pk2(a[0], a[1]); o.y = pk2(a[2], a[3]); o.z = pk2(b[0], b[1]); o.w = pk2(b[2], b[3]); return __builtin_bit_cast(bf16x8, o); }
__device__ __forceinline__ bf16x8 ldfrag_pk(const LAS unsigned char* p) {
    const s16x4 lo = *(const LAS s16x4*)p, hi = *(const LAS s16x4*)(p + 32); return __builtin_shufflevector(lo, hi, 0, 1, 2, 3, 4, 5, 6, 7); }
__device__ __forceinline__ bf16x8 ldfrag_trp(const LAS unsigned char* p, int RS) {
    const s16x4 lo = __builtin_amdgcn_ds_read_tr16_b64_v4i16((LAS s16x4*)p);
    const s16x4 hi = __builtin_amdgcn_ds_read_tr16_b64_v4i16((LAS s16x4*)(p + 16 * RS));
    return __builtin_shufflevector(lo, hi, 0, 1, 2, 3, 4, 5, 6, 7); }
__device__ __forceinline__ int trofs_p(int fr, int fq, int RS) { return (4 * fq + (fr >> 2)) * RS + 8 * (fr & 3); }
__device__ __forceinline__ void delta_unit(Frame& F, int unit, const float* d_alog, const float* d_dtb) {
    const int tid = F.tid, lane = F.lane, w = F.wave, fr0 = lane & 15, fq0 = lane >> 4;
    const int dir = unit & 1, h = (unit >> 1) & 7, b = unit >> 4;
    LAS unsigned char* L = F.lds;
    LAS float* vec = (LAS float*)(L + DN_VEC);
    f32x4 accS[8];
#pragma unroll
    for (int t = 0; t < 8; ++t) accS[t] = (f32x4){0.f, 0.f, 0.f, 0.f};
    const float* Ga = (const float*)(F.ws + WS_GATES) + 16 + dir * 8 + h; const float* Gb = Ga + 16;
    const bf16* Qg = (const bf16*)(F.ws + WS_DQ) + h * 128; const bf16* Kg = (const bf16*)(F.ws + WS_DK) + h * 128; const bf16* Vg = (const bf16*)(F.ws + WS_DV) + h * 128;
    bf16* Oout = (bf16*)(F.ws + (dir ? WS_ODB : WS_ODF)) + h * 128;
    bf16* Tg = (bf16*)(F.ws + WS_TSCR) + (size_t)unit * (8 * 4096);
    const float Aexp = __expf(d_alog[dir * 8 + h]), dtb = d_dtb[dir * 8 + h];
    const int sr = tid >> 4, sc = tid & 15;
    v4u q[2], k[2], v[2], tT;
#define DN_LOADQKV(jj) do { _Pragma("unroll") for (int p = 0; p < 2; ++p) { const int tt_ = (jj) * 64 + sr + 32 * p, t_ = dir ? (SEQ - 1 - tt_) : tt_; const unsigned ro_ = (unsigned)(b * SEQ + t_) * 2048u + (unsigned)sc * 16u; \
        q[p] = *(const v4u*)((const char*)Qg + ro_); k[p] = *(const v4u*)((const char*)Kg + ro_); v[p] = *(const v4u*)((const char*)Vg + ro_); } \
        tT = __builtin_nontemporal_load((const v4u*)((const char*)Tg + (unsigned)(((jj) & 7) * 8192 + tid * 16))); } while (0)
    TP_DECL
    for (int grp = 0; grp < 4; ++grp) {
        TP(20);
        int fr = fr0, fq = fq0; asm volatile("" : "+v"(fr), "+v"(fq));
        __syncthreads();
        {
            const int c = grp * 8 + w; const int tro144 = trofs(fq * 16 + fr, 144);
            LAS unsigned char* PA = L + w * DN_WREG; LAS unsigned char* XA = PA + 9216; LAS float* gv = vec + w * DN_VECN;
            { const int tt = c * 64 + lane, t = dir ? (SEQ - 1 - tt) : tt; const unsigned go = (unsigned)(b * SEQ + t) * 256u;
              const float ap = *(const float*)((const char*)Ga + go) + dtb, bp = *(const float*)((const char*)Gb + go);
              const float sp = ap > 0.f ? ap + __logf(1.0f + __expf(-ap)) : __logf(1.0f + __expf(ap));
              const float gq = -Aexp * sp, beta = 1.0f / (1.0f + __expf(-bp)), gc = wave_incl_sum(gq), gl = lane63(gc);
              gv[lane] = gc; gv[64 + lane] = beta; gv[128 + lane] = __expf(gc); gv[192 + lane] = __expf(gl - gc); if (lane == 0) gv[256] = __expf(gl); }
            f32x4 accX[4][4];
#pragma unroll
            for (int tb = 0; tb < 4; ++tb)
#pragma unroll
                for (int ta = 0; ta < 4; ++ta) accX[ta][tb] = (f32x4){0.f, 0.f, 0.f, 0.f};
#pragma unroll
            for (int kh = 0; kh < 2; ++kh) {
                bf16x8 kf[4][2];
#pragma unroll
                for (int t4 = 0; t4 < 4; ++t4) { const int tt = c * 64 + t4 * 16 + fr, t = dir ? (SEQ - 1 - tt) : tt; const unsigned ro = (unsigned)(b * SEQ + t) * 2048u + (unsigned)fq * 16u;
#pragma unroll
                    for (int ks = 0; ks < 2; ++ks) kf[t4][ks] = *(const bf16x8*)((const char*)Kg + ro + (kh * 2 + ks) * 64); }
#pragma unroll
                for (int tb = 0; tb < 4; ++tb)
#pragma unroll
                    for (int ta = 0; ta < 4; ++ta) if (ta <= tb) {
#pragma unroll
                        for (int ks = 0; ks < 2; ++ks) accX[ta][tb] = MFMA16(kf[ta][ks], kf[tb][ks], accX[ta][tb]); }
            }
#pragma unroll
            for (int tb = 0; tb < 4; ++tb)
#pragma unroll
                for (int ta = 0; ta < 4; ++ta) {
                    const int bI = tb * 16 + fr, a0 = ta * 16 + 4 * fq;
                    if (ta <= tb) {
                        const f32x4 acc = accX[ta][tb];
                        const float gcb = gv[bI], betab = gv[64 + bI];
                        f32x4 vna, vxa;
#pragma unroll
                        for (int r = 0; r < 4; ++r) { const int aI = a0 + r; const float e = -betab * acc[r] * __expf(fminf(gcb - gv[aI], 0.f));
                            if (ta == tb) { const int dd = (4 * fq + r) - fr; vna[r] = dd < 0 ? e : 0.f; vxa[r] = dd < 0 ? e : (dd == 0 ? 1.0f : 0.f); }
                            else { vna[r] = e; vxa[r] = e; } }
                        accX[ta][tb] = vxa;
                        st8(PA + bI * 144 + a0 * 2, vna); st8(XA + bI * 144 + a0 * 2, vxa);
                    } else { const f32x4 z = (f32x4){0.f, 0.f, 0.f, 0.f}; st8(PA + bI * 144 + a0 * 2, z); st8(XA + bI * 144 + a0 * 2, z); }
                }
#pragma unroll 1
            for (int kk = 1; kk <= 6; ++kk) {
                f32x4 accP[4][4];
                bf16x8 fA[4][2];
#pragma unroll
                for (int ta = 0; ta < 4; ++ta)
#pragma unroll
                    for (int ks = 0; ks < 2; ++ks) if (ks >= (ta >> 1)) fA[ta][ks] = ldfrag_tr(PA + (ks * 32) * 144 + ta * 32 + tro144, 144);
#pragma unroll
                for (int tb = 0; tb < 4; ++tb) {
                    bf16x8 pb[2], xb[2];
#pragma unroll
                    for (int ks = 0; ks < 2; ++ks) if (ks <= (tb >> 1)) { pb[ks] = ldfrag(PA + (tb * 16 + fr) * 144 + ks * 64 + fq * 16); xb[ks] = ldfrag(XA + (tb * 16 + fr) * 144 + ks * 64 + fq * 16); }
#pragma unroll
                    for (int ta = 0; ta < 4; ++ta) if (ta <= tb) {
                        accP[ta][tb] = (f32x4){0.f, 0.f, 0.f, 0.f};
#pragma unroll
                        for (int ks = 0; ks < 2; ++ks) if (ks >= (ta >> 1) && ks <= (tb >> 1)) {
                            if (kk <= 5) accP[ta][tb] = MFMA16(fA[ta][ks], pb[ks], accP[ta][tb]);
                            if (kk >= 2) accX[ta][tb] = MFMA16(fA[ta][ks], xb[ks], accX[ta][tb]); } }
                }
#pragma unroll
                for (int tb = 0; tb < 4; ++tb)
#pragma unroll
                    for (int ta = 0; ta < 4; ++ta) if (ta <= tb) { const int off = (tb * 16 + fr) * 144 + (ta * 16 + 4 * fq) * 2;
                        if (kk <= 5) st8(PA + off, accP[ta][tb]);
                        if (kk >= 2) st8(XA + off, accX[ta][tb]); }
            }
            bf16* Tc = Tg + (size_t)w * 4096;
#pragma unroll
            for (int tb = 0; tb < 4; ++tb)
#pragma unroll
                for (int ta = 0; ta < 4; ++ta) { v2u o; if (ta <= tb) { o.x = pk2(accX[ta][tb][0], accX[ta][tb][1]); o.y = pk2(accX[ta][tb][2], accX[ta][tb][3]); } else { o.x = 0u; o.y = 0u; }
                    *(v2u*)((char*)Tc + (unsigned)(((tb * 16 + fr) * 64 + ta * 16 + 4 * fq) * 2)) = o; }
        }
        __syncthreads();
        DN_LOADQKV(grp * 8);
        TP(21);
        for (int jc = 0; jc < 8; ++jc) {
            TP(22);
            const int j = grp * 8 + jc; asm volatile("" : "+v"(fr), "+v"(fq)); const int tro272 = trofs(fq * 16 + fr, 272);
            LAS float* vb = vec + jc * DN_VECN;
            const int pb = (j & 1) * 17408;
            const int pcA = ((sc >> 2) * 32 + 16 * (sc & 1) + 4 * ((sc >> 1) & 1)) * 2, pcB = pcA + 16;
#pragma unroll
            for (int p = 0; p < 2; ++p) { const int r = sr + 32 * p; const float kds = vb[192 + r];
                *(LAS v2u*)(L + DN_QS + pb + r * 272 + pcA) = (v2u){q[p].x, q[p].y}; *(LAS v2u*)(L + DN_QS + pb + r * 272 + pcB) = (v2u){q[p].z, q[p].w};
                *(LAS v2u*)(L + DN_KS + r * 272 + pcA) = (v2u){k[p].x, k[p].y}; *(LAS v2u*)(L + DN_KS + r * 272 + pcB) = (v2u){k[p].z, k[p].w};
                *(LAS v4u*)(L + DN_KD + pb + r * 272 + sc * 16) = scale8(k[p], kds); *(LAS v4u*)(L + DN_VS + r * 272 + sc * 16) = v[p]; }
            {
                const int tr = tid >> 3, c0 = (tid & 7) * 8; v4u t1, t2;
#pragma unroll
                for (int i = 0; i < 4; ++i) { const float b0 = vb[64 + c0 + 2 * i], b1 = vb[64 + c0 + 2 * i + 1], e0 = vb[128 + c0 + 2 * i], e1 = vb[128 + c0 + 2 * i + 1];
                    const float x0 = bflo(tT[i]) * b0, x1 = bfhi(tT[i]) * b1; t1[i] = pk2(x0, x1); t2[i] = pk2(x0 * e0, x1 * e1); }
                *(LAS v4u*)(L + DN_T1 + tr * 144 + c0 * 2) = t1; *(LAS v4u*)(L + DN_T2 + tr * 144 + c0 * 2) = t2; }
            if (jc + 1 < 8) DN_LOADQKV(j + 1);
            TP(23); WG_BAR(); TP(24);
            f32x4 accU[4];
            {
                const int tb = w & 3, bI = tb * 16 + fr; const float gcb = vb[bI];
#pragma unroll
                for (int x = 0; x < 2; ++x) { const int ta = (w >> 2) * 2 + x, a0 = ta * 16 + 4 * fq;
                    f32x4 acc = (f32x4){0.f, 0.f, 0.f, 0.f};
                    if (ta <= tb) {
#pragma unroll
                        for (int ks = 0; ks < 4; ++ks) acc = MFMA16(ldfrag(L + DN_KS + (ta * 16 + fr) * 272 + ks * 64 + fq * 16), ldfrag(L + DN_QS + pb + bI * 272 + ks * 64 + fq * 16), acc); }
                    f32x4 vat;
#pragma unroll
                    for (int r = 0; r < 4; ++r) { const int aI = a0 + r; const float e = acc[r] * __expf(fminf(gcb - vb[aI], 0.f)); vat[r] = (ta < tb || (ta == tb && 4 * fq + r <= fr)) ? e : 0.f; }
                    st8(L + DN_AT + bI * 144 + ((ta >> 1) * 32 + 8 * fq + 4 * (ta & 1)) * 2, vat); }
                f32x4 accW[4];
#pragma unroll
                for (int lt = 0; lt < 4; ++lt) { accU[lt] = (f32x4){0.f, 0.f, 0.f, 0.f}; accW[lt] = (f32x4){0.f, 0.f, 0.f, 0.f}; }
#pragma unroll
                for (int ks = 0; ks < 2; ++ks) {
                    const bf16x8 vtr = ldfrag_tr(L + DN_VS + (ks * 32) * 272 + w * 32 + tro272, 272), ktr = ldfrag_tr(L + DN_KS + (ks * 32) * 272 + w * 32 + tro272, 272);
#pragma unroll
                    for (int lt = 0; lt < 4; ++lt) if (ks <= (lt >> 1)) {
                        accU[lt] = MFMA16(ldfrag(L + DN_T1 + (lt * 16 + fr) * 144 + ks * 64 + fq * 16), vtr, accU[lt]);
                        accW[lt] = MFMA16(ktr, ldfrag(L + DN_T2 + (lt * 16 + fr) * 144 + ks * 64 + fq * 16), accW[lt]); } }
#pragma unroll
                for (int lt = 0; lt < 4; ++lt) { const f32x4 nw = -accW[lt]; st8(L + DN_WL + (lt * 16 + fr) * 272 + (w * 16 + 4 * fq) * 2, nw); }
            }
            TP(25); WG_BAR(); TP(26);
            {
                bf16x8 sfr[4];
#pragma unroll
                for (int ks = 0; ks < 4; ++ks) sfr[ks] = packacc(accS[2 * ks], accS[2 * ks + 1]);
                const float egl = vb[256];
                const int tgo = (int)((j * 64) ), trp = trofs_p(fr, fq, 272);
                {
                    bf16x8 wf[4][4];
#pragma unroll
                    for (int ks = 0; ks < 4; ++ks)
#pragma unroll
                        for (int lt = 0; lt < 4; ++lt) wf[ks][lt] = ldfrag(L + DN_WL + (lt * 16 + fr) * 272 + ks * 64 + fq * 16);
                    __builtin_amdgcn_sched_barrier(0);
#pragma unroll
                    for (int ks = 0; ks < 4; ++ks)
#pragma unroll
                        for (int lt = 0; lt < 4; ++lt) accU[lt] = MFMA16(wf[ks][lt], sfr[ks], accU[lt]);
                }
                f32x4 aOQ[4];
                {
                    bf16x8 qf[4][4];
#pragma unroll
                    for (int ks = 0; ks < 4; ++ks)
#pragma unroll
                        for (int lt = 0; lt < 4; ++lt) qf[ks][lt] = ldfrag(L + DN_QS + pb + (lt * 16 + fr) * 272 + ks * 64 + fq * 16);
                    __builtin_amdgcn_sched_barrier(0);
#pragma unroll
                    for (int lt = 0; lt < 4; ++lt) aOQ[lt] = (f32x4){0.f, 0.f, 0.f, 0.f};
#pragma unroll
                    for (int ks = 0; ks < 4; ++ks)
#pragma unroll
                        for (int lt = 0; lt < 4; ++lt) aOQ[lt] = MFMA16(sfr[ks], qf[ks][lt], aOQ[lt]);
                }
                bf16x8 vfr[2];
#pragma unroll
                for (int ks = 0; ks < 2; ++ks) vfr[ks] = packacc(accU[2 * ks], accU[2 * ks + 1]);
                {
                    bf16x8 af[2][4], kd[2][8];
#pragma unroll
                    for (int ks = 0; ks < 2; ++ks)
#pragma unroll
                        for (int lt = 0; lt < 4; ++lt) af[ks][lt] = ldfrag(L + DN_AT + (lt * 16 + fr) * 144 + ks * 64 + fq * 16);
#pragma unroll
                    for (int ks = 0; ks < 2; ++ks)
#pragma unroll
                        for (int t8 = 0; t8 < 8; ++t8) kd[ks][t8] = ldfrag_trp(L + DN_KD + pb + (ks * 32) * 272 + t8 * 32 + trp, 272);
                    __builtin_amdgcn_sched_barrier(0);
#pragma unroll
                    for (int lt = 0; lt < 4; ++lt) {
                        f32x4 aOA = (f32x4){0.f, 0.f, 0.f, 0.f};
#pragma unroll
                        for (int ks = 0; ks < 2; ++ks) aOA = MFMA16(vfr[ks], af[ks][lt], aOA);
                        const int l = lt * 16 + fr; const float egl_l = vb[128 + l];
                        const int tt = tgo + l, t = dir ? (SEQ - 1 - tt) : tt; const unsigned oo = (unsigned)(b * SEQ + t) * 2048u + (unsigned)(w * 16 + 4 * fq) * 2u;
                        const f32x4 ov = aOA + aOQ[lt] * egl_l; v2u o; o.x = pk2(ov[0], ov[1]); o.y = pk2(ov[2], ov[3]);
                        *(v2u*)((char*)Oout + oo) = o; }
#pragma unroll
                    for (int t8 = 0; t8 < 8; ++t8) accS[t8] = accS[t8] * egl;
#pragma unroll
                    for (int ks = 0; ks < 2; ++ks)
#pragma unroll
                        for (int t8 = 0; t8 < 8; ++t8) accS[t8] = MFMA16(kd[ks][t8], vfr[ks], accS[t8]);
                }
            }
            TP(30);
        }
    }
    TP_SPIN(unit == 0);
    __syncthreads();
#undef DN_LOADQKV
}

__device__ __forceinline__ void p4_combine(Frame& F, const float* m_ng, const float* d_ng) {
    const int gw = F.vcu * NWAVES + F.wave, NGW = F.G * NWAVES, lane = F.lane;
    const bf16* PROJ = (const bf16*)(F.ws + WS_PROJ);
    const bf16* HMf = (const bf16*)(F.ws + WS_HM); const bf16* HMb = HMf + (size_t)MROWS * 1024;
    const bf16* ODf = (const bf16*)(F.ws + WS_ODF); const bf16* ODb = (const bf16*)(F.ws + WS_ODB);
    bf16* YM = (bf16*)(F.ws + WS_YM); bf16* YD = (bf16*)(F.ws + WS_YD);
    for (int m = gw; m < MROWS; m += NGW) {
        v2u hf[4], hb[4], mo[4]; unsigned of[8], ob[8], dz[8];
#pragma unroll
        for (int h = 0; h < 4; ++h) { hf[h] = *(const v2u*)(HMf + (size_t)m * 1024 + h * 256 + 4 * lane); hb[h] = *(const v2u*)(HMb + (size_t)m * 1024 + h * 256 + 4 * lane);
            mo[h] = *(const v2u*)(PROJ + (size_t)(8 + h) * BLK + (size_t)m * 256 + 4 * lane); }
#pragma unroll
        for (int h = 0; h < 8; ++h) { of[h] = *(const unsigned*)(ODf + (size_t)m * 1024 + h * 128 + 2 * lane); ob[h] = *(const unsigned*)(ODb + (size_t)m * 1024 + h * 128 + 2 * lane);
            dz[h] = *(const unsigned*)(PROJ + (size_t)(24 + (h >> 1)) * BLK + (size_t)m * 256 + (h & 1) * 128 + 2 * lane); }
#pragma unroll
        for (int h = 0; h < 4; ++h) {
            const float a0 = bflo(hf[h].x) + bflo(hb[h].x), a1 = bfhi(hf[h].x) + bfhi(hb[h].x), a2 = bflo(hf[h].y) + bflo(hb[h].y), a3 = bfhi(hf[h].y) + bfhi(hb[h].y);
            const float ss = wave_sum((a0 * a0 + a1 * a1) + (a2 * a2 + a3 * a3));
            const float r = 1.0f / sqrtf(ss * (1.f / 256.f) + RMS_EPS);
            const f32x4 g = *(const f32x4*)(m_ng + h * 256 + 4 * lane);
            const float o0 = bflo(mo[h].x), o1 = bfhi(mo[h].x), o2 = bflo(mo[h].y), o3 = bfhi(mo[h].y);
            v2u y; y.x = pk2(a0 * r * g.x / (1.f + expf(-o0)), a1 * r * g.y / (1.f + expf(-o1))); y.y = pk2(a2 * r * g.z / (1.f + expf(-o2)), a3 * r * g.w / (1.f + expf(-o3)));
            *(v2u*)(YM + (size_t)m * 1024 + h * 256 + 4 * lane) = y;
        }
        const float g0 = d_ng[2 * lane], g1 = d_ng[2 * lane + 1];
#pragma unroll
        for (int h = 0; h < 8; ++h) {
            const float a0 = bflo(of[h]) + bflo(ob[h]), a1 = bfhi(of[h]) + bfhi(ob[h]);
            const float ss = wave_sum(a0 * a0 + a1 * a1);
            const float r = 1.0f / sqrtf(ss * (1.f / 128.f) + RMS_EPS);
            const float z0 = bflo(dz[h]), z1 = bfhi(dz[h]);
            *(unsigned*)(YD + (size_t)m * 1024 + h * 128 + 2 * lane) = pk2(a0 * r * g0 * z0 / (1.f + expf(-z0)), a1 * r * g1 * z1 / (1.f + expf(-z1)));
        }
    }
}

__device__ __forceinline__ void p7_norm2(Frame& F, const float* n2g, const float* w_ff1, const float* w_ff2) {
    LAS float* scr = (LAS float*)(F.lds + F.wave * TR_SCR);
    const int gw = F.vcu * NWAVES + F.wave, NGW = F.G * NWAVES;
    bf16* W1T = (bf16*)(F.ws + WS_W1T); bf16* W2T = (bf16*)(F.ws + WS_W2T); bf16* XN2 = (bf16*)(F.ws + WS_XN2);
    constexpr int I_1 = (DM / 64) * (DFF / 64), I_2 = (DFF / 64) * (DM / 64);
    for (int it = gw; it < I_1 + I_2; it += NGW) {
        if (it < I_1) tr_item(w_ff1, DM, DFF, W1T, scr, it, F.lane, false); else tr_item(w_ff2, DFF, DM, W2T, scr, it - I_1, F.lane, false);
    }
    for (int m = gw; m < MROWS; m += NGW) rms_row_bf16(F.lane, F.out + (size_t)m * DM, n2g, XN2 + (size_t)m * DM);
}
__device__ __forceinline__ void p10_final(Frame& F, const float* nfg) {
    const int gw = F.vcu * NWAVES + F.wave, NGW = F.G * NWAVES;
    for (int m = gw; m < MROWS; m += NGW) rms_row_f32(F.lane, F.out + (size_t)m * DM, nfg, F.out + (size_t)m * DM);
}
struct Args { const float* in[17]; float* out; unsigned char* ws; int ph_lo, ph_hi, li, pad; };
__global__ void __launch_bounds__(NWAVES * 64, 2) hybrid_fwd(Args args) {
    extern __shared__ __attribute__((aligned(16))) unsigned char lds[];
    Frame F;
    F.lds = (LAS unsigned char*)lds;
    F.MISC = (volatile LAS unsigned*)(F.lds + MISC_OFF);
    F.tid = threadIdx.x; F.lane = F.tid & 63; F.wave = __builtin_amdgcn_readfirstlane(F.tid >> 6);
    F.G = gridDim.x; { const int bx = blockIdx.x; F.vcu = (F.G % 8 == 0) ? (bx % 8) * (F.G / 8) + bx / 8 : bx; }
    F.ws = args.ws; F.ctl = (gu32*)(args.ws + WS_CTL);
    F.out = args.out;
    if (F.tid < 64) ((LAS unsigned*)(F.lds + MISC_OFF))[F.tid] = 0u;
    __syncthreads();
    XcdBarrier bar; bar.bar = (unsigned*)(F.ctl + CW_BAR); bar.x = 0; bar.st = nullptr;
    if (N_LAUNCHES != PER_PHASE) bar = xcd_barrier_post((unsigned*)(F.ctl + CW_BAR), F.MISC + 8);
#define GRID_BAR() do { if (N_LAUNCHES != PER_PHASE) xcd_barrier(bar); } while (0)
    const int lo = args.ph_lo, hi = args.ph_hi;
#ifndef PHASE_MASK
#define PHASE_MASK 0x7ff
#endif
#define IN(k) (((PHASE_MASK >> (k)) & 1) && lo <= (k) && (k) < hi)
#define BOTH(k) (IN(k) && IN((k) + 1))
    bf16* PROJ = (bf16*)(F.ws + WS_PROJ);

    if (IN(0)) { p0_prologue(F, args.in[0], args.in[1], args.in[2], args.in[10], args.in[11], args.in[12]); if (BOTH(0)) GRID_BAR(); }
    if (IN(1)) {
        pg8::Gemm g{(const bf16*)(F.ws + WS_XN), (const bf16*)(F.ws + WS_WIN), MROWS, 11264, DM}; pg8::StaticOrder S; S.init(MROWS, 11264, F.G, (int)blockIdx.x);
        pg8::EpiProj E{PROJ, (float*)(F.ws + WS_GATES)};
        pg8::gemm_phase<pg8::EpiProj, pg8::StaticOrder, true, true>(F.lds, g, S, E);
        gate_gemm(F);
        if (BOTH(1)) GRID_BAR();
    }
    if (IN(2)) { p2_conv(F, args.in[6]); if (BOTH(2)) GRID_BAR(); }
    if (IN(3)) {
        const int u = F.vcu;
        if (u < 128) { if (args.pad != 2) mlstm_unit(F, u, args.in[3], args.in[4]); }
        else if (u < 256) { if (args.pad != 1) delta_unit(F, u - 128, args.in[7], args.in[8]); }
        if (BOTH(3)) GRID_BAR();
    }
    if (IN(4)) { p4_combine(F, args.in[5], args.in[9]); if (BOTH(4)) GRID_BAR(); }
    if (IN(5)) {
        pg8::Gemm g{(const bf16*)(F.ws + WS_YM), (const bf16*)(F.ws + WS_WBM), 2 * MROWS, 4096, 1024}; pg8::BranchOrder S; S.init(F.G, (int)blockIdx.x);
        pg8::EpiBranch E{PROJ, (bf16*)(F.ws + WS_MIX)};
        pg8::gemm_phase<pg8::EpiBranch, pg8::BranchOrder, true, true>(F.lds, g, S, E);
        if (BOTH(5)) GRID_BAR();
    }
    if (IN(6)) {
        pg8::Gemm g{(const bf16*)(F.ws + WS_MIX), (const bf16*)(F.ws + WS_WOUT), MROWS, DM, DM}; pg8::StaticOrder S; S.init(MROWS, DM, F.G, (int)blockIdx.x);
        pg8::EpiResid E{args.in[0], F.out, DM};
        pg8::gemm_phase<pg8::EpiResid, pg8::StaticOrder, true, true>(F.lds, g, S, E);
        if (BOTH(6)) GRID_BAR();
    }
    if (IN(7)) { p7_norm2(F, args.in[13], args.in[14], args.in[15]); if (BOTH(7)) GRID_BAR(); }
    if (IN(8)) {
        pg8::Gemm g{(const bf16*)(F.ws + WS_XN2), (const bf16*)(F.ws + WS_W1T), MROWS, DFF, DM}; pg8::StaticOrder S; S.init(MROWS, DFF, F.G, (int)blockIdx.x);
        pg8::EpiRelu2 E{(bf16*)(F.ws + WS_HFF), DFF};
        pg8::gemm_phase<pg8::EpiRelu2, pg8::StaticOrder, true, true>(F.lds, g, S, E);
        if (BOTH(8)) GRID_BAR();
    }
    if (IN(9)) {
        pg8::Gemm g{(const bf16*)(F.ws + WS_HFF), (const bf16*)(F.ws + WS_W2T), MROWS, DM, DFF}; pg8::StaticOrder S; S.init(MROWS, DM, F.G, (int)blockIdx.x);
        pg8::EpiResid E{F.out, F.out, DM};
        pg8::gemm_phase<pg8::EpiResid, pg8::StaticOrder, true, true>(F.lds, g, S, E);
        if (BOTH(9)) GRID_BAR();
    }
    if (IN(10)) { p10_final(F, args.in[16]); }
#undef IN
#undef BOTH
}

extern "C" void kernel_launch(void* const* d_in, const int* in_sizes, int n_in, void* d_out, int out_size, void* d_ws, size_t ws_size, hipStream_t stream) {
    static int grid = 0;
    if (grid == 0) {
        if (n_in != 17 || in_sizes[0] != MROWS * DM || out_size != MROWS * DM || ws_size < WS_END) {
            fprintf(stderr, "kernel_launch: unexpected problem: n_in %d, in0 %d, out %d, ws %zu (need %zu); nothing launched\n", n_in, n_in > 0 ? in_sizes[0] : -1, out_size, ws_size, (size_t)WS_END); grid = -1; return; }
        int dev = 0, cus = 0, per_cu = 0;
        if (hipGetDevice(&dev) != hipSuccess || hipDeviceGetAttribute(&cus, hipDeviceAttributeMultiprocessorCount, dev) != hipSuccess) { fprintf(stderr, "kernel_launch: device query failed\n"); grid = -1; return; }
        if (hipFuncSetAttribute((const void*)hybrid_fwd, hipFuncAttributeMaxDynamicSharedMemorySize, LDS_BYTES) != hipSuccess) { fprintf(stderr, "kernel_launch: hipFuncSetAttribute failed\n"); grid = -1; return; }
        if (hipOccupancyMaxActiveBlocksPerMultiprocessor(&per_cu, (const void*)hybrid_fwd, NWAVES * 64, LDS_BYTES) != hipSuccess || per_cu < 1)
            fprintf(stderr, "kernel_launch: note: occupancy query reports %d workgroups per CU\n", per_cu);
        (void)hipGetLastError();
        grid = cus;
    }
    if (grid < 0) return;
    if (hipMemsetAsync((char*)d_ws + WS_CTL, 0, CTL_ZERO_BYTES, stream) != hipSuccess) { fprintf(stderr, "kernel_launch: memset failed\n"); return; }
    Args a{};
    for (int i = 0; i < 17; ++i) a.in[i] = (const float*)d_in[i];
    a.out = (float*)d_out; a.ws = (unsigned char*)d_ws;
#ifdef PROBE_PH
    const int nl = 2; const int plo[2] = {0, PROBE_PH}, phi[2] = {PROBE_PH + 1, PER_PHASE};
#else
    const int nl = N_LAUNCHES; const int plo[2] = {0, 0}, phi[2] = {PER_PHASE, PER_PHASE};
#endif
    for (int li = 0; li < nl; ++li) {
        if (li > 0 && N_LAUNCHES != PER_PHASE) (void)hipMemsetAsync((char*)d_ws + WS_CTL, 0, CTL_ZERO_BYTES, stream);
#ifdef PROBE_SKIP
        a.pad = (li == 1) ? PROBE_SKIP : 0;
#endif
        a.ph_lo = (N_LAUNCHES == PER_PHASE) ? li : plo[li & 1]; a.ph_hi = (N_LAUNCHES == PER_PHASE) ? li + 1 : phi[li & 1]; a.li = li;
        hipLaunchKernelGGL(hybrid_fwd, dim3(grid), dim3(NWAVES * 64), LDS_BYTES, stream, a);
        const hipError_t le = hipPeekAtLastError();
        if (le != hipSuccess) { fprintf(stderr, "kernel_launch: launch %d failed: %s\n", li, hipGetErrorName(le)); break; }
    }
}
```

```cpp
#include <hip/hip_runtime.h>
#include <cstdio>
#include <cstdint>

#ifndef MK_N_LAUNCHES
#define MK_N_LAUNCHES 1
#endif
constexpr int MROWS = 16384;
namespace pg8 {
#define PG8_LAS __attribute__((address_space(3)))
typedef unsigned short bf16_t;
typedef short bf16x8 __attribute__((ext_vector_type(8)));
typedef float f32x4 __attribute__((ext_vector_type(4)));
typedef unsigned u32x4 __attribute__((ext_vector_type(4)));
constexpr int BM = 256, BK = 64, HALF = 128, HTB = HALF * BK * 2  , STAGE_BYTES = 8 * HTB, NXCD = 8, WGM = 8;

__host__ __device__ __forceinline__ int lds_byte(int r, int c) { const int st = (r >> 4) * 2 + (c >> 5), rr = r & 15, cc = c & 31, ob = rr * 64 + cc * 2; return st * 1024 + (ob ^ (((ob >> 9) & 1) << 5)); }
__host__ __device__ __forceinline__ void stage_rc(int b, int& R, int& C) { const int st = b / 1024, sb = b % 1024, swz = sb ^ (((sb >> 9) & 1) << 5); R = (st >> 1) * 16 + swz / 64; C = (st & 1) * 32 + (swz % 64) / 2; }
__host__ __device__ __forceinline__ int perm32(int rho) { const int n = rho >> 4, i = rho & 15; return 8 * (i >> 2) + 4 * n + (i & 3); }

struct Unit { int pm, pn; };
struct Gemm { const bf16_t* A; const bf16_t* Bt; int M, N, K; };

struct StaticOrder {
    int nM, nN, nwg, G, c;
    __host__ __device__ void init(int M, int N, int G_, int c_) { nM = M / BM; nN = N / BM; nwg = nM * nN; G = G_; c = c_; }
    __host__ __device__ bool next(int i, Unit& u) const {
        const long L = (long)i * G + c; if (L >= nwg) return false;
        int wgid = (int)L; { const int q = nwg / NXCD, r = nwg % NXCD, xcd = wgid % NXCD, off = wgid / NXCD; wgid = (xcd < r ? xcd * (q + 1) : r * (q + 1) + (xcd - r) * q) + off; }
        const int nig = WGM * nN, gid = wgid / nig, fm = gid * WGM, gsz = (nM - fm) < WGM ? (nM - fm) : WGM;
        u.pm = fm + ((wgid % nig) % gsz); u.pn = (wgid % nig) / gsz; return true;
    }
    __device__ __forceinline__ void a_ready(const Unit&) const {}
    __device__ __forceinline__ void done(const Unit&) const {}
};

__device__ __forceinline__ unsigned cvt_pk_bf16(float lo, float hi) { unsigned r; asm volatile("v_cvt_pk_bf16_f32 %0, %1, %2" : "=v"(r) : "v"(lo), "v"(hi)); return r; }
typedef float f32x2 __attribute__((ext_vector_type(2)));
typedef unsigned u32x2 __attribute__((ext_vector_type(2)));
__device__ __forceinline__ float bf_lo(unsigned w) { return __uint_as_float(w << 16); }
__device__ __forceinline__ float bf_hi(unsigned w) { return __uint_as_float(w & 0xffff0000u); }
__device__ __forceinline__ float fsigmoid(float x) { return __builtin_amdgcn_rcpf(1.0f + __expf(-x)); }

struct EpiProj {
    static constexpr bool PERM = true, AFTER_DRAIN = false;
    bf16_t* P; float* gates;
    __device__ __forceinline__ void operator()(const f32x4 (&acc)[2][2][4][2], const Unit& u, int wr, int wc, int fr, int fq) const {
        const int row0 = u.pm * BM + wr * 64 + fr;
        if (u.pn < 44) {
            bf16_t* base = P + (size_t)u.pn * ((size_t)MROWS * 256) + wc * 32 + 8 * fq;
#pragma unroll
            for (int ai = 0; ai < 2; ++ai)
#pragma unroll
                for (int m = 0; m < 4; ++m) { bf16_t* rowp = base + (size_t)(row0 + ai * HALF + m * 16) * 256;
#pragma unroll
                    for (int bj = 0; bj < 2; ++bj) { const f32x4 v0 = acc[ai][bj][m][0], v1 = acc[ai][bj][m][1];
                        u32x4 w; w.x = cvt_pk_bf16(v0[0], v0[1]); w.y = cvt_pk_bf16(v0[2], v0[3]); w.z = cvt_pk_bf16(v1[0], v1[1]); w.w = cvt_pk_bf16(v1[2], v1[3]);
                        *(u32x4*)(rowp + bj * HALF) = w; } }
        } else if (wc < 2) {
#pragma unroll
            for (int ai = 0; ai < 2; ++ai)
#pragma unroll
                for (int m = 0; m < 4; ++m) { float* rp = gates + (size_t)(row0 + ai * HALF + m * 16) * 64 + wc * 32 + 8 * fq;
                    *(f32x4*)rp = acc[ai][0][m][0]; *(f32x4*)(rp + 4) = acc[ai][0][m][1]; }
        }
    }
};

struct EpiBranch {
    static constexpr bool PERM = true, AFTER_DRAIN = false;
    const bf16_t* G; bf16_t* O;
    __device__ __forceinline__ void operator()(const f32x4 (&acc)[2][2][4][2], const Unit& u, int wr, int wc, int fr, int fq) const {
        const int br = u.pn >> 3, pn = u.pn & 7, pm = u.pm & 63;
        const int row0 = pm * BM + wr * 64 + fr, cl = wc * 32 + 8 * fq;
        const bf16_t* gbase = G + (size_t)(28 + 8 * br + pn) * ((size_t)MROWS * 256) + cl;
        bf16_t* obase = O + pn * 256 + cl;
#pragma unroll
        for (int ai = 0; ai < 2; ++ai)
#pragma unroll
            for (int m = 0; m < 4; ++m) { const size_t r = (size_t)(row0 + ai * HALF + m * 16);
#pragma unroll
                for (int bj = 0; bj < 2; ++bj) {
                    const u32x4 gv = *(const u32x4*)(gbase + r * 256 + bj * HALF);
                    const f32x4 a0 = acc[ai][bj][m][0], a1 = acc[ai][bj][m][1];
                    float v[8];
                    v[0] = a0[0] * fsigmoid(bf_lo(gv.x)); v[1] = a0[1] * fsigmoid(bf_hi(gv.x)); v[2] = a0[2] * fsigmoid(bf_lo(gv.y)); v[3] = a0[3] * fsigmoid(bf_hi(gv.y));
                    v[4] = a1[0] * fsigmoid(bf_lo(gv.z)); v[5] = a1[1] * fsigmoid(bf_hi(gv.z)); v[6] = a1[2] * fsigmoid(bf_lo(gv.w)); v[7] = a1[3] * fsigmoid(bf_hi(gv.w));
                    bf16_t* op = obase + r * 2048 + bj * HALF;
                    if (br) { const u32x4 pv = *(const u32x4*)op;
                        v[0] += bf_lo(pv.x); v[1] += bf_hi(pv.x); v[2] += bf_lo(pv.y); v[3] += bf_hi(pv.y); v[4] += bf_lo(pv.z); v[5] += bf_hi(pv.z); v[6] += bf_lo(pv.w); v[7] += bf_hi(pv.w); }
                    u32x4 w; w.x = cvt_pk_bf16(v[0], v[1]); w.y = cvt_pk_bf16(v[2], v[3]); w.z = cvt_pk_bf16(v[4], v[5]); w.w = cvt_pk_bf16(v[6], v[7]);
                    *(u32x4*)op = w; } }
    }
};
struct BranchOrder {
    StaticOrder so;
    __host__ __device__ void init(int G_, int c_) { so.init(MROWS, 2048, G_, c_); }
    __host__ __device__ bool next(int i, Unit& u) const { Unit t; if (!so.next(i >> 1, t)) return false; const int br = i & 1; u.pm = t.pm + 64 * br; u.pn = t.pn + 8 * br; return true; }
    __device__ __forceinline__ void a_ready(const Unit&) const {}
    __device__ __forceinline__ void done(const Unit&) const {}
};

struct EpiResid {
    static constexpr bool PERM = false, AFTER_DRAIN = false;
    const float* base; float* out; int ldc;
    __device__ __forceinline__ void operator()(const f32x4 (&acc)[2][2][4][2], const Unit& u, int wr, int wc, int fr, int fq) const {
        const int col0 = u.pn * BM + wc * 32 + 4 * fq;
#pragma unroll
        for (int ai = 0; ai < 2; ++ai)
#pragma unroll
            for (int m = 0; m < 4; ++m) { const size_t off = (size_t)(u.pm * BM + ai * HALF + wr * 64 + m * 16 + fr) * ldc + col0;
#pragma unroll
                for (int bj = 0; bj < 2; ++bj)
#pragma unroll
                    for (int n = 0; n < 2; ++n) { const f32x4 bs = *(const f32x4*)(base + off + bj * HALF + n * 16); *(f32x4*)(out + off + bj * HALF + n * 16) = bs + acc[ai][bj][m][n]; } }
    }
};

struct EpiRelu2 {
    static constexpr bool PERM = true, AFTER_DRAIN = false;
    bf16_t* O; int ldc;
    __device__ __forceinline__ void operator()(const f32x4 (&acc)[2][2][4][2], const Unit& u, int wr, int wc, int fr, int fq) const {
        const int row0 = u.pm * BM + wr * 64 + fr, col0 = u.pn * BM + wc * 32 + 8 * fq;
#pragma unroll
        for (int ai = 0; ai < 2; ++ai)
#pragma unroll
            for (int m = 0; m < 4; ++m) { bf16_t* rowp = O + (size_t)(row0 + ai * HALF + m * 16) * ldc + col0;
#pragma unroll
                for (int bj = 0; bj < 2; ++bj) { f32x4 v0 = acc[ai][bj][m][0], v1 = acc[ai][bj][m][1];
#pragma unroll
                    for (int e = 0; e < 4; ++e) { const float a = fmaxf(v0[e], 0.f), b = fmaxf(v1[e], 0.f); v0[e] = a * a; v1[e] = b * b; }
                    u32x4 w; w.x = cvt_pk_bf16(v0[0], v0[1]); w.y = cvt_pk_bf16(v0[2], v0[3]); w.z = cvt_pk_bf16(v1[0], v1[1]); w.w = cvt_pk_bf16(v1[2], v1[3]);
                    *(u32x4*)(rowp + bj * HALF) = w; } }
    }
};
template <class Epi, class Sched, bool ALIGN_EPI = false, bool SP2 = false>
__device__ __forceinline__ void gemm_phase(PG8_LAS unsigned char* lds, const Gemm g, const Sched& S, const Epi& E) {
    const int tid = threadIdx.x, wid = __builtin_amdgcn_readfirstlane(tid >> 6), lane = tid & 63, wr = wid >> 2, wc = wid & 3, fr = lane & 15, fq = lane >> 4;
    const int K = g.K, nt = K / BK;
    unsigned voffA[2], voffB[2];
#pragma unroll
    for (int i = 0; i < 2; ++i) { int R, C; stage_rc(tid * 16 + i * 8192, R, C); const int Rb = Epi::PERM ? ((R & ~31) + perm32(R & 31)) : R;
        voffA[i] = (unsigned)(R * K + C) * 2u; voffB[i] = (unsigned)(Rb * K + C) * 2u; }
    const size_t kstep = (size_t)(BK * 2);
    const size_t hstep = (size_t)HALF * K * 2;
    const size_t tstep = 2 * hstep;
    const unsigned ldsw = (unsigned)wid * 1024u;
    const int aoff = lds_byte(wr * 64 + fr, fq * 8), boff = lds_byte(wc * 32 + fr, fq * 8);
#define PG8_SA(b, h) (((b) * 2 + (h)) * HTB)
#define PG8_SB(b, h) ((4 + (b) * 2 + (h)) * HTB)
#define PG8_STAGE(bufoff, gbase, voff) do { _Pragma("unroll") for (int _i = 0; _i < 2; ++_i) \
        __builtin_amdgcn_global_load_lds((const unsigned*)((const char*)(gbase) + (voff)[_i]), (PG8_LAS unsigned*)(lds + (bufoff) + ldsw + _i * 8192), 16, 0, 0); } while (0)
#define PG8_LDA(dst, b, h) do { _Pragma("unroll") for (int m = 0; m < 4; ++m) _Pragma("unroll") for (int k = 0; k < 2; ++k) dst[m][k] = *(const PG8_LAS bf16x8*)(lds + PG8_SA(b, h) + aoff + m * 2048 + k * 1024); } while (0)
#define PG8_LDB(dst, b, h) do { _Pragma("unroll") for (int n = 0; n < 2; ++n) _Pragma("unroll") for (int k = 0; k < 2; ++k) dst[n][k] = *(const PG8_LAS bf16x8*)(lds + PG8_SB(b, h) + boff + n * 2048 + k * 1024); } while (0)
#define PG8_MMA(ai, bj, At, Bt) do { __builtin_amdgcn_s_setprio(1); _Pragma("unroll") for (int m = 0; m < 4; ++m) _Pragma("unroll") for (int n = 0; n < 2; ++n) _Pragma("unroll") for (int k = 0; k < 2; ++k) \
        acc[ai][bj][m][n] = __builtin_amdgcn_mfma_f32_16x16x32_bf16(Bt[n][k], At[m][k], acc[ai][bj][m][n], 0, 0, 0); __builtin_amdgcn_s_setprio(0); } while (0)
#define PG8_WAIT_V(n) asm volatile("s_waitcnt vmcnt(" #n ")" ::: "memory")
#define PG8_WAIT_L(n) asm volatile("s_waitcnt lgkmcnt(" #n ")" ::: "memory")
#define PG8_BAR __builtin_amdgcn_s_barrier()
#define PG8_SCHED __builtin_amdgcn_sched_barrier(0)
    Unit cur, nxt; int ui = 0;
    if (!S.next(0, cur)) return;
    f32x4 acc[2][2][4][2];
#pragma unroll
    for (int a = 0; a < 2; ++a)
#pragma unroll
        for (int b = 0; b < 2; ++b)
#pragma unroll
            for (int m = 0; m < 4; ++m)
#pragma unroll
                for (int n = 0; n < 2; ++n) acc[a][b][m][n] = (f32x4){0.f, 0.f, 0.f, 0.f};
    bf16x8 At[4][2], B0[2][2], B1[2][2];
    const char* cA = (const char*)g.A + (size_t)cur.pm * tstep; const char* cB = (const char*)g.Bt + (size_t)cur.pn * tstep;
    S.a_ready(cur);
    if constexpr (SP2) {
        PG8_STAGE(PG8_SB(0, 0), cB, voffB); PG8_STAGE(PG8_SB(0, 1), cB + hstep, voffB); PG8_STAGE(PG8_SA(0, 0), cA, voffA); PG8_STAGE(PG8_SA(0, 1), cA + hstep, voffA);
        if (wr == 1) PG8_BAR;
        PG8_WAIT_V(2); PG8_BAR;
        PG8_STAGE(PG8_SB(1, 0), cB + kstep, voffB); PG8_STAGE(PG8_SA(1, 0), cA + kstep, voffA); PG8_STAGE(PG8_SB(1, 1), cB + hstep + kstep, voffB);
        PG8_WAIT_V(6); PG8_BAR;
    } else {
        PG8_STAGE(PG8_SB(0, 0), cB, voffB); PG8_STAGE(PG8_SA(0, 0), cA, voffA); PG8_STAGE(PG8_SB(0, 1), cB + hstep, voffB); PG8_STAGE(PG8_SA(0, 1), cA + hstep, voffA);
        if (wr == 1) PG8_BAR;
        PG8_WAIT_V(4); PG8_BAR;
        PG8_STAGE(PG8_SB(1, 0), cB + kstep, voffB); PG8_STAGE(PG8_SA(1, 0), cA + kstep, voffA); PG8_STAGE(PG8_SB(1, 1), cB + hstep + kstep, voffB);
        PG8_WAIT_V(6); PG8_BAR;
    }
    for (;;) {
        const bool has_next = S.next(ui + 1, nxt);
        const char* nA = has_next ? (const char*)g.A + (size_t)nxt.pm * tstep : cA; const char* nB = has_next ? (const char*)g.Bt + (size_t)nxt.pn * tstep : cB;
        for (int t = 0; t < nt; t += 2) {
            const bool last = (t == nt - 2);
            const char* a1 = cA + (size_t)(t + 1) * kstep;
            const char* a2 = last ? nA : cA + (size_t)(t + 2) * kstep; const char* b2 = last ? nB : cB + (size_t)(t + 2) * kstep;
            const char* a3 = a2 + kstep; const char* b3 = b2 + kstep;
            if (last && has_next) S.a_ready(nxt);
            if constexpr (SP2) {
            PG8_LDB(B0, 0, 0); PG8_LDB(B1, 0, 1); PG8_SCHED; PG8_LDA(At, 0, 0); PG8_STAGE(PG8_SA(1, 1), a1 + hstep, voffA);
            PG8_WAIT_V(8); PG8_WAIT_L(0); PG8_BAR; PG8_MMA(0, 0, At, B0); PG8_MMA(0, 1, At, B1); PG8_BAR; PG8_SCHED;
            PG8_LDA(At, 0, 1); PG8_STAGE(PG8_SB(0, 0), b2, voffB); PG8_STAGE(PG8_SB(0, 1), b2 + hstep, voffB); PG8_STAGE(PG8_SA(0, 0), a2, voffA);
            PG8_WAIT_V(8); PG8_WAIT_L(0); PG8_BAR; PG8_MMA(1, 0, At, B0); PG8_MMA(1, 1, At, B1); PG8_BAR; PG8_SCHED;
            PG8_LDB(B0, 1, 0); PG8_LDB(B1, 1, 1); PG8_SCHED; PG8_LDA(At, 1, 0); PG8_STAGE(PG8_SA(0, 1), a2 + hstep, voffA);
            PG8_WAIT_V(8); PG8_WAIT_L(0); PG8_BAR; PG8_MMA(0, 0, At, B0); PG8_MMA(0, 1, At, B1); PG8_BAR; PG8_SCHED;
            PG8_LDA(At, 1, 1); PG8_STAGE(PG8_SB(1, 0), b3, voffB); PG8_STAGE(PG8_SB(1, 1), b3 + hstep, voffB); PG8_STAGE(PG8_SA(1, 0), a3, voffA);
            PG8_WAIT_V(8); PG8_WAIT_L(0); PG8_BAR; PG8_MMA(1, 0, At, B0); PG8_MMA(1, 1, At, B1); PG8_BAR; PG8_SCHED;
            } else {
            PG8_LDB(B0, 0, 0); PG8_SCHED; PG8_LDA(At, 0, 0); PG8_STAGE(PG8_SA(1, 1), a1 + hstep, voffA);
            PG8_WAIT_L(8); PG8_BAR; PG8_WAIT_L(0); PG8_MMA(0, 0, At, B0); PG8_BAR; PG8_SCHED;
            PG8_LDB(B1, 0, 1); PG8_STAGE(PG8_SB(0, 0), b2, voffB);
            PG8_BAR; PG8_WAIT_L(0); PG8_MMA(0, 1, At, B1); PG8_BAR;
            PG8_LDA(At, 0, 1); PG8_STAGE(PG8_SA(0, 0), a2, voffA);
            PG8_BAR; PG8_WAIT_L(0); PG8_MMA(1, 0, At, B0); PG8_BAR; PG8_SCHED;
            PG8_STAGE(PG8_SB(0, 1), b2 + hstep, voffB);
            PG8_WAIT_V(6); PG8_BAR; PG8_MMA(1, 1, At, B1); PG8_BAR;
            PG8_LDB(B0, 1, 0); PG8_SCHED; PG8_LDA(At, 1, 0); PG8_STAGE(PG8_SA(0, 1), a2 + hstep, voffA);
            PG8_WAIT_L(8); PG8_BAR; PG8_WAIT_L(0); PG8_MMA(0, 0, At, B0); PG8_BAR; PG8_SCHED;
            PG8_LDB(B1, 1, 1); PG8_STAGE(PG8_SB(1, 0), b3, voffB);
            PG8_BAR; PG8_WAIT_L(0); PG8_MMA(0, 1, At, B1); PG8_BAR;
            PG8_LDA(At, 1, 1); PG8_STAGE(PG8_SA(1, 0), a3, voffA);
            PG8_BAR; PG8_WAIT_L(0); PG8_MMA(1, 0, At, B0); PG8_BAR; PG8_SCHED;
            PG8_STAGE(PG8_SB(1, 1), b3 + hstep, voffB);
            PG8_WAIT_V(6); PG8_BAR; PG8_MMA(1, 1, At, B1); PG8_BAR;
            }
        }
        if constexpr (ALIGN_EPI) { if (wr == 0) PG8_BAR; }
        if constexpr (!Epi::AFTER_DRAIN) { E(acc, cur, wr, wc, fr, fq); S.done(cur); }
        if (!has_next) break;
#pragma unroll
        for (int a = 0; a < 2; ++a)
#pragma unroll
            for (int b = 0; b < 2; ++b)
#pragma unroll
                for (int m = 0; m < 4; ++m)
#pragma unroll
                    for (int n = 0; n < 2; ++n) acc[a][b][m][n] = (f32x4){0.f, 0.f, 0.f, 0.f};
        cur = nxt; cA = nA; cB = nB; ++ui;
        if constexpr (ALIGN_EPI) { if (wr == 1) PG8_BAR; }
    }
    PG8_WAIT_V(0);
    if constexpr (!ALIGN_EPI) { if (wr == 0) PG8_BAR; }
    PG8_BAR;
    if constexpr (Epi::AFTER_DRAIN) { E.fused(acc, cur, wr, wc, fr, fq, lds, wid, lane); S.done(cur); }
#undef PG8_SA
#undef PG8_SB
#undef PG8_STAGE
#undef PG8_LDA
#undef PG8_LDB
#undef PG8_MMA
#undef PG8_WAIT_V
#undef PG8_WAIT_L
#undef PG8_BAR
#undef PG8_SCHED
}
}
constexpr int NWAVES = 8;
constexpr int N_LAUNCHES = MK_N_LAUNCHES;
constexpr int PER_PHASE = 11;
constexpr int SEQ = 2048, DM = 2048, DFF = 8192, NPROJ_IN = 11312, NPROJ_PAD = 11520;
constexpr float RMS_EPS = 1e-6f;
constexpr size_t MiB = 1u << 20;
constexpr size_t BLK = (size_t)MROWS * 256;
constexpr size_t WS_CTL = 0, CTL_ZERO_BYTES = 1 * MiB;
constexpr size_t WS_GATES = 1 * MiB, WS_WBM = 5 * MiB, WS_WBD = 9 * MiB, WS_WOUT = 13 * MiB, WS_PROJ = 21 * MiB, WS_WIN = 373 * MiB, WS_XN = 418 * MiB;
constexpr size_t WS_DQ = 373 * MiB, WS_DK = 405 * MiB, WS_DV = 437 * MiB;
constexpr size_t WS_HM = 117 * MiB, WS_ODF = 181 * MiB, WS_ODB = 469 * MiB;
constexpr size_t WS_YM = 21 * MiB, WS_YD = 53 * MiB, WS_MIX = 373 * MiB;
constexpr size_t WS_XN2 = 437 * MiB, WS_W1T = 21 * MiB, WS_W2T = 53 * MiB, WS_HFF = 117 * MiB, WS_END = 501 * MiB;
constexpr int CW_BAR = 4096;
constexpr int LDS_BYTES = 163840;
constexpr int MISC_OFF = LDS_BYTES - 256;

#define GAS __attribute__((address_space(1)))
#define LAS __attribute__((address_space(3)))
typedef unsigned short bf16;
typedef unsigned v4u __attribute__((ext_vector_type(4)));
typedef unsigned v2u __attribute__((ext_vector_type(2)));
typedef float f32x4 __attribute__((ext_vector_type(4)));
typedef short bf16x8 __attribute__((ext_vector_type(8)));
typedef GAS unsigned gu32;
#define RLX_AGENT __ATOMIC_RELAXED, __HIP_MEMORY_SCOPE_AGENT
#define LDS_WAIT() asm volatile("s_waitcnt lgkmcnt(0)" ::: "memory")
#define VM_WAIT() asm volatile("s_waitcnt vmcnt(0)" ::: "memory")
__device__ __forceinline__ unsigned f2bf(float f) { unsigned u = __builtin_bit_cast(unsigned, f); return (u + 0x7fffu + ((u >> 16) & 1u)) >> 16; }
typedef float f32x2v_ __attribute__((ext_vector_type(2)));
typedef __bf16 bf16x2v_ __attribute__((ext_vector_type(2)));
__device__ __forceinline__ unsigned pk2(float lo, float hi) { const f32x2v_ v = {lo, hi}; return __builtin_bit_cast(unsigned, __builtin_convertvector(v, bf16x2v_)); }
__device__ __forceinline__ float bflo(unsigned w) { return __uint_as_float(w << 16); }
__device__ __forceinline__ float bfhi(unsigned w) { return __uint_as_float(w & 0xffff0000u); }
__device__ __forceinline__ float bfel(const v4u& v, int i) { const unsigned w = v[i >> 1]; return (i & 1) ? bfhi(w) : bflo(w); }
#define MFMA16(a, b, c) __builtin_amdgcn_mfma_f32_16x16x32_bf16((a), (b), (c), 0, 0, 0)
__device__ __forceinline__ bf16x8 ldfrag(const LAS unsigned char* p) { return *(const LAS bf16x8*)p; }
__device__ __forceinline__ void st8(LAS unsigned char* p, const f32x4& v) { v2u w; w.x = pk2(v[0], v[1]); w.y = pk2(v[2], v[3]); *(LAS v2u*)p = w; }
#define XB_TMO      128
#define XB_XCNT(j)  (256  + 64 * (j))
#define XB_XSUB(j)  (1280 + 64 * (j))
#define XB_XGEN(j)  (2304 + 64 * (j))
#define XB_TOP      3328
#define XB_TOPGEN   3392
#define XCD_BAR_WORDS 3456
#define XB_SPIN_CAP (1u << 18)

__device__ __forceinline__ unsigned xb_ld(unsigned* p)              { return __hip_atomic_load(p, __ATOMIC_RELAXED, __HIP_MEMORY_SCOPE_AGENT); }
__device__ __forceinline__ unsigned xb_add(unsigned* p, unsigned v) { return __hip_atomic_fetch_add(p, v, __ATOMIC_RELAXED, __HIP_MEMORY_SCOPE_AGENT); }
__device__ __forceinline__ unsigned xb_xcc_id() { return (unsigned)__builtin_amdgcn_s_getreg((3 << 11) | 20) & 0xFu; }
#define XB_SPIN(cond, bar) do { unsigned _sp = 0; while (cond) { __builtin_amdgcn_s_sleep(1); \
    if ((++_sp & 255u) == 0u) { if (xb_ld(&(bar)[XB_TMO])) break; if (_sp > XB_SPIN_CAP) { atomicAdd(&(bar)[XB_TMO], 1u); break; } } } } while (0)

struct XcdBarrier {
    unsigned* bar; unsigned x;
    volatile LAS unsigned* st;
};

__device__ __forceinline__ XcdBarrier xcd_barrier_post(unsigned* bar, volatile LAS unsigned* st) {
    XcdBarrier b; b.bar = bar; b.x = xb_xcc_id(); b.st = st;
    if (threadIdx.x == 0) (void)xb_add(&bar[XB_XCNT(b.x)], 1u);
    return b;
}
__device__ __forceinline__ void xcd_barrier_complete(unsigned* bar, unsigned x, unsigned& nloc, unsigned& nx) {
    const unsigned G = gridDim.x * gridDim.y * gridDim.z;
    unsigned sum, cnt, mine, sp = 0u;
    for (;;) {
        sum = 0u; cnt = 0u; mine = 0u;
#pragma unroll
        for (unsigned j = 0; j < 16; ++j) { const unsigned c = xb_ld(&bar[XB_XCNT(j)]); sum += c; cnt += (c > 0u) ? 1u : 0u; mine = (j == x) ? c : mine; }
        if (sum == G) break;
        __builtin_amdgcn_s_sleep(1);
        if ((++sp & 255u) == 0u) { if (xb_ld(&bar[XB_TMO])) break; if (sp > XB_SPIN_CAP) { atomicAdd(&bar[XB_TMO], 1u); break; } }
    }
    nloc = mine > 0u ? mine : 1u; nx = cnt > 0u ? cnt : 1u;
}

__device__ __forceinline__ void xcd_barrier(const XcdBarrier& b) {
    asm volatile("s_waitcnt vmcnt(0)" ::: "memory");
    __syncthreads();
    if (threadIdx.x == 0) {
        unsigned* bar = b.bar;
        __builtin_amdgcn_s_waitcnt(0);
        unsigned nloc = b.st[0], nx = b.st[1];
        if (nloc == 0u) { xcd_barrier_complete(bar, b.x, nloc, nx); b.st[0] = nloc; b.st[1] = nx; }
        const unsigned old = xb_add(&bar[XB_XSUB(b.x)], 1u);
        const unsigned gen = old / nloc;
        if (old + 1u == (gen + 1u) * nloc) {
            __builtin_amdgcn_fence(__ATOMIC_RELEASE, "agent");
            asm volatile("s_waitcnt vmcnt(0)" ::: "memory");
            const unsigned og = xb_add(&bar[XB_TOP], 1u);
            const unsigned tg = og / nx;
            if (og + 1u == (tg + 1u) * nx) xb_add(&bar[XB_TOPGEN], 1u);
            else XB_SPIN(xb_ld(&bar[XB_TOPGEN]) == tg, bar);
            __builtin_amdgcn_fence(__ATOMIC_ACQUIRE, "agent");
            xb_add(&bar[XB_XGEN(b.x)], 1u);
            asm volatile("s_waitcnt vmcnt(0)" ::: "memory");
        } else {
            XB_SPIN(xb_ld(&bar[XB_XGEN(b.x)]) == gen, bar);
            __builtin_amdgcn_fence(__ATOMIC_ACQUIRE, "agent");
            asm volatile("s_waitcnt vmcnt(0)" ::: "memory");
        }
    }
    __syncthreads();
}
struct Frame {
    LAS unsigned char* lds;
    volatile LAS unsigned* MISC;
    gu32* ctl;
    int tid, lane, wave;
    int vcu, G;
    float* out;
    unsigned char* ws;
};
__device__ __forceinline__ float wave_sum(float v) {
#pragma unroll
    for (int o = 1; o < 64; o <<= 1) v += __shfl_xor(v, o);
    return v;
}
__device__ __forceinline__ int win_map(int n) {
    if (n < 3072) return n;
    if (n < 3088) return 11264 + (n - 3072);
    if (n < 7184) return n - 16;
    if (n < 7216) return 11264 + 16 + (n - 7184);
    return n - 48;
}
constexpr int TR_SCR = 64 * 65 * 4;
__device__ __forceinline__ void tr_item(const float* W, int K, int N, bf16* WT, LAS float* scr, int item, int lane, bool remap) {
    const int nblk = (N + 63) / 64, kb = item / nblk, nb = item % nblk, k0 = 64 * kb, n0 = 64 * nb;
    const int kr = lane >> 4, c4 = lane & 15, nn = n0 + 4 * c4; const bool okc = nn < N;
    f32x4 v[16];
#pragma unroll
    for (int i = 0; i < 16; ++i) v[i] = okc ? *(const f32x4*)(W + (size_t)(k0 + 4 * i + kr) * N + nn) : (f32x4){0.f, 0.f, 0.f, 0.f};
#pragma unroll
    for (int i = 0; i < 16; ++i) { LAS float* s = scr + (4 * i + kr) * 65 + 4 * c4; s[0] = v[i].x; s[1] = v[i].y; s[2] = v[i].z; s[3] = v[i].w; }
    LDS_WAIT(); asm volatile("" ::: "memory");
    const int j = lane >> 3, n8 = lane & 7;
#pragma unroll
    for (int p = 0; p < 8; ++p) { const int n = 8 * p + n8; const LAS float* s = scr + (8 * j) * 65 + n;
        v4u o; o.x = pk2(s[0 * 65], s[1 * 65]); o.y = pk2(s[2 * 65], s[3 * 65]); o.z = pk2(s[4 * 65], s[5 * 65]); o.w = pk2(s[6 * 65], s[7 * 65]);
        if (n0 + n < N) { const int row = remap ? win_map(n0 + n) : (n0 + n); *(v4u*)(WT + (size_t)row * K + k0 + 8 * j) = o; } }
    LDS_WAIT(); asm volatile("" ::: "memory");
}
__device__ __forceinline__ void rms_row_bf16(int lane, const float* xrow, const float* g, bf16* orow) {
    const f32x4* xr = (const f32x4*)xrow + lane; const f32x4* gr = (const f32x4*)g + lane;
    f32x4 v[8]; float s = 0.f;
#pragma unroll
    for (int j = 0; j < 8; ++j) { v[j] = xr[64 * j]; s += (v[j].x * v[j].x + v[j].y * v[j].y) + (v[j].z * v[j].z + v[j].w * v[j].w); }
    const float r = 1.0f / sqrtf(wave_sum(s) * (1.f / 2048.f) + RMS_EPS);
    v2u* o8 = (v2u*)orow + lane;
#pragma unroll
    for (int j = 0; j < 8; ++j) { const f32x4 gg = gr[64 * j]; v2u w; w.x = pk2(v[j].x * r * gg.x, v[j].y * r * gg.y); w.y = pk2(v[j].z * r * gg.z, v[j].w * r * gg.w); o8[64 * j] = w; }
}
__device__ __forceinline__ void rms_row_f32(int lane, const float* xrow, const float* g, float* orow) {
    const f32x4* xr = (const f32x4*)xrow + lane; const f32x4* gr = (const f32x4*)g + lane;
    f32x4 v[8]; float s = 0.f;
#pragma unroll
    for (int j = 0; j < 8; ++j) { v[j] = xr[64 * j]; s += (v[j].x * v[j].x + v[j].y * v[j].y) + (v[j].z * v[j].z + v[j].w * v[j].w); }
    const float r = 1.0f / sqrtf(wave_sum(s) * (1.f / 2048.f) + RMS_EPS);
    f32x4* o = (f32x4*)orow + lane;
#pragma unroll
    for (int j = 0; j < 8; ++j) { const f32x4 gg = gr[64 * j]; o[64 * j] = (v[j] * r) * gg; }
}

__device__ __forceinline__ void p0_prologue(Frame& F, const float* x, const float* n1g, const float* w_in, const float* w_bm, const float* w_bd, const float* w_out) {
    LAS float* scr = (LAS float*)(F.lds + F.wave * TR_SCR);
    const int gw = F.vcu * NWAVES + F.wave, NGW = F.G * NWAVES;
    bf16* WIN = (bf16*)(F.ws + WS_WIN); bf16* WBM = (bf16*)(F.ws + WS_WBM); bf16* WBD = (bf16*)(F.ws + WS_WBD); bf16* WOUT = (bf16*)(F.ws + WS_WOUT); bf16* XN = (bf16*)(F.ws + WS_XN);
    constexpr int I_IN = (DM / 64) * ((NPROJ_IN + 63) / 64), I_B = (1024 / 64) * (DM / 64), I_O = (DM / 64) * (DM / 64);
    constexpr int NITEMS = I_IN + 2 * I_B + I_O;
    for (int it = gw; it < NITEMS; it += NGW) {
        int r = it;
        if (r < I_IN) { tr_item(w_in, DM, NPROJ_IN, WIN, scr, r, F.lane, true); continue; } r -= I_IN;
        if (r < I_B) { tr_item(w_bm, 1024, DM, WBM, scr, r, F.lane, false); continue; } r -= I_B;
        if (r < I_B) { tr_item(w_bd, 1024, DM, WBD, scr, r, F.lane, false); continue; } r -= I_B;
        tr_item(w_out, DM, DM, WOUT, scr, r, F.lane, false);
    }
    { v4u* z = (v4u*)(WIN + (size_t)(11264 + 48) * DM); const int nz = (NPROJ_PAD - 11264 - 48) * DM / 8;
      for (int i = gw * 64 + F.lane; i < nz; i += NGW * 64) z[i] = (v4u){0u, 0u, 0u, 0u}; }
    for (int m = gw; m < MROWS; m += NGW) rms_row_bf16(F.lane, x + (size_t)m * DM, n1g, XN + (size_t)m * DM);
}

__device__ __forceinline__ void gate_gemm(Frame& F) {
    const int lane = F.lane, w = F.wave, fr = lane & 15, fq = lane >> 4;
    const bf16* XN = (const bf16*)(F.ws + WS_XN); const bf16* WG = (const bf16*)(F.ws + WS_WIN) + (size_t)11264 * DM;
    float* GATES = (float*)(F.ws + WS_GATES);
    LAS float* red = (LAS float*)F.lds;
    for (int blk = F.vcu; blk < MROWS / 64; blk += F.G) {
        f32x4 acc[4][4];
#pragma unroll
        for (int mt = 0; mt < 4; ++mt)
#pragma unroll
            for (int nt = 0; nt < 4; ++nt) acc[mt][nt] = (f32x4){0.f, 0.f, 0.f, 0.f};
        const char* ap = (const char*)XN + (size_t)(blk * 64 + fr) * (DM * 2) + w * 512 + fq * 16;
        const char* bp = (const char*)WG + (size_t)fr * (DM * 2) + w * 512 + fq * 16;
#pragma unroll
        for (int kb = 0; kb < 2; ++kb) {
            bf16x8 af[4][4], bfr[4][4];
#pragma unroll
            for (int ks = 0; ks < 4; ++ks)
#pragma unroll
                for (int t = 0; t < 4; ++t) { af[ks][t] = *(const bf16x8*)(ap + (size_t)t * 16 * (DM * 2) + (kb * 4 + ks) * 64); bfr[ks][t] = *(const bf16x8*)(bp + (size_t)t * 16 * (DM * 2) + (kb * 4 + ks) * 64); }
#pragma unroll
            for (int ks = 0; ks < 4; ++ks)
#pragma unroll
                for (int mt = 0; mt < 4; ++mt)
#pragma unroll
                    for (int nt = 0; nt < 4; ++nt) acc[mt][nt] = MFMA16(bfr[ks][nt], af[ks][mt], acc[mt][nt]);
        }
#pragma unroll
        for (int mt = 0; mt < 4; ++mt)
#pragma unroll
            for (int nt = 0; nt < 4; ++nt) *(LAS f32x4*)(red + ((w * 16 + mt * 4 + nt) * 64 + lane) * 4) = acc[mt][nt];
        __syncthreads();
#pragma unroll
        for (int i = 0; i < 2; ++i) { const int tile = w * 2 + i, mt = tile >> 2, nt = tile & 3;
            f32x4 o = (f32x4){0.f, 0.f, 0.f, 0.f};
#pragma unroll
            for (int ww = 0; ww < 8; ++ww) o += *(const LAS f32x4*)(red + ((ww * 16 + tile) * 64 + lane) * 4);
            *(f32x4*)(GATES + (size_t)(blk * 64 + mt * 16 + fr) * 64 + nt * 16 + 4 * fq) = o; }
        __syncthreads();
    }
}

__device__ __forceinline__ void p2_conv(Frame& F, const float* convw) {
    const int gw = F.vcu * NWAVES + F.wave, NGW = F.G * NWAVES, lane = F.lane, c = lane & 15, r4 = lane >> 4;
    const bf16* PROJ = (const bf16*)(F.ws + WS_PROJ);
    bf16* DQ = (bf16*)(F.ws + WS_DQ); bf16* DK = (bf16*)(F.ws + WS_DK); bf16* DV = (bf16*)(F.ws + WS_DV);
    constexpr int NIT = 24 * (MROWS / 32);
    for (int it = gw; it < NIT; it += NGW) {
        const int gI = it % 24, tb32 = it / 24, m0 = tb32 * 32 + r4 * 8, b = m0 >> 11, t0 = m0 & 2047;
        const int c0 = gI * 128;
        const bf16* src = PROJ + (size_t)(12 + (c0 >> 8)) * BLK + (c0 & 255) + 8 * c;
        v4u xr[12];
#pragma unroll
        for (int i = 0; i < 12; ++i) { const int tp = t0 - 2 + i; xr[i] = (v4u){0u, 0u, 0u, 0u};
            if (tp >= 0 && tp < SEQ) xr[i] = *(const v4u*)(src + (size_t)(b * SEQ + tp) * 256); }
        f32x4 cwl[5], cwh[5];
#pragma unroll
        for (int i = 0; i < 5; ++i) { const float* cp = convw + (size_t)i * 3072 + c0 + 8 * c; cwl[i] = *(const f32x4*)cp; cwh[i] = *(const f32x4*)(cp + 4); }
        bf16* dst = (gI < 8 ? DQ : (gI < 16 ? DK : DV)) + (size_t)m0 * 1024 + (c0 & 1023) + 8 * c;
#pragma unroll
        for (int o = 0; o < 8; ++o) {
            float y[8];
#pragma unroll
            for (int e = 0; e < 8; ++e) y[e] = 0.f;
#pragma unroll
            for (int i = 0; i < 5; ++i) { const v4u xv = xr[o + i];
                y[0] += cwl[i][0] * bflo(xv.x); y[1] += cwl[i][1] * bfhi(xv.x); y[2] += cwl[i][2] * bflo(xv.y); y[3] += cwl[i][3] * bfhi(xv.y);
                y[4] += cwh[i][0] * bflo(xv.z); y[5] += cwh[i][1] * bfhi(xv.z); y[6] += cwh[i][2] * bflo(xv.w); y[7] += cwh[i][3] * bfhi(xv.w); }
            float ss = 0.f;
#pragma unroll
            for (int e = 0; e < 8; ++e) { y[e] = y[e] / (1.0f + __expf(-y[e])); ss += y[e] * y[e]; }
            if (gI < 16) { ss += __shfl_xor(ss, 1); ss += __shfl_xor(ss, 2); ss += __shfl_xor(ss, 4); ss += __shfl_xor(ss, 8);
                float r = 1.0f / sqrtf(ss + 1e-6f); if (gI < 8) r *= 0.08838834764831845f;
#pragma unroll
                for (int e = 0; e < 8; ++e) y[e] *= r; }
            v4u ov; ov.x = pk2(y[0], y[1]); ov.y = pk2(y[2], y[3]); ov.z = pk2(y[4], y[5]); ov.w = pk2(y[6], y[7]);
            *(v4u*)(dst + (size_t)o * 1024) = ov;
        }
    }
}

#define WG_BAR() do { asm volatile("s_waitcnt lgkmcnt(0)" ::: "memory"); __builtin_amdgcn_s_barrier(); asm volatile("" ::: "memory"); } while (0)
typedef short s16x4 __attribute__((ext_vector_type(4)));
__device__ __forceinline__ bf16x8 ldfrag_tr(const LAS unsigned char* p, int RS) {
    const s16x4 lo = __builtin_amdgcn_ds_read_tr16_b64_v4i16((LAS s16x4*)p);
    const s16x4 hi = __builtin_amdgcn_ds_read_tr16_b64_v4i16((LAS s16x4*)(p + 4 * RS));
    return __builtin_shufflevector(lo, hi, 0, 1, 2, 3, 4, 5, 6, 7);
}
__device__ __forceinline__ int trofs(int lane, int RS) { const int i = lane & 15, g = lane >> 4; return (8 * g + (i >> 2)) * RS + 8 * (i & 3); }
template <int CTRL, int ROWMASK> __device__ __forceinline__ float dppf(float old, float src) {
    return __builtin_bit_cast(float, __builtin_amdgcn_update_dpp(__builtin_bit_cast(int, old), __builtin_bit_cast(int, src), CTRL, ROWMASK, 0xf, false)); }
__device__ __forceinline__ float wave_incl_sum(float v) {
    v += dppf<0x111, 0xf>(0.f, v); v += dppf<0x112, 0xf>(0.f, v); v += dppf<0x114, 0xf>(0.f, v); v += dppf<0x118, 0xf>(0.f, v);
    v += dppf<0x142, 0xa>(0.f, v); v += dppf<0x143, 0xc>(0.f, v); return v; }
__device__ __forceinline__ float wave_incl_max(float v) {
    const float NI = -3.0e38f;
    v = fmaxf(v, dppf<0x111, 0xf>(NI, v)); v = fmaxf(v, dppf<0x112, 0xf>(NI, v)); v = fmaxf(v, dppf<0x114, 0xf>(NI, v)); v = fmaxf(v, dppf<0x118, 0xf>(NI, v));
    v = fmaxf(v, dppf<0x142, 0xa>(NI, v)); v = fmaxf(v, dppf<0x143, 0xc>(NI, v)); return v; }
__device__ __forceinline__ float lane63(float v) { return __builtin_bit_cast(float, __builtin_amdgcn_readlane(__builtin_bit_cast(int, v), 63)); }
__device__ __forceinline__ v4u scale8(const v4u& v, float s) { v4u o; o.x = pk2(bflo(v.x) * s, bfhi(v.x) * s); o.y = pk2(bflo(v.y) * s, bfhi(v.y) * s); o.z = pk2(bflo(v.z) * s, bfhi(v.z) * s); o.w = pk2(bflo(v.w) * s, bfhi(v.w) * s); return o; }

#ifdef PROBE_SEG
#define TP(k) do { if (PROBE_SEG == (k)) tp0 = __builtin_amdgcn_s_memtime(); if (PROBE_SEG + PROBE_LEN == (k)) tpacc += __builtin_amdgcn_s_memtime() - tp0; } while (0)
#define TP_DECL unsigned long long tp0 = 0, tpacc = 0;
#define TP_SPIN(isunit0) do { if ((isunit0) && tid == 0) { const unsigned long long t1 = __builtin_amdgcn_s_memtime(), dt = (PROBE_SEG == 99) ? 1000000ull * PROBE_AMP : tpacc * PROBE_AMP; while (__builtin_amdgcn_s_memtime() - t1 < dt) __builtin_amdgcn_s_sleep(8); } } while (0)
#else
#define TP(k) do {} while (0)
#define TP_DECL
#define TP_SPIN(x) do {} while (0)
#endif
constexpr int ML_QP = 0, ML_KS = 26624, ML_KW = 45056, ML_VX = 62464, ML_CT = 81920, ML_CT_BYTES = 41472, ML_VEC = 123392, ML_VECN = 336;
constexpr float ML_SCALE = 0.08838834764831845f;
__device__ __forceinline__ void mlstm_unit(Frame& F, int unit, const float* m_ib, const float* m_fb) {
    const int tid = F.tid, lane = F.lane, w = F.wave, fr = lane & 15, fq = lane >> 4;
    const int half = unit & 1, dir = (unit >> 1) & 1, h = (unit >> 2) & 3, b = unit >> 4;
    LAS unsigned char* L = F.lds;
    LAS float* vec = (LAS float*)(L + ML_VEC);
    const int tro272 = trofs(lane, 272), tro304 = trofs(lane, 304);
    for (int i = tid; i < ML_CT_BYTES / 16; i += 512) ((LAS v4u*)(L + ML_CT))[i] = (v4u){0u, 0u, 0u, 0u};
    if (tid < 64) { *(LAS v4u*)(L + ML_VX + tid * 304 + 256) = (v4u){0x00003f80u, 0u, 0u, 0u}; *(LAS v4u*)(L + ML_VX + tid * 304 + 272) = (v4u){0u, 0u, 0u, 0u}; }
    f32x4 accS[9];
#pragma unroll
    for (int t = 0; t < 9; ++t) accS[t] = (f32x4){0.f, 0.f, 0.f, 0.f};
    float m_st = -1e30f;
    const bf16* PROJ = (const bf16*)(F.ws + WS_PROJ);
    const float* GATES = (const float*)(F.ws + WS_GATES);
    const bf16* Qg = PROJ + (size_t)(h >> 1) * BLK + (h & 1) * 128;
    const bf16* Kg = PROJ + (size_t)(2 + (h >> 1)) * BLK + (h & 1) * 128;
    const bf16* Vg = PROJ + (size_t)(4 + h) * BLK + half * 128;
    bf16* Hout = (bf16*)(F.ws + WS_HM) + (size_t)dir * MROWS * 1024 + h * 256 + half * 128;
    const float ib = m_ib[dir * 4 + h], fb = m_fb[dir * 4 + h];
    const int sr = tid >> 4, sc = tid & 15;
    v4u q[2], k[2], v[2];
    float g_i = 0.f, g_f = 0.f;
#define ML_GATES(vb_, ig_raw, f_raw) do { \
        const float ig_ = (ig_raw) + ib, fp_ = (f_raw) + fb; \
        const float lf_ = fp_ >= 0.f ? -__logf(1.0f + __expf(-fp_)) : fp_ - __logf(1.0f + __expf(fp_)); \
        const float bc_ = wave_incl_sum(lf_), a_ = ig_ - bc_, am_ = wave_incl_max(a_); \
        const float Ml_ = fmaxf(m_st, am_), M63_ = lane63(Ml_), bl_ = lane63(bc_); \
        (vb_)[lane] = a_; (vb_)[64 + lane] = Ml_; (vb_)[128 + lane] = __expf(-(bc_ + Ml_)); (vb_)[192 + lane] = __expf(m_st - Ml_) * ML_SCALE; (vb_)[256 + lane] = __expf(a_ - M63_); \
        if (lane == 0) (vb_)[320] = __expf(m_st - M63_); \
        m_st = bl_ + M63_; } while (0)
#define ML_LOADQKV(jj) do { _Pragma("unroll") for (int p = 0; p < 2; ++p) { const int tt_ = (jj) * 64 + sr + 32 * p, t_ = dir ? (SEQ - 1 - tt_) : tt_; const size_t mr_ = (size_t)(b * SEQ + t_); \
        q[p] = *(const v4u*)(Qg + mr_ * 256 + sc * 8); k[p] = *(const v4u*)(Kg + mr_ * 256 + sc * 8); v[p] = *(const v4u*)(Vg + mr_ * 256 + sc * 8); } } while (0)
#define ML_LOADG(jj) do { const int tt_ = (jj) * 64 + lane, t_ = dir ? (SEQ - 1 - tt_) : tt_; const size_t mr_ = (size_t)(b * SEQ + t_); g_i = GATES[mr_ * 64 + dir * 4 + h]; g_f = GATES[mr_ * 64 + 8 + dir * 4 + h]; } while (0)
    ML_LOADQKV(0);
    if (w == 0) { ML_LOADG(0); ML_GATES(vec, g_i, g_f); ML_LOADG(1); }
    __syncthreads();
    TP_DECL
    for (int j = 0; j < 32; ++j) {
        TP(0);
        LAS float* vb = vec + (j & 1) * ML_VECN;
#pragma unroll
        for (int p = 0; p < 2; ++p) { const int r = sr + 32 * p; const float wsr = vb[256 + r];
            *(LAS v4u*)(L + ML_QP + r * 416 + 128 + sc * 16) = q[p]; *(LAS v4u*)(L + ML_KS + r * 288 + sc * 16) = k[p];
            *(LAS v4u*)(L + ML_KW + r * 272 + sc * 16) = scale8(k[p], wsr); *(LAS v4u*)(L + ML_VX + r * 304 + sc * 16) = v[p]; }
        if (j + 1 < 32) ML_LOADQKV(j + 1);
        if (w == 0 && j + 1 < 32) { LAS float* vn = vec + ((j + 1) & 1) * ML_VECN; ML_GATES(vn, g_i, g_f); if (j + 2 < 32) ML_LOADG(j + 2); }
        TP(1); WG_BAR(); TP(2);
        {
            const int lt = w & 3, l = lt * 16 + fr; const float Ml = vb[64 + l];
#pragma unroll
            for (int s2 = 0; s2 < 2; ++s2) { const int st = (w >> 2) * 2 + s2;
                f32x4 acc = (f32x4){0.f, 0.f, 0.f, 0.f};
                if (st <= lt) {
#pragma unroll
                    for (int ks = 0; ks < 4; ++ks) acc = MFMA16(ldfrag(L + ML_KS + (st * 16 + fr) * 288 + ks * 64 + fq * 16), ldfrag(L + ML_QP + l * 416 + 128 + ks * 64 + fq * 16), acc); }
                f32x4 pv;
#pragma unroll
                for (int r = 0; r < 4; ++r) { const int s = st * 16 + 4 * fq + r; pv[r] = (s <= l) ? acc[r] * ML_SCALE * __expf(fminf(vb[s] - Ml, 0.f)) : 0.f; }
                st8(L + ML_QP + l * 416 + (st * 16 + 4 * fq) * 2, pv); }
        }
        TP(3); WG_BAR(); TP(4);
        {
            const int lt = w & 3, dq = w >> 2, l = lt * 16 + fr;
            f32x4 aPV[5], aQC[5];
#pragma unroll
            for (int t = 0; t < 5; ++t) { aPV[t] = (f32x4){0.f, 0.f, 0.f, 0.f}; aQC[t] = (f32x4){0.f, 0.f, 0.f, 0.f}; }
            bf16x8 bq[6];
#pragma unroll
            for (int ks = 0; ks < 6; ++ks) bq[ks] = ldfrag(L + ML_QP + l * 416 + ks * 64 + fq * 16);
#pragma unroll
            for (int t = 0; t < 5; ++t) { const int tile = (t < 4) ? (dq * 4 + t) : 8;
#pragma unroll
                for (int ks = 0; ks < 2; ++ks) aPV[t] = MFMA16(ldfrag_tr(L + ML_VX + (ks * 32) * 304 + tile * 32 + tro304, 304), bq[ks], aPV[t]);
#pragma unroll
                for (int ks = 0; ks < 4; ++ks) aQC[t] = MFMA16(ldfrag(L + ML_CT + (tile * 16 + fr) * 288 + ks * 64 + fq * 16), bq[2 + ks], aQC[t]); }
            const float wi = vb[192 + l], eml = vb[128 + l];
            float den = aPV[4][0] + wi * aQC[4][0];
            den = __shfl(den, fr);
            const float inv = 1.0f / fmaxf(fabsf(den), eml);
            const int tt = j * 64 + l, t = dir ? (SEQ - 1 - tt) : tt; const size_t mrow = (size_t)(b * SEQ + t);
#pragma unroll
            for (int t4 = 0; t4 < 4; ++t4) { const f32x4 nv = (aPV[t4] + aQC[t4] * wi) * inv; v2u o; o.x = pk2(nv[0], nv[1]); o.y = pk2(nv[2], nv[3]);
                *(v2u*)(Hout + mrow * 1024 + (dq * 4 + t4) * 16 + 4 * fq) = o; }
        }
        TP(5);
        {
            const float decay = vb[320];
            bf16x8 ak[2];
#pragma unroll
            for (int ks = 0; ks < 2; ++ks) ak[ks] = ldfrag_tr(L + ML_KW + (ks * 32) * 272 + w * 32 + tro272, 272);
#pragma unroll
            for (int t = 0; t < 9; ++t) { accS[t] = accS[t] * decay;
#pragma unroll
                for (int ks = 0; ks < 2; ++ks) accS[t] = MFMA16(ak[ks], ldfrag_tr(L + ML_VX + (ks * 32) * 304 + t * 32 + tro304, 304), accS[t]); }
        }
        TP(6); WG_BAR(); TP(7);
#pragma unroll
        for (int t = 0; t < 9; ++t) st8(L + ML_CT + (t * 16 + fr) * 288 + (w * 16 + 4 * fq) * 2, accS[t]);
        TP(8);
    }
    TP_SPIN(unit == 0);
    __syncthreads();
#undef ML_GATES
#undef ML_LOADQKV
#undef ML_LOADG
}

constexpr int DN_WREG = 18432;
constexpr int DNP_GV = 8 * DN_WREG;
__device__ __forceinline__ void delta_pre(Frame& F, const float* d_alog, const float* d_dtb) {
    const int lane = F.lane, w = F.wave, fr = lane & 15, fq = lane >> 4;
    LAS unsigned char* L = F.lds;
    const int tro144 = trofs(lane, 144);
    LAS unsigned char* PA = L + w * DN_WREG; LAS unsigned char* XA = PA + 9216; LAS float* gv = (LAS float*)(L + DNP_GV + w * 512);
    const int gw = F.vcu * NWAVES + w, NGW = F.G * NWAVES;
#pragma unroll 1
    for (int item = gw; item < 4096; item += NGW) {
        const int c = item & 31, dir = (item >> 5) & 1, h = (item >> 6) & 7, b = item >> 9;
        const float* Ga = (const float*)(F.ws + WS_GATES) + 16 + dir * 8 + h; const float* Gb = Ga + 16;
        const bf16* Qg = (const bf16*)(F.ws + WS_DQ) + h * 128; const bf16* Kg = (const bf16*)(F.ws + WS_DK) + h * 128;
        bf16* Slot = (bf16*)(F.ws + (dir ? WS_ODB : WS_ODF)) + h * 128;
        const float Aexp = __expf(d_alog[dir * 8 + h]), dtb = d_dtb[dir * 8 + h];
        { const int tt = c * 64 + lane, t = dir ? (SEQ - 1 - tt) : tt; const unsigned go = (unsigned)(b * SEQ + t) * 256u;
          const float ap = *(const float*)((const char*)Ga + go) + dtb, bp = *(const float*)((const char*)Gb + go);
          const float sp = ap > 0.f ? ap + __logf(1.0f + __expf(-ap)) : __logf(1.0f + __expf(ap));
          const float gq = -Aexp * sp, beta = 1.0f / (1.0f + __expf(-bp));
          gv[lane] = wave_incl_sum(gq); gv[64 + lane] = beta; }
        unsigned ro[4];
#pragma unroll
        for (int t4 = 0; t4 < 4; ++t4) { const int tt = c * 64 + t4 * 16 + fr, t = dir ? (SEQ - 1 - tt) : tt; ro[t4] = (unsigned)(b * SEQ + t) * 2048u; }
        f32x4 accX[4][4], accA[4][4];
#pragma unroll
        for (int tb = 0; tb < 4; ++tb)
#pragma unroll
            for (int ta = 0; ta < 4; ++ta) { accX[ta][tb] = (f32x4){0.f, 0.f, 0.f, 0.f}; accA[ta][tb] = (f32x4){0.f, 0.f, 0.f, 0.f}; }
#pragma unroll
        for (int kh = 0; kh < 2; ++kh) {
            bf16x8 kf[4][2], qf[4][2];
#pragma unroll
            for (int t4 = 0; t4 < 4; ++t4)
#pragma unroll
                for (int ks = 0; ks < 2; ++ks) { kf[t4][ks] = *(const bf16x8*)((const char*)Kg + ro[t4] + fq * 16 + (kh * 2 + ks) * 64); qf[t4][ks] = *(const bf16x8*)((const char*)Qg + ro[t4] + fq * 16 + (kh * 2 + ks) * 64); }
#pragma unroll
            for (int tb = 0; tb < 4; ++tb)
#pragma unroll
                for (int ta = 0; ta < 4; ++ta) if (ta <= tb) {
#pragma unroll
                    for (int ks = 0; ks < 2; ++ks) { accX[ta][tb] = MFMA16(kf[ta][ks], kf[tb][ks], accX[ta][tb]);
                        accA[ta][tb] = MFMA16(kf[ta][ks], qf[tb][ks], accA[ta][tb]); } }
        }
#pragma unroll
        for (int tb = 0; tb < 4; ++tb)
#pragma unroll
            for (int ta = 0; ta < 4; ++ta) {
                const int bI = tb * 16 + fr, a0 = ta * 16 + 4 * fq;
                if (ta <= tb) {
                    const f32x4 acc = accX[ta][tb], aq = accA[ta][tb];
                    const float gcb = gv[bI], betab = gv[64 + bI];
                    f32x4 vna, vxa, vat;
#pragma unroll
                    for (int r = 0; r < 4; ++r) { const float gm = __expf(fminf(gcb - gv[a0 + r], 0.f)); const float e = -betab * acc[r] * gm, ea = aq[r] * gm;
                        if (ta == tb) { const int dd = (4 * fq + r) - fr; vna[r] = dd < 0 ? e : 0.f; vxa[r] = dd < 0 ? e : (dd == 0 ? 1.0f : 0.f); vat[r] = dd <= 0 ? ea : 0.f; }
                        else { vna[r] = e; vxa[r] = e; vat[r] = ea; } }
                    accX[ta][tb] = vxa;
                    st8(PA + bI * 144 + a0 * 2, vna); st8(XA + bI * 144 + a0 * 2, vxa);
                    v2u o; o.x = pk2(vat[0], vat[1]); o.y = pk2(vat[2], vat[3]);
                    *(v2u*)((char*)Slot + ro[tb] + 128 + a0 * 2) = o;
                } else { const f32x4 z = (f32x4){0.f, 0.f, 0.f, 0.f}; st8(PA + bI * 144 + a0 * 2, z); st8(XA + bI * 144 + a0 * 2, z);
                    *(v2u*)((char*)Slot + ro[tb] + 128 + a0 * 2) = (v2u){0u, 0u}; }
            }
#pragma unroll 1
        for (int kk = 1; kk <= 6; ++kk) {
            f32x4 accP[4][4];
            bf16x8 fA[4][2];
#pragma unroll
            for (int ta = 0; ta < 4; ++ta)
#pragma unroll
                for (int ks = 0; ks < 2; ++ks) if (ks >= (ta >> 1)) fA[ta][ks] = ldfrag_tr(PA + (ks * 32) * 144 + ta * 32 + tro144, 144);
#pragma unroll
            for (int tb = 0; tb < 4; ++tb) {
                bf16x8 pb[2], xb[2];
#pragma unroll
                for (int ks = 0; ks < 2; ++ks) if (ks <= (tb >> 1)) { pb[ks] = ldfrag(PA + (tb * 16 + fr) * 144 + ks * 64 + fq * 16); xb[ks] = ldfrag(XA + (tb * 16 + fr) * 144 + ks * 64 + fq * 16); }
#pragma unroll
                for (int ta = 0; ta < 4; ++ta) if (ta <= tb) {
                    accP[ta][tb] = (f32x4){0.f, 0.f, 0.f, 0.f};
#pragma unroll
                    for (int ks = 0; ks < 2; ++ks) if (ks >= (ta >> 1) && ks <= (tb >> 1)) {
                        if (kk <= 5) accP[ta][tb] = MFMA16(fA[ta][ks], pb[ks], accP[ta][tb]);
                        if (kk >= 2) accX[ta][tb] = MFMA16(fA[ta][ks], xb[ks], accX[ta][tb]); } }
            }
#pragma unroll
            for (int tb = 0; tb < 4; ++tb)
#pragma unroll
                for (int ta = 0; ta < 4; ++ta) if (ta <= tb) { const int off = (tb * 16 + fr) * 144 + (ta * 16 + 4 * fq) * 2;
                    if (kk <= 5) st8(PA + off, accP[ta][tb]);
                    if (kk >= 2) st8(XA + off, accX[ta][tb]); }
        }
#pragma unroll
        for (int tb = 0; tb < 4; ++tb)
#pragma unroll
            for (int ta = 0; ta < 4; ++ta) { v2u o; if (ta <= tb) { o.x = pk2(accX[ta][tb][0], accX[ta][tb][1]); o.y = pk2(accX[ta][tb][2], accX[ta][tb][3]); } else { o.x = 0u; o.y = 0u; }
                *(v2u*)((char*)Slot + ro[tb] + (ta * 16 + 4 * fq) * 2) = o; }
    }
}

constexpr int DN_QS = 0, DN_KS = 36864, DN_VS = 77824, DN_T1 = 95232, DN_T2 = 105472, DN_AT = 115712, DN_WL = 125952;
constexpr int DN_VEC = 144384, DN_VECN = 264;
__device__ __forceinline__ bf16x8 packacc(const f32x4& a, const f32x4& b) { v4u o; o.x = pk2(a[0], a[1]); o.y = pk2(a[2], a[3]); o.z = pk2(b[0], b[1]); o.w = pk2(b[2], b[3]); return __builtin_bit_cast(bf16x8, o); }
__device__ __forceinline__ bf16x8 ldfrag_trs(const LAS unsigned char* p, int RS) {
    const s16x4 lo = __builtin_amdgcn_ds_read_tr16_b64_v4i16((LAS s16x4*)p);
    const s16x4 hi = __builtin_amdgcn_ds_read_tr16_b64_v4i16((LAS s16x4*)(p + 16 * RS));
    return __builtin_shufflevector(lo, hi, 0, 1, 2, 3, 4, 5, 6, 7); }
__device__ __forceinline__ int trofs_s(int fr, int fq, int RS) { return (8 * fq + (fr >> 2)) * RS + 16 * (fr & 3); }
__device__ __forceinline__ void delta_unit(Frame& F, int unit, const float* d_alog, const float* d_dtb) {
    const int tid = F.tid, lane = F.lane, w = F.wave, fr0 = lane & 15, fq0 = lane >> 4;
    const int dir = unit & 1, h = (unit >> 1) & 7, b = unit >> 4;
    LAS unsigned char* L = F.lds;
    LAS float* vec = (LAS float*)(L + DN_VEC);
    f32x4 accS[8];
#pragma unroll
    for (int t = 0; t < 8; ++t) accS[t] = (f32x4){0.f, 0.f, 0.f, 0.f};
    const float* Ga = (const float*)(F.ws + WS_GATES) + 16 + dir * 8 + h; const float* Gb = Ga + 16;
    const bf16* Qg = (const bf16*)(F.ws + WS_DQ) + h * 128; const bf16* Kg = (const bf16*)(F.ws + WS_DK) + h * 128; const bf16* Vg = (const bf16*)(F.ws + WS_DV) + h * 128;
    bf16* Oout = (bf16*)(F.ws + (dir ? WS_ODB : WS_ODF)) + h * 128;
    const float Aexp = __expf(d_alog[dir * 8 + h]), dtb = d_dtb[dir * 8 + h];
    const int sr = tid >> 4, sc = tid & 15;
    v4u q[2], k[2], v[2], tT, tA;
#define DN_LOADQKV(jj) do { _Pragma("unroll") for (int p = 0; p < 2; ++p) { const int tt_ = (jj) * 64 + sr + 32 * p, t_ = dir ? (SEQ - 1 - tt_) : tt_; const unsigned ro_ = (unsigned)(b * SEQ + t_) * 2048u + (unsigned)sc * 16u; \
        q[p] = *(const v4u*)((const char*)Qg + ro_); k[p] = *(const v4u*)((const char*)Kg + ro_); v[p] = *(const v4u*)((const char*)Vg + ro_); } \
        { const int tt_ = (jj) * 64 + (tid >> 3), t_ = dir ? (SEQ - 1 - tt_) : tt_; const unsigned so_ = (unsigned)(b * SEQ + t_) * 2048u + (unsigned)(tid & 7) * 16u; \
          tT = *(const v4u*)((const char*)Oout + so_); tA = *(const v4u*)((const char*)Oout + so_ + 128); } } while (0)
    TP_DECL
    DN_LOADQKV(0);
    for (int grp = 0; grp < 4; ++grp) {
        int fr = fr0, fq = fq0; asm volatile("" : "+v"(fr), "+v"(fq));
        WG_BAR();
        {
            const int c = grp * 8 + w; LAS float* gv = vec + w * DN_VECN;
            const int tt = c * 64 + lane, t = dir ? (SEQ - 1 - tt) : tt; const unsigned go = (unsigned)(b * SEQ + t) * 256u;
            const float ap = *(const float*)((const char*)Ga + go) + dtb, bp = *(const float*)((const char*)Gb + go);
            const float sp = ap > 0.f ? ap + __logf(1.0f + __expf(-ap)) : __logf(1.0f + __expf(ap));
            const float gq = -Aexp * sp, beta = 1.0f / (1.0f + __expf(-bp)), gc = wave_incl_sum(gq), gl = lane63(gc);
            gv[lane] = gc; gv[64 + lane] = beta; gv[128 + lane] = __expf(gc); gv[192 + lane] = __expf(gl - gc); if (lane == 0) gv[256] = __expf(gl);
        }
        WG_BAR();
        for (int jc = 0; jc < 8; ++jc) {
            TP(22);
            const int j = grp * 8 + jc; asm volatile("" : "+v"(fr), "+v"(fq)); const int tro272 = trofs(fq * 16 + fr, 272), tro320 = trofs(fq * 16 + fr, 320);
            LAS float* vb = vec + jc * DN_VECN;
            const int pbq = (j & 1) * 18432, pbk = (j & 1) * 20480;
#pragma unroll
            for (int p = 0; p < 2; ++p) { const int r = sr + 32 * p;
                *(LAS v4u*)(L + DN_QS + pbq + r * 288 + sc * 16) = q[p]; *(LAS v4u*)(L + DN_KS + pbk + r * 320 + sc * 16) = k[p]; *(LAS v4u*)(L + DN_VS + r * 272 + sc * 16) = v[p]; }
            {
                const int tr = tid >> 3, c0 = (tid & 7) * 8; v4u t1, t2;
#pragma unroll
                for (int i = 0; i < 4; ++i) { const float b0 = vb[64 + c0 + 2 * i], b1 = vb[64 + c0 + 2 * i + 1], e0 = vb[128 + c0 + 2 * i], e1 = vb[128 + c0 + 2 * i + 1];
                    const float x0 = bflo(tT[i]) * b0, x1 = bfhi(tT[i]) * b1; t1[i] = pk2(x0, x1); t2[i] = pk2(x0 * e0, x1 * e1); }
                *(LAS v4u*)(L + DN_T1 + tr * 160 + c0 * 2) = t1; *(LAS v4u*)(L + DN_T2 + tr * 160 + c0 * 2) = t2; }
            TP(23); WG_BAR(); TP(24);
            *(LAS v4u*)(L + DN_AT + (tid >> 3) * 160 + (tid & 7) * 16) = tA;
            if (j + 1 < 32) DN_LOADQKV(j + 1);
            f32x4 accU[4];
            {
                f32x4 accW[4];
#pragma unroll
                for (int lt = 0; lt < 4; ++lt) { accU[lt] = (f32x4){0.f, 0.f, 0.f, 0.f}; accW[lt] = (f32x4){0.f, 0.f, 0.f, 0.f}; }
                bf16x8 vtr[2], ktr[2], t1f[2][4], t2f[2][4];
#pragma unroll
                for (int ks = 0; ks < 2; ++ks) { vtr[ks] = ldfrag_tr(L + DN_VS + (ks * 32) * 272 + w * 32 + tro272, 272); ktr[ks] = ldfrag_tr(L + DN_KS + pbk + (ks * 32) * 320 + w * 32 + tro320, 320);
#pragma unroll
                    for (int lt = 0; lt < 4; ++lt) if (ks <= (lt >> 1)) { t1f[ks][lt] = ldfrag(L + DN_T1 + ((lt >> 1) * 32 + 8 * (fr >> 2) + 4 * (lt & 1) + (fr & 3)) * 160 + ks * 64 + fq * 16);     t2f[ks][lt] = ldfrag(L + DN_T2 + (lt * 16 + fr) * 160 + ks * 64 + fq * 16); } }
                __builtin_amdgcn_sched_barrier(0);
#pragma unroll
                for (int ks = 0; ks < 2; ++ks)
#pragma unroll
                    for (int lt = 0; lt < 4; ++lt) if (ks <= (lt >> 1)) { accU[lt] = MFMA16(t1f[ks][lt], vtr[ks], accU[lt]); accW[lt] = MFMA16(ktr[ks], t2f[ks][lt], accW[lt]); }
#pragma unroll
                for (int lt = 0; lt < 4; ++lt) { const f32x4 nw = -accW[lt]; st8(L + DN_WL + (lt * 16 + fr) * 288 + (w * 16 + 4 * fq) * 2, nw); }
            }
            TP(25); WG_BAR(); TP(26);
            {
                bf16x8 sfr[4];
#pragma unroll
                for (int ks = 0; ks < 4; ++ks) sfr[ks] = packacc(accS[2 * ks], accS[2 * ks + 1]);
                const float egl = vb[256];
                const int tgo = j * 64, trs = trofs_s(fr, fq, 320);
                {
                    bf16x8 wf[4][4];
#pragma unroll
                    for (int ks = 0; ks < 4; ++ks)
#pragma unroll
                        for (int lt = 0; lt < 4; ++lt) wf[ks][lt] = ldfrag(L + DN_WL + ((lt >> 1) * 32 + 8 * (fr >> 2) + 4 * (lt & 1) + (fr & 3)) * 288 + ks * 64 + fq * 16);
                    __builtin_amdgcn_sched_barrier(0);
#pragma unroll
                    for (int ks = 0; ks < 4; ++ks)
#pragma unroll
                        for (int lt = 0; lt < 4; ++lt) accU[lt] = MFMA16(wf[ks][lt], sfr[ks], accU[lt]);
                }
                f32x4 aOQ[4];
                {
                    bf16x8 qf[4][4];
#pragma unroll
                    for (int ks = 0; ks < 4; ++ks)
#pragma unroll
                        for (int lt = 0; lt < 4; ++lt) qf[ks][lt] = ldfrag(L + DN_QS + pbq + (lt * 16 + fr) * 288 + ks * 64 + fq * 16);
                    __builtin_amdgcn_sched_barrier(0);
#pragma unroll
                    for (int lt = 0; lt < 4; ++lt) aOQ[lt] = (f32x4){0.f, 0.f, 0.f, 0.f};
#pragma unroll
                    for (int ks = 0; ks < 4; ++ks)
#pragma unroll
                        for (int lt = 0; lt < 4; ++lt) aOQ[lt] = MFMA16(sfr[ks], qf[ks][lt], aOQ[lt]);
                }
                bf16x8 vfr[2], vfs[2];
#pragma unroll
                for (int ks = 0; ks < 2; ++ks) { vfr[ks] = packacc(accU[2 * ks], accU[2 * ks + 1]);
                    const f32x4 ka = *(const LAS f32x4*)(vb + 192 + 32 * ks + 8 * fq), kb2 = *(const LAS f32x4*)(vb + 192 + 32 * ks + 8 * fq + 4);
                    vfs[ks] = packacc(accU[2 * ks] * ka, accU[2 * ks + 1] * kb2); }
                {
                    bf16x8 af[2][4], kd[2][8];
#pragma unroll
                    for (int ks = 0; ks < 2; ++ks)
#pragma unroll
                        for (int lt = 0; lt < 4; ++lt) af[ks][lt] = ldfrag(L + DN_AT + (lt * 16 + fr) * 160 + ks * 64 + fq * 16);
#pragma unroll
                    for (int ks = 0; ks < 2; ++ks)
#pragma unroll
                        for (int t8 = 0; t8 < 8; ++t8) kd[ks][t8] = ldfrag_tr(L + DN_KS + pbk + (ks * 32) * 320 + ((t8 >> 1) * 32 + 4 * (t8 & 1)) * 2 + trs, 320);
                    __builtin_amdgcn_sched_barrier(0);
#pragma unroll
                    for (int lt = 0; lt < 4; ++lt) {
                        f32x4 aOA = (f32x4){0.f, 0.f, 0.f, 0.f};
#pragma unroll
                        for (int ks = 0; ks < 2; ++ks) aOA = MFMA16(vfr[ks], af[ks][lt], aOA);
                        const int l = lt * 16 + fr; const float egl_l = vb[128 + l];
                        const int tt = tgo + l, t = dir ? (SEQ - 1 - tt) : tt; const unsigned oo = (unsigned)(b * SEQ + t) * 2048u + (unsigned)(w * 16 + 4 * fq) * 2u;
                        const f32x4 ov = aOA + aOQ[lt] * egl_l; v2u o; o.x = pk2(ov[0], ov[1]); o.y = pk2(ov[2], ov[3]);
                        *(v2u*)((char*)Oout + oo) = o; }
#pragma unroll
                    for (int t8 = 0; t8 < 8; ++t8) accS[t8] = accS[t8] * egl;
#pragma unroll
                    for (int ks = 0; ks < 2; ++ks)
#pragma unroll
                        for (int t8 = 0; t8 < 8; ++t8) accS[t8] = MFMA16(kd[ks][t8], vfs[ks], accS[t8]);
                }
            }
            TP(30);
        }
    }
    TP_SPIN(unit == 0);
    __syncthreads();
#undef DN_LOADQKV
}

__device__ __forceinline__ void p4_combine(Frame& F, const float* m_ng, const float* d_ng) {
    const int gw = F.vcu * NWAVES + F.wave, NGW = F.G * NWAVES, lane = F.lane;
    const bf16* PROJ = (const bf16*)(F.ws + WS_PROJ);
    const bf16* HMf = (const bf16*)(F.ws + WS_HM); const bf16* HMb = HMf + (size_t)MROWS * 1024;
    const bf16* ODf = (const bf16*)(F.ws + WS_ODF); const bf16* ODb = (const bf16*)(F.ws + WS_ODB);
    bf16* YM = (bf16*)(F.ws + WS_YM); bf16* YD = (bf16*)(F.ws + WS_YD);
    for (int m = gw; m < MROWS; m += NGW) {
        v2u hf[4], hb[4], mo[4]; unsigned of[8], ob[8], dz[8];
#pragma unroll
        for (int h = 0; h < 4; ++h) { hf[h] = *(const v2u*)(HMf + (size_t)m * 1024 + h * 256 + 4 * lane); hb[h] = *(const v2u*)(HMb + (size_t)m * 1024 + h * 256 + 4 * lane);
            mo[h] = *(const v2u*)(PROJ + (size_t)(8 + h) * BLK + (size_t)m * 256 + 4 * lane); }
#pragma unroll
        for (int h = 0; h < 8; ++h) { of[h] = *(const unsigned*)(ODf + (size_t)m * 1024 + h * 128 + 2 * lane); ob[h] = *(const unsigned*)(ODb + (size_t)m * 1024 + h * 128 + 2 * lane);
            dz[h] = *(const unsigned*)(PROJ + (size_t)(24 + (h >> 1)) * BLK + (size_t)m * 256 + (h & 1) * 128 + 2 * lane); }
#pragma unroll
        for (int h = 0; h < 4; ++h) {
            const float a0 = bflo(hf[h].x) + bflo(hb[h].x), a1 = bfhi(hf[h].x) + bfhi(hb[h].x), a2 = bflo(hf[h].y) + bflo(hb[h].y), a3 = bfhi(hf[h].y) + bfhi(hb[h].y);
            const float ss = wave_sum((a0 * a0 + a1 * a1) + (a2 * a2 + a3 * a3));
            const float r = 1.0f / sqrtf(ss * (1.f / 256.f) + RMS_EPS);
            const f32x4 g = *(const f32x4*)(m_ng + h * 256 + 4 * lane);
            const float o0 = bflo(mo[h].x), o1 = bfhi(mo[h].x), o2 = bflo(mo[h].y), o3 = bfhi(mo[h].y);
            v2u y; y.x = pk2(a0 * r * g.x / (1.f + expf(-o0)), a1 * r * g.y / (1.f + expf(-o1))); y.y = pk2(a2 * r * g.z / (1.f + expf(-o2)), a3 * r * g.w / (1.f + expf(-o3)));
            *(v2u*)(YM + (size_t)m * 1024 + h * 256 + 4 * lane) = y;
        }
        const float g0 = d_ng[2 * lane], g1 = d_ng[2 * lane + 1];
#pragma unroll
        for (int h = 0; h < 8; ++h) {
            const float a0 = bflo(of[h]) + bflo(ob[h]), a1 = bfhi(of[h]) + bfhi(ob[h]);
            const float ss = wave_sum(a0 * a0 + a1 * a1);
            const float r = 1.0f / sqrtf(ss * (1.f / 128.f) + RMS_EPS);
            const float z0 = bflo(dz[h]), z1 = bfhi(dz[h]);
            *(unsigned*)(YD + (size_t)m * 1024 + h * 128 + 2 * lane) = pk2(a0 * r * g0 * z0 / (1.f + expf(-z0)), a1 * r * g1 * z1 / (1.f + expf(-z1)));
        }
    }
}

__device__ __forceinline__ void p7_norm2(Frame& F, const float* n2g, const float* w_ff1, const float* w_ff2) {
    LAS float* scr = (LAS float*)(F.lds + F.wave * TR_SCR);
    const int gw = F.vcu * NWAVES + F.wave, NGW = F.G * NWAVES;
    bf16* W1T = (bf16*)(F.ws + WS_W1T); bf16* W2T = (bf16*)(F.ws + WS_W2T); bf16* XN2 = (bf16*)(F.ws + WS_XN2);
    constexpr int I_1 = (DM / 64) * (DFF / 64), I_2 = (DFF / 64) * (DM / 64);
    for (int it = gw; it < I_1 + I_2; it += NGW) {
        if (it < I_1) tr_item(w_ff1, DM, DFF, W1T, scr, it, F.lane, false); else tr_item(w_ff2, DFF, DM, W2T, scr, it - I_1, F.lane, false);
    }
    for (int m = gw; m < MROWS; m += NGW) rms_row_bf16(F.lane, F.out + (size_t)m * DM, n2g, XN2 + (size_t)m * DM);
}
__device__ __forceinline__ void p10_final(Frame& F, const float* nfg) {
    const int gw = F.vcu * NWAVES + F.wave, NGW = F.G * NWAVES;
    for (int m = gw; m < MROWS; m += NGW) rms_row_f32(F.lane, F.out + (size_t)m * DM, nfg, F.out + (size_t)m * DM);
}
struct Args { const float* in[17]; float* out; unsigned char* ws; int ph_lo, ph_hi, li, pad; };
__global__ void __launch_bounds__(NWAVES * 64, 2) hybrid_fwd(Args args) {
    extern __shared__ __attribute__((aligned(16))) unsigned char lds[];
    Frame F;
    F.lds = (LAS unsigned char*)lds;
    F.MISC = (volatile LAS unsigned*)(F.lds + MISC_OFF);
    F.tid = threadIdx.x; F.lane = F.tid & 63; F.wave = __builtin_amdgcn_readfirstlane(F.tid >> 6);
    F.G = gridDim.x; { const int bx = blockIdx.x; F.vcu = (F.G % 8 == 0) ? (bx % 8) * (F.G / 8) + bx / 8 : bx; }
    F.ws = args.ws; F.ctl = (gu32*)(args.ws + WS_CTL);
    F.out = args.out;
    if (F.tid < 64) ((LAS unsigned*)(F.lds + MISC_OFF))[F.tid] = 0u;
    __syncthreads();
    XcdBarrier bar; bar.bar = (unsigned*)(F.ctl + CW_BAR); bar.x = 0; bar.st = nullptr;
    if (N_LAUNCHES != PER_PHASE) bar = xcd_barrier_post((unsigned*)(F.ctl + CW_BAR), F.MISC + 8);
#define GRID_BAR() do { if (N_LAUNCHES != PER_PHASE) xcd_barrier(bar); } while (0)
    const int lo = args.ph_lo, hi = args.ph_hi;
#ifndef PHASE_MASK
#define PHASE_MASK 0x7ff
#endif
#define IN(k) (((PHASE_MASK >> (k)) & 1) && lo <= (k) && (k) < hi)
#define BOTH(k) (IN(k) && IN((k) + 1))
    bf16* PROJ = (bf16*)(F.ws + WS_PROJ);

    if (IN(0)) { p0_prologue(F, args.in[0], args.in[1], args.in[2], args.in[10], args.in[11], args.in[12]); if (BOTH(0)) GRID_BAR(); }
    if (IN(1)) {
        pg8::Gemm g{(const bf16*)(F.ws + WS_XN), (const bf16*)(F.ws + WS_WIN), MROWS, 11264, DM}; pg8::StaticOrder S; S.init(MROWS, 11264, F.G, (int)blockIdx.x);
        pg8::EpiProj E{PROJ, (float*)(F.ws + WS_GATES)};
        pg8::gemm_phase<pg8::EpiProj, pg8::StaticOrder, true, true>(F.lds, g, S, E);
        gate_gemm(F);
        if (BOTH(1)) GRID_BAR();
    }
    if (IN(2)) { p2_conv(F, args.in[6]); if (BOTH(2)) GRID_BAR(); }
    if (IN(3)) {
        delta_pre(F, args.in[7], args.in[8]);
        GRID_BAR();
        const int u = F.vcu;
        if (u < 128) { if (args.pad != 2) mlstm_unit(F, u, args.in[3], args.in[4]); }
        else if (u < 256) { if (args.pad != 1) delta_unit(F, u - 128, args.in[7], args.in[8]); }
        if (BOTH(3)) GRID_BAR();
    }
    if (IN(4)) { p4_combine(F, args.in[5], args.in[9]); if (BOTH(4)) GRID_BAR(); }
    if (IN(5)) {
        pg8::Gemm g{(const bf16*)(F.ws + WS_YM), (const bf16*)(F.ws + WS_WBM), 2 * MROWS, 4096, 1024}; pg8::BranchOrder S; S.init(F.G, (int)blockIdx.x);
        pg8::EpiBranch E{PROJ, (bf16*)(F.ws + WS_MIX)};
        pg8::gemm_phase<pg8::EpiBranch, pg8::BranchOrder, true, true>(F.lds, g, S, E);
        if (BOTH(5)) GRID_BAR();
    }
    if (IN(6)) {
        pg8::Gemm g{(const bf16*)(F.ws + WS_MIX), (const bf16*)(F.ws + WS_WOUT), MROWS, DM, DM}; pg8::StaticOrder S; S.init(MROWS, DM, F.G, (int)blockIdx.x);
        pg8::EpiResid E{args.in[0], F.out, DM};
        pg8::gemm_phase<pg8::EpiResid, pg8::StaticOrder, true, true>(F.lds, g, S, E);
        if (BOTH(6)) GRID_BAR();
    }
    if (IN(7)) { p7_norm2(F, args.in[13], args.in[14], args.in[15]); if (BOTH(7)) GRID_BAR(); }
    if (IN(8)) {
        pg8::Gemm g{(const bf16*)(F.ws + WS_XN2), (const bf16*)(F.ws + WS_W1T), MROWS, DFF, DM}; pg8::StaticOrder S; S.init(MROWS, DFF, F.G, (int)blockIdx.x);
        pg8::EpiRelu2 E{(bf16*)(F.ws + WS_HFF), DFF};
        pg8::gemm_phase<pg8::EpiRelu2, pg8::StaticOrder, true, true>(F.lds, g, S, E);
        if (BOTH(8)) GRID_BAR();
    }
    if (IN(9)) {
        pg8::Gemm g{(const bf16*)(F.ws + WS_HFF), (const bf16*)(F.ws + WS_W2T), MROWS, DM, DFF}; pg8::StaticOrder S; S.init(MROWS, DM, F.G, (int)blockIdx.x);
        pg8::EpiResid E{F.out, F.out, DM};
        pg8::gemm_phase<pg8::EpiResid, pg8::StaticOrder, true, true>(F.lds, g, S, E);
        if (BOTH(9)) GRID_BAR();
    }
    if (IN(10)) { p10_final(F, args.in[16]); }
#undef IN
#undef BOTH
}

extern "C" void kernel_launch(void* const* d_in, const int* in_sizes, int n_in, void* d_out, int out_size, void* d_ws, size_t ws_size, hipStream_t stream) {
    static int grid = 0;
    if (grid == 0) {
        if (n_in != 17 || in_sizes[0] != MROWS * DM || out_size != MROWS * DM || ws_size < WS_END) {
            fprintf(stderr, "kernel_launch: unexpected problem: n_in %d, in0 %d, out %d, ws %zu (need %zu); nothing launched\n", n_in, n_in > 0 ? in_sizes[0] : -1, out_size, ws_size, (size_t)WS_END); grid = -1; return; }
        int dev = 0, cus = 0, per_cu = 0;
        if (hipGetDevice(&dev) != hipSuccess || hipDeviceGetAttribute(&cus, hipDeviceAttributeMultiprocessorCount, dev) != hipSuccess) { fprintf(stderr, "kernel_launch: device query failed\n"); grid = -1; return; }
        if (hipFuncSetAttribute((const void*)hybrid_fwd, hipFuncAttributeMaxDynamicSharedMemorySize, LDS_BYTES) != hipSuccess) { fprintf(stderr, "kernel_launch: hipFuncSetAttribute failed\n"); grid = -1; return; }
        if (hipOccupancyMaxActiveBlocksPerMultiprocessor(&per_cu, (const void*)hybrid_fwd, NWAVES * 64, LDS_BYTES) != hipSuccess || per_cu < 1)
            fprintf(stderr, "kernel_launch: note: occupancy query reports %d workgroups per CU\n", per_cu);
        (void)hipGetLastError();
        grid = cus;
    }
    if (grid < 0) return;
    if (hipMemsetAsync((char*)d_ws + WS_CTL, 0, CTL_ZERO_BYTES, stream) != hipSuccess) { fprintf(stderr, "kernel_launch: memset failed\n"); return; }
    Args a{};
    for (int i = 0; i < 17; ++i) a.in[i] = (const float*)d_in[i];
    a.out = (float*)d_out; a.ws = (unsigned char*)d_ws;
#ifdef PROBE_PH
    const int nl = 2; const int plo[2] = {0, PROBE_PH}, phi[2] = {PROBE_PH + 1, PER_PHASE};
#else
    const int nl = N_LAUNCHES; const int plo[2] = {0, 0}, phi[2] = {PER_PHASE, PER_PHASE};
#endif
    for (int li = 0; li < nl; ++li) {
        if (li > 0 && N_LAUNCHES != PER_PHASE) (void)hipMemsetAsync((char*)d_ws + WS_CTL, 0, CTL_ZERO_BYTES, stream);
#ifdef PROBE_SKIP
        a.pad = (li == 1) ? PROBE_SKIP : 0;
#endif
        a.ph_lo = (N_LAUNCHES == PER_PHASE) ? li : plo[li & 1]; a.ph_hi = (N_LAUNCHES == PER_PHASE) ? li + 1 : phi[li & 1]; a.li = li;
        hipLaunchKernelGGL(hybrid_fwd, dim3(grid), dim3(NWAVES * 64), LDS_BYTES, stream, a);
        const hipError_t le = hipPeekAtLastError();
        if (le != hipSuccess) { fprintf(stderr, "kernel_launch: launch %d failed: %s\n", li, hipGetErrorName(le)); break; }
    }
}
```
